# Optimizing an MI355X kernel written in HIP

```python
import math
import jax, jax.numpy as jnp
from jax import lax
import numpy as np

D_MODEL = 1024
BATCH = 4
SEQ = 8192
DEPTH = 2

N_EVEN = (DEPTH + 1) // 2
N_ODD = DEPTH // 2
EPS = 1e-6
NEG_INF = -1e30

A_GROUPS = 4
A_GROUP_DIM = 128
A_CHUNK = 128
A_WIDTH = A_GROUPS * A_GROUP_DIM

B_HEADS = 8
B_KV_HEADS = 2
B_HEAD_DIM = 64
B_WIDTH = B_HEADS * B_HEAD_DIM
B_KV_WIDTH = B_KV_HEADS * B_HEAD_DIM
CMP_BLOCK = 32
CMP_STRIDE = 16
CMP_HIDDEN = 128
SLC_BLOCK = 64
SLC_TOPK = 16
WINDOW = 512
Q_BLOCK = 128
N_BRANCH = 3

MIX_WIDTH = A_WIDTH + B_WIDTH
EVEN_IN = 2 * A_WIDTH + B_WIDTH + 6 * B_KV_WIDTH + N_BRANCH * B_HEADS
EVEN_SPLITS = [int(c) for c in np.cumsum([A_WIDTH, A_WIDTH, B_WIDTH] + [B_KV_WIDTH] * 6)]

C_HEADS = 8
C_HEAD_DIM = 128
C_WIDTH = C_HEADS * C_HEAD_DIM
C_CHUNK = 64
ODD_IN = 4 * C_WIDTH

P_HEADS = 8
P_QDIM = 256
P_NKEYS = 128
P_TOPK = 16
P_EXPERTS = P_NKEYS * P_NKEYS
P_TOK_BLOCK = 128

kernel_name = "hybrid_gmlp_nsa_hgrn2_peer"


def rmsnorm(x, w):
    xf = x.astype(jnp.float32)
    y = xf * lax.rsqrt(jnp.mean(xf * xf, axis=-1, keepdims=True) + EPS)
    return (y * w.astype(jnp.float32)).astype(x.dtype)


def layernorm(x, w):
    xf = x.astype(jnp.float32)
    mu = jnp.mean(xf, axis=-1, keepdims=True)
    var = jnp.mean(jnp.square(xf - mu), axis=-1, keepdims=True)
    return ((xf - mu) * lax.rsqrt(var + EPS) * w.astype(jnp.float32)).astype(x.dtype)


def alibi_slopes(n_heads):
    return (2.0 ** (-8.0 * np.arange(1, n_heads + 1) / n_heads)).astype(np.float32)


def masked_softmax(scores, bias, valid):
    s = jnp.where(valid, scores.astype(jnp.float32) + bias, NEG_INF)
    m = jnp.max(s, axis=-1, keepdims=True)
    e = jnp.where(valid, jnp.exp(s - m), 0.0)
    return e / jnp.maximum(jnp.sum(e, axis=-1, keepdims=True), 1e-30)


def chunked_gmlp(u, v, ln_w, w_s, b_s):
    B_, S_, _ = u.shape
    nc = S_ // A_CHUNK
    vc = v.reshape(B_, nc, A_CHUNK, A_GROUPS, A_GROUP_DIM)
    vc = layernorm(vc, ln_w.reshape(A_GROUPS, A_GROUP_DIM))
    causal = jnp.tril(jnp.ones((A_CHUNK, A_CHUNK), dtype=bool))
    ws = jnp.where(causal[None], w_s, 0.0).astype(v.dtype)
    mixed = jnp.einsum('gts,bnsgd->bntgd', ws, vc) + b_s.T.astype(v.dtype)[:, :, None]
    return u * mixed.reshape(B_, S_, A_WIDTH)


def compress(kv, idx, pos, w1, w2):
    B_, _, G, Dh = kv.shape
    blk = kv[:, idx] + pos[:, None, :].astype(kv.dtype)
    blk = blk.transpose(0, 1, 3, 2, 4).reshape(B_, idx.shape[0], G, CMP_BLOCK * Dh)
    return jax.nn.gelu(blk @ w1) @ w2


def nsa(q, k_c, v_c, k_s, v_s, k_w, v_w, gates, cmp_pos, ck_w1, ck_w2, cv_w1, cv_w2):
    B_, S_ = q.shape[0], q.shape[1]
    G, R, Dh = B_KV_HEADS, B_HEADS // B_KV_HEADS, B_HEAD_DIM
    dt = q.dtype
    scale = Dh ** -0.5
    slopes = jnp.asarray(alibi_slopes(B_HEADS)).reshape(G, R)[:, :, None, None]

    n_cmp = (S_ - CMP_BLOCK) // CMP_STRIDE + 1
    cmp_idx = np.arange(n_cmp)[:, None] * CMP_STRIDE + np.arange(CMP_BLOCK)[None, :]
    k_cmp = compress(k_c, cmp_idx, cmp_pos, ck_w1, ck_w2)
    v_cmp = compress(v_c, cmp_idx, cmp_pos, cv_w1, cv_w2)
    cmp_end = jnp.asarray(cmp_idx[:, -1].astype(np.int32))

    n_slc = S_ // SLC_BLOCK
    topk = min(SLC_TOPK, n_slc)
    ci = np.arange(n_cmp)[:, None] * CMP_STRIDE
    sj = np.arange(n_slc)[None, :] * SLC_BLOCK
    overlap = jnp.asarray(((ci < sj + SLC_BLOCK) & (ci + CMP_BLOCK > sj)).astype(np.float32))
    ks_blocks = k_s.transpose(0, 2, 1, 3).reshape(B_, G, n_slc, SLC_BLOCK, Dh)
    vs_blocks = v_s.transpose(0, 2, 1, 3).reshape(B_, G, n_slc, SLC_BLOCK, Dh)
    bi = jnp.arange(B_)[:, None, None, None]
    gi = jnp.arange(G)[None, :, None, None]
    j_blk = jnp.arange(n_slc)

    k_w_pad = jnp.pad(k_w, ((0, 0), (WINDOW, 0), (0, 0), (0, 0)))
    v_w_pad = jnp.pad(v_w, ((0, 0), (WINDOW, 0), (0, 0), (0, 0)))
    gate = jax.nn.sigmoid(gates.astype(jnp.float32)).astype(dt)

    def one_block(qb):
        t0 = qb * Q_BLOCK
        t = t0 + jnp.arange(Q_BLOCK)
        qg = lax.dynamic_slice_in_dim(q, t0, Q_BLOCK, 1).reshape(B_, Q_BLOCK, G, R, Dh) * scale

        sc = jnp.einsum('btgrd,bngd->bgrtn', qg, k_cmp)
        dist_c = t[:, None] - cmp_end[None, :]
        p_cmp = masked_softmax(sc, -slopes * dist_c, dist_c >= 0)
        o_cmp = jnp.einsum('bgrtn,bngd->btgrd', p_cmp.astype(dt), v_cmp)

        imp = jnp.einsum('bgrtn,nj->bgtj', p_cmp, overlap)
        jcur = t // SLC_BLOCK
        forced = (j_blk[None, :] == 0) | (j_blk[None, :] == jcur[:, None]) | (j_blk[None, :] == jcur[:, None] - 1)
        causal_blk = j_blk[None, :] * SLC_BLOCK <= t[:, None]
        imp = jnp.where(forced, 1e9, jnp.where(causal_blk, imp, NEG_INF))
        _, sel = lax.top_k(imp, topk)
        ks = ks_blocks[bi, gi, sel].reshape(B_, G, Q_BLOCK, topk * SLC_BLOCK, Dh)
        vs = vs_blocks[bi, gi, sel].reshape(B_, G, Q_BLOCK, topk * SLC_BLOCK, Dh)
        kpos = (sel[..., None] * SLC_BLOCK + jnp.arange(SLC_BLOCK)).reshape(B_, G, Q_BLOCK, topk * SLC_BLOCK)
        dist_s = (t[None, None, :, None] - kpos)[:, :, None]
        ss = jnp.einsum('btgrd,bgtkd->bgrtk', qg, ks)
        p_s = masked_softmax(ss, -slopes * dist_s, dist_s >= 0)
        o_slc = jnp.einsum('bgrtk,bgtkd->btgrd', p_s.astype(dt), vs)

        kw = lax.dynamic_slice_in_dim(k_w_pad, t0, Q_BLOCK + WINDOW, 1)
        vw = lax.dynamic_slice_in_dim(v_w_pad, t0, Q_BLOCK + WINDOW, 1)
        kpos_w = t0 - WINDOW + jnp.arange(Q_BLOCK + WINDOW)
        dist_w = t[:, None] - kpos_w[None, :]
        valid_w = (dist_w >= 0) & (dist_w < WINDOW) & (kpos_w[None, :] >= 0)
        sw = jnp.einsum('btgrd,blgd->bgrtl', qg, kw)
        p_w = masked_softmax(sw, -slopes * dist_w, valid_w)
        o_win = jnp.einsum('bgrtl,blgd->btgrd', p_w.astype(dt), vw)

        gb = lax.dynamic_slice_in_dim(gate, t0, Q_BLOCK, 1).reshape(B_, Q_BLOCK, G, R, N_BRANCH)
        o = gb[..., 0:1] * o_cmp + gb[..., 1:2] * o_slc + gb[..., 2:3] * o_win
        return o.reshape(B_, Q_BLOCK, B_WIDTH)

    out = lax.map(one_block, jnp.arange(S_ // Q_BLOCK))
    return out.transpose(1, 0, 2, 3).reshape(B_, S_, B_WIDTH)


def even_mixer(h, w_in, a_ln_w, a_ws, a_bs, cmp_pos, ck_w1, ck_w2, cv_w1, cv_w2, w_out):
    B_, S_, _ = h.shape
    u, v, q, kc, vc, ks, vs, kw, vw, gt = jnp.split(h @ w_in, EVEN_SPLITS, axis=-1)
    a = chunked_gmlp(jax.nn.gelu(u), jax.nn.gelu(v), a_ln_w, a_ws, a_bs)
    kvh = lambda z: z.reshape(B_, S_, B_KV_HEADS, B_HEAD_DIM)
    b = nsa(q.reshape(B_, S_, B_HEADS, B_HEAD_DIM), kvh(kc), kvh(vc), kvh(ks), kvh(vs), kvh(kw), kvh(vw),
            gt.reshape(B_, S_, B_HEADS, N_BRANCH), cmp_pos, ck_w1, ck_w2, cv_w1, cv_w2)
    return jnp.concatenate([a, b], axis=-1) @ w_out


def hgrn2_recurrence(q, f_logits, i, lb):
    B_, S_, _ = q.shape
    nc = S_ // C_CHUNK
    fg = lb + (1.0 - lb) * jax.nn.sigmoid(f_logits.astype(jnp.float32))
    log_f = jnp.log(fg)
    k = 1.0 - fg

    def to_chunks(z):
        return z.astype(jnp.float32).reshape(B_, nc, C_CHUNK, C_HEADS, C_HEAD_DIM).transpose(1, 0, 3, 2, 4)

    causal = jnp.tril(jnp.ones((C_CHUNK, C_CHUNK), dtype=bool))[:, :, None]

    def step(state, inp):
        qc, kc, vc, gc = inp
        b = jnp.cumsum(gc, axis=2)
        o_inter = jnp.einsum('bhtk,bhkv->bhtv', qc * jnp.exp(b), state)
        diff = b[:, :, :, None, :] - b[:, :, None, :, :]
        decay = jnp.exp(jnp.where(causal, diff, NEG_INF))
        attn = jnp.einsum('bhtk,bhsk,bhtsk->bhts', qc, kc, decay)
        o_intra = jnp.einsum('bhts,bhsv->bhtv', attn, vc)
        b_last = b[:, :, -1:, :]
        state = jnp.exp(b_last[:, :, 0, :])[..., None] * state + \
            jnp.einsum('bhsk,bhsv->bhkv', kc * jnp.exp(b_last - b), vc)
        return state, o_inter + o_intra

    s0 = jnp.zeros((B_, C_HEADS, C_HEAD_DIM, C_HEAD_DIM), jnp.float32)
    _, o = lax.scan(step, s0, (to_chunks(q), to_chunks(k), to_chunks(i), to_chunks(log_f)))
    return o.transpose(1, 0, 3, 2, 4).reshape(B_, S_, C_HEADS, C_HEAD_DIM).astype(q.dtype)


def odd_mixer(h, w_in, lb, norm_w, w_out):
    B_, S_, _ = h.shape
    q, f, i, g = jnp.split(h @ w_in, 4, axis=-1)
    o = hgrn2_recurrence(jax.nn.silu(q), f, i, lb)
    o = rmsnorm(o, norm_w.reshape(C_HEADS, C_HEAD_DIM)) * jax.nn.silu(g).reshape(B_, S_, C_HEADS, C_HEAD_DIM)
    return o.reshape(B_, S_, C_WIDTH) @ w_out


def peer(x, w_q, sub_keys, u_tab, v_tab):
    B_, S_, D = x.shape
    xt = x.reshape(-1, P_TOK_BLOCK, D)

    def block(xb):
        qh = (xb @ w_q).reshape(P_TOK_BLOCK, P_HEADS, 2, P_QDIM // 2)
        s = jnp.einsum('thpd,hpnd->thpn', qh, sub_keys).astype(jnp.float32)
        s_top, i_top = lax.top_k(s, P_TOPK)
        cand = (s_top[:, :, 0, :, None] + s_top[:, :, 1, None, :]).reshape(P_TOK_BLOCK, P_HEADS, P_TOPK * P_TOPK)
        cand_idx = (i_top[:, :, 0, :, None] * P_NKEYS + i_top[:, :, 1, None, :]).reshape(P_TOK_BLOCK, P_HEADS, P_TOPK * P_TOPK)
        best, pos = lax.top_k(cand, P_TOPK)
        experts = jnp.take_along_axis(cand_idx, pos, axis=-1)
        gate = jax.nn.softmax(best, axis=-1).astype(xb.dtype)
        u = u_tab[experts]
        v = v_tab[experts]
        act = jax.nn.gelu(jnp.einsum('td,thkd->thk', xb, u))
        return jnp.einsum('thk,thkd->td', gate * act, v)

    return lax.map(block, xt).reshape(B_, S_, D)


def setup_inputs(seed: int = 0) -> dict:
    key = jax.random.key(seed)
    ks = jax.random.split(key, 24)
    nrm = lambda k, shape, sc: jax.random.normal(k, shape, jnp.float32) * sc
    gain = lambda k, shape: 1.0 + 0.02 * jax.random.normal(k, shape, jnp.float32)
    return {
        "x": nrm(ks[0], (BATCH, SEQ, D_MODEL), 1.0),
        "norm_mix": gain(ks[1], (DEPTH, D_MODEL)),
        "norm_ffn": gain(ks[2], (DEPTH, D_MODEL)),
        "final_norm": gain(ks[3], (D_MODEL,)),
        "even_w_in": nrm(ks[4], (N_EVEN, D_MODEL, EVEN_IN), D_MODEL ** -0.5),
        "gmlp_ln_w": gain(ks[5], (N_EVEN, A_WIDTH)),
        "gmlp_w_s": nrm(ks[6], (N_EVEN, A_GROUPS, A_CHUNK, A_CHUNK), A_CHUNK ** -0.5),
        "gmlp_b_s": gain(ks[7], (N_EVEN, A_GROUPS, A_CHUNK)),
        "nsa_cmp_pos": nrm(ks[8], (N_EVEN, CMP_BLOCK, B_HEAD_DIM), 0.1),
        "nsa_ck_w1": nrm(ks[9], (N_EVEN, CMP_BLOCK * B_HEAD_DIM, CMP_HIDDEN), (CMP_BLOCK * B_HEAD_DIM) ** -0.5),
        "nsa_ck_w2": nrm(ks[10], (N_EVEN, CMP_HIDDEN, B_HEAD_DIM), CMP_HIDDEN ** -0.5),
        "nsa_cv_w1": nrm(ks[11], (N_EVEN, CMP_BLOCK * B_HEAD_DIM, CMP_HIDDEN), (CMP_BLOCK * B_HEAD_DIM) ** -0.5),
        "nsa_cv_w2": nrm(ks[12], (N_EVEN, CMP_HIDDEN, B_HEAD_DIM), CMP_HIDDEN ** -0.5),
        "even_w_out": nrm(ks[13], (N_EVEN, MIX_WIDTH, D_MODEL), MIX_WIDTH ** -0.5),
        "odd_w_in": nrm(ks[14], (N_ODD, D_MODEL, ODD_IN), D_MODEL ** -0.5),
        "hgrn_lower_bounds": nrm(ks[15], (DEPTH, C_WIDTH), 0.1),
        "hgrn_norm_w": gain(ks[16], (N_ODD, C_WIDTH)),
        "odd_w_out": nrm(ks[17], (N_ODD, C_WIDTH, D_MODEL), C_WIDTH ** -0.5),
        "peer_w_q": nrm(ks[18], (DEPTH, D_MODEL, P_HEADS * P_QDIM), D_MODEL ** -0.5),
        "peer_keys": nrm(ks[19], (DEPTH, P_HEADS, 2, P_NKEYS, P_QDIM // 2), (P_QDIM // 2) ** -0.5),
        "peer_u": nrm(ks[20], (DEPTH, P_EXPERTS, D_MODEL), D_MODEL ** -0.5),
        "peer_v": nrm(ks[21], (DEPTH, P_EXPERTS, D_MODEL), P_HEADS ** -0.5),
    }


def reference(x, norm_mix, norm_ffn, final_norm, even_w_in, gmlp_ln_w, gmlp_w_s, gmlp_b_s,
              nsa_cmp_pos, nsa_ck_w1, nsa_ck_w2, nsa_cv_w1, nsa_cv_w2, even_w_out,
              odd_w_in, hgrn_lower_bounds, hgrn_norm_w, odd_w_out,
              peer_w_q, peer_keys, peer_u, peer_v):
    p_lb = jax.nn.softmax(hgrn_lower_bounds.astype(jnp.float32), axis=0)
    lbs = jnp.cumsum(p_lb, axis=0) - p_lb[0:1]
    for layer in range(DEPTH):
        h = rmsnorm(x, norm_mix[layer])
        if layer % 2 == 0:
            e = layer // 2
            x = x + even_mixer(h, even_w_in[e], gmlp_ln_w[e], gmlp_w_s[e], gmlp_b_s[e],
                               nsa_cmp_pos[e], nsa_ck_w1[e], nsa_ck_w2[e], nsa_cv_w1[e], nsa_cv_w2[e],
                               even_w_out[e])
        else:
            o = layer // 2
            x = x + odd_mixer(h, odd_w_in[o], lbs[layer], hgrn_norm_w[o], odd_w_out[o])
        x = x + peer(rmsnorm(x, norm_ffn[layer]), peer_w_q[layer], peer_keys[layer], peer_u[layer], peer_v[layer])
    return rmsnorm(x, final_norm)
```

```cpp
#include <hip/hip_runtime.h>
#include <cstdio>
#include <cstdint>
#define MK_N_LAUNCHES 1
#define FAST_GEMM 0
namespace pg8 {
#define PG8_LAS __attribute__((address_space(3)))
typedef unsigned short bf16_t;
typedef short bf16x8 __attribute__((ext_vector_type(8)));
typedef float f32x4 __attribute__((ext_vector_type(4)));
typedef unsigned u32x4 __attribute__((ext_vector_type(4)));
constexpr int BM = 256, BK = 64, HALF = 128, HTB = HALF * BK * 2  , STAGE_BYTES = 8 * HTB, NXCD = 8, WGM = 8;

__host__ __device__ __forceinline__ int lds_byte(int r, int c) { const int st = (r >> 4) * 2 + (c >> 5), rr = r & 15, cc = c & 31, ob = rr * 64 + cc * 2; return st * 1024 + (ob ^ (((ob >> 9) & 1) << 5)); }
__host__ __device__ __forceinline__ void stage_rc(int b, int& R, int& C) { const int st = b / 1024, sb = b % 1024, swz = sb ^ (((sb >> 9) & 1) << 5); R = (st >> 1) * 16 + swz / 64; C = (st & 1) * 32 + (swz % 64) / 2; }
__host__ __device__ __forceinline__ int perm32(int rho) { const int n = rho >> 4, i = rho & 15; return 8 * (i >> 2) + 4 * n + (i & 3); }

struct Unit { int pm, pn; };
struct Gemm { const bf16_t* A; const bf16_t* Bt; int M, N, K; };

struct StaticOrder {
    int nM, nN, nwg, G, c;
    __host__ __device__ void init(int M, int N, int G_, int c_) { nM = M / BM; nN = N / BM; nwg = nM * nN; G = G_; c = c_; }
    __host__ __device__ bool next(int i, Unit& u) const {
        const long L = (long)i * G + c; if (L >= nwg) return false;
        int wgid = (int)L; { const int q = nwg / NXCD, r = nwg % NXCD, xcd = wgid % NXCD, off = wgid / NXCD; wgid = (xcd < r ? xcd * (q + 1) : r * (q + 1) + (xcd - r) * q) + off; }
        const int nig = WGM * nN, gid = wgid / nig, fm = gid * WGM, gsz = (nM - fm) < WGM ? (nM - fm) : WGM;
        u.pm = fm + ((wgid % nig) % gsz); u.pn = (wgid % nig) / gsz; return true;
    }
    __device__ __forceinline__ void a_ready(const Unit&) const {}
    __device__ __forceinline__ void done(const Unit&) const {}
};
__device__ __forceinline__ unsigned cvt_pk_bf16(float lo, float hi) { unsigned r; asm volatile("v_cvt_pk_bf16_f32 %0, %1, %2" : "=v"(r) : "v"(lo), "v"(hi)); return r; }
typedef float f32x2 __attribute__((ext_vector_type(2)));
__device__ __forceinline__ f32x2 gelu_pk(f32x2 v) {
    const f32x2 av = __builtin_elementwise_abs(v), d = av * 0.2316418882f + 1.0f;
    f32x2 t; t.x = __builtin_amdgcn_rcpf(d.x); t.y = __builtin_amdgcn_rcpf(d.y);
    f32x2 q = t * 0.5307027145f + (-0.7265760135f); q = q * t + 0.7107068705f; q = q * t + (-0.142248368f); q = q * t + 0.127414796f; q = q * t;
    const f32x2 s = (v * v) * (-0.72134752044f);
    f32x2 e; e.x = __builtin_amdgcn_exp2f(s.x); e.y = __builtin_amdgcn_exp2f(s.y);
    const f32x2 m = v * (q * e), r = v - m;
    f32x2 o; o.x = v.x < 0.f ? m.x : r.x; o.y = v.y < 0.f ? m.y : r.y; return o;
}

__device__ __forceinline__ float sigmoidf_(float x) { return 1.0f / (1.0f + __expf(-x)); }
__device__ __forceinline__ float siluf_(float x) { return x / (1.0f + __expf(-x)); }
__device__ __forceinline__ float gelu_tanh(float x) {
    const float u = 0.7978845608028654f * (x + 0.044715f * x * x * x);
    const float t = 1.0f - 2.0f / (__expf(2.0f * u) + 1.0f);
    return 0.5f * x * (1.0f + t);
}
__device__ __forceinline__ unsigned short f2h_bits(float x) { _Float16 h = (_Float16)x; return __builtin_bit_cast(unsigned short, h); }
__device__ __forceinline__ float h2f_bits(unsigned short b) { _Float16 h = __builtin_bit_cast(_Float16, b); return (float)h; }
__device__ __forceinline__ unsigned short f2bf_rne(float f) { unsigned u = __builtin_bit_cast(unsigned, f); return (unsigned short)((u + 0x7fffu + ((u >> 16) & 1u)) >> 16); }
enum { AK_ID = 0, AK_GELU = 1, AK_SCALE8 = 2, AK_SIGMOID = 3, AK_SILU = 4, AK_KK = 5 };
__device__ __forceinline__ int kind_p0(int col) { return col < 1024 ? AK_GELU : col < 1536 ? AK_SCALE8 : col < 2304 ? AK_ID : AK_SIGMOID; }
__device__ __forceinline__ int kind_p1(int col) { return col < 1024 ? AK_SILU : col < 2048 ? AK_KK : col < 3072 ? AK_ID : AK_SILU; }
__device__ __forceinline__ unsigned short act_store(int kind, float v, float lbv) {
    switch (kind) {
        case AK_GELU: return f2bf_rne(gelu_tanh(v));
        case AK_SCALE8: return f2bf_rne(v * 0.125f);
        case AK_SIGMOID: return f2bf_rne(sigmoidf_(v));
        case AK_SILU: return f2bf_rne(siluf_(v));
        case AK_KK: return f2h_bits((1.0f - lbv) * sigmoidf_(-v));
        default: return f2bf_rne(v);
    }
}
template <int WHICH> struct EpiAct {
    static constexpr bool PERM = true, AFTER_DRAIN = false;
    bf16_t* O; int ldc; const float* lb;
    __device__ __forceinline__ void operator()(const f32x4 (&acc)[2][2][4][2], const Unit& u, int wr, int wc, int fr, int fq) const {
        const int row0 = u.pm * BM + wr * 64 + fr; const int colt = u.pn * BM;
        const int kind = WHICH == 0 ? kind_p0(colt) : WHICH == 1 ? kind_p1(colt) : AK_ID;
        const int col0 = colt + wc * 32 + 8 * fq;
#pragma unroll
        for (int bj = 0; bj < 2; ++bj) {
            float lbv[8];
#pragma unroll
            for (int e = 0; e < 8; ++e) lbv[e] = (WHICH == 1 && kind == AK_KK) ? lb[col0 + bj * HALF + e - 1024] : 0.f;
#pragma unroll
            for (int ai = 0; ai < 2; ++ai)
#pragma unroll
                for (int m = 0; m < 4; ++m) {
                    const f32x4 v0 = acc[ai][bj][m][0], v1 = acc[ai][bj][m][1];
                    u32x4 w;
                    w.x = (unsigned)act_store(kind, v0[0], lbv[0]) | ((unsigned)act_store(kind, v0[1], lbv[1]) << 16);
                    w.y = (unsigned)act_store(kind, v0[2], lbv[2]) | ((unsigned)act_store(kind, v0[3], lbv[3]) << 16);
                    w.z = (unsigned)act_store(kind, v1[0], lbv[4]) | ((unsigned)act_store(kind, v1[1], lbv[5]) << 16);
                    w.w = (unsigned)act_store(kind, v1[2], lbv[6]) | ((unsigned)act_store(kind, v1[3], lbv[7]) << 16);
                    *(u32x4*)(O + (size_t)(row0 + ai * HALF + m * 16) * ldc + col0 + bj * HALF) = w;
                }
        }
    }
};
struct EpiResid {
    static constexpr bool PERM = false, AFTER_DRAIN = false;
    const float* base; float* out; int ldc;
    __device__ __forceinline__ void operator()(const f32x4 (&acc)[2][2][4][2], const Unit& u, int wr, int wc, int fr, int fq) const {
        const int row0 = u.pm * BM + wr * 64 + fr; const int col0 = u.pn * BM + wc * 32 + 4 * fq;
#pragma unroll
        for (int ai = 0; ai < 2; ++ai)
#pragma unroll
            for (int m = 0; m < 4; ++m) { const size_t off = (size_t)(row0 + ai * HALF + m * 16) * ldc + col0;
#pragma unroll
                for (int bj = 0; bj < 2; ++bj)
#pragma unroll
                    for (int n = 0; n < 2; ++n) { const f32x4 b = *(const f32x4*)(base + off + bj * HALF + n * 16); *(f32x4*)(out + off + bj * HALF + n * 16) = b + acc[ai][bj][m][n]; } }
    }
};
template <class Epi, class Sched, bool ALIGN_EPI = false, bool SP2 = false>
__device__ __forceinline__ void gemm_phase(PG8_LAS unsigned char* lds, const Gemm g, const Sched& S, const Epi& E) {
    const int tid = threadIdx.x, wid = __builtin_amdgcn_readfirstlane(tid >> 6), lane = tid & 63, wr = wid >> 2, wc = wid & 3, fr = lane & 15, fq = lane >> 4;
    const int K = g.K, nt = K / BK;
    unsigned voffA[2], voffB[2];
#pragma unroll
    for (int i = 0; i < 2; ++i) { int R, C; stage_rc(tid * 16 + i * 8192, R, C); const int Rb = Epi::PERM ? ((R & ~31) + perm32(R & 31)) : R;
        voffA[i] = (unsigned)(R * K + C) * 2u; voffB[i] = (unsigned)(Rb * K + C) * 2u; }
    const size_t kstep = (size_t)(BK * 2);
    const size_t hstep = (size_t)HALF * K * 2;
    const size_t tstep = 2 * hstep;
    const unsigned ldsw = (unsigned)wid * 1024u;
    const int aoff = lds_byte(wr * 64 + fr, fq * 8), boff = lds_byte(wc * 32 + fr, fq * 8);
#define PG8_SA(b, h) (((b) * 2 + (h)) * HTB)
#define PG8_SB(b, h) ((4 + (b) * 2 + (h)) * HTB)
#define PG8_STAGE(bufoff, gbase, voff) do { _Pragma("unroll") for (int _i = 0; _i < 2; ++_i) \
        __builtin_amdgcn_global_load_lds((const unsigned*)((const char*)(gbase) + (voff)[_i]), (PG8_LAS unsigned*)(lds + (bufoff) + ldsw + _i * 8192), 16, 0, 0); } while (0)
#define PG8_LDA(dst, b, h) do { _Pragma("unroll") for (int m = 0; m < 4; ++m) _Pragma("unroll") for (int k = 0; k < 2; ++k) dst[m][k] = *(const PG8_LAS bf16x8*)(lds + PG8_SA(b, h) + aoff + m * 2048 + k * 1024); } while (0)
#define PG8_LDB(dst, b, h) do { _Pragma("unroll") for (int n = 0; n < 2; ++n) _Pragma("unroll") for (int k = 0; k < 2; ++k) dst[n][k] = *(const PG8_LAS bf16x8*)(lds + PG8_SB(b, h) + boff + n * 2048 + k * 1024); } while (0)
#define PG8_MMA(ai, bj, At, Bt) do { __builtin_amdgcn_s_setprio(1); _Pragma("unroll") for (int m = 0; m < 4; ++m) _Pragma("unroll") for (int n = 0; n < 2; ++n) _Pragma("unroll") for (int k = 0; k < 2; ++k) \
        acc[ai][bj][m][n] = __builtin_amdgcn_mfma_f32_16x16x32_bf16(Bt[n][k], At[m][k], acc[ai][bj][m][n], 0, 0, 0); __builtin_amdgcn_s_setprio(0); } while (0)
#define PG8_WAIT_V(n) asm volatile("s_waitcnt vmcnt(" #n ")" ::: "memory")
#define PG8_WAIT_L(n) asm volatile("s_waitcnt lgkmcnt(" #n ")" ::: "memory")
#define PG8_BAR __builtin_amdgcn_s_barrier()
#define PG8_SCHED __builtin_amdgcn_sched_barrier(0)
    Unit cur, nxt; int ui = 0;
    if (!S.next(0, cur)) return;
    f32x4 acc[2][2][4][2];
#pragma unroll
    for (int a = 0; a < 2; ++a)
#pragma unroll
        for (int b = 0; b < 2; ++b)
#pragma unroll
            for (int m = 0; m < 4; ++m)
#pragma unroll
                for (int n = 0; n < 2; ++n) acc[a][b][m][n] = (f32x4){0.f, 0.f, 0.f, 0.f};
    bf16x8 At[4][2], B0[2][2], B1[2][2];
    const char* cA = (const char*)g.A + (size_t)cur.pm * tstep; const char* cB = (const char*)g.Bt + (size_t)cur.pn * tstep;
    S.a_ready(cur);
    if constexpr (SP2) {
        PG8_STAGE(PG8_SB(0, 0), cB, voffB); PG8_STAGE(PG8_SB(0, 1), cB + hstep, voffB); PG8_STAGE(PG8_SA(0, 0), cA, voffA); PG8_STAGE(PG8_SA(0, 1), cA + hstep, voffA);
        if (wr == 1) PG8_BAR;
        PG8_WAIT_V(2); PG8_BAR;
        PG8_STAGE(PG8_SB(1, 0), cB + kstep, voffB); PG8_STAGE(PG8_SA(1, 0), cA + kstep, voffA); PG8_STAGE(PG8_SB(1, 1), cB + hstep + kstep, voffB);
        PG8_WAIT_V(6); PG8_BAR;
    } else {
        PG8_STAGE(PG8_SB(0, 0), cB, voffB); PG8_STAGE(PG8_SA(0, 0), cA, voffA); PG8_STAGE(PG8_SB(0, 1), cB + hstep, voffB); PG8_STAGE(PG8_SA(0, 1), cA + hstep, voffA);
        if (wr == 1) PG8_BAR;
        PG8_WAIT_V(4); PG8_BAR;
        PG8_STAGE(PG8_SB(1, 0), cB + kstep, voffB); PG8_STAGE(PG8_SA(1, 0), cA + kstep, voffA); PG8_STAGE(PG8_SB(1, 1), cB + hstep + kstep, voffB);
        PG8_WAIT_V(6); PG8_BAR;
    }
    for (;;) {
        const bool has_next = S.next(ui + 1, nxt);
        const char* nA = has_next ? (const char*)g.A + (size_t)nxt.pm * tstep : cA; const char* nB = has_next ? (const char*)g.Bt + (size_t)nxt.pn * tstep : cB;
        for (int t = 0; t < nt; t += 2) {
            const bool last = (t == nt - 2);
            const char* a1 = cA + (size_t)(t + 1) * kstep;
            const char* a2 = last ? nA : cA + (size_t)(t + 2) * kstep; const char* b2 = last ? nB : cB + (size_t)(t + 2) * kstep;
            const char* a3 = a2 + kstep; const char* b3 = b2 + kstep;
            if (last && has_next) S.a_ready(nxt);
            if constexpr (SP2) {
            PG8_LDB(B0, 0, 0); PG8_LDB(B1, 0, 1); PG8_SCHED; PG8_LDA(At, 0, 0); PG8_STAGE(PG8_SA(1, 1), a1 + hstep, voffA);
            PG8_WAIT_V(8); PG8_WAIT_L(0); PG8_BAR; PG8_MMA(0, 0, At, B0); PG8_MMA(0, 1, At, B1); PG8_BAR; PG8_SCHED;
            PG8_LDA(At, 0, 1); PG8_STAGE(PG8_SB(0, 0), b2, voffB); PG8_STAGE(PG8_SB(0, 1), b2 + hstep, voffB); PG8_STAGE(PG8_SA(0, 0), a2, voffA);
            PG8_WAIT_V(8); PG8_WAIT_L(0); PG8_BAR; PG8_MMA(1, 0, At, B0); PG8_MMA(1, 1, At, B1); PG8_BAR; PG8_SCHED;
            PG8_LDB(B0, 1, 0); PG8_LDB(B1, 1, 1); PG8_SCHED; PG8_LDA(At, 1, 0); PG8_STAGE(PG8_SA(0, 1), a2 + hstep, voffA);
            PG8_WAIT_V(8); PG8_WAIT_L(0); PG8_BAR; PG8_MMA(0, 0, At, B0); PG8_MMA(0, 1, At, B1); PG8_BAR; PG8_SCHED;
            PG8_LDA(At, 1, 1); PG8_STAGE(PG8_SB(1, 0), b3, voffB); PG8_STAGE(PG8_SB(1, 1), b3 + hstep, voffB); PG8_STAGE(PG8_SA(1, 0), a3, voffA);
            PG8_WAIT_V(8); PG8_WAIT_L(0); PG8_BAR; PG8_MMA(1, 0, At, B0); PG8_MMA(1, 1, At, B1); PG8_BAR; PG8_SCHED;
            } else {
            PG8_LDB(B0, 0, 0); PG8_SCHED; PG8_LDA(At, 0, 0); PG8_STAGE(PG8_SA(1, 1), a1 + hstep, voffA);
            PG8_WAIT_L(8); PG8_BAR; PG8_WAIT_L(0); PG8_MMA(0, 0, At, B0); PG8_BAR; PG8_SCHED;
            PG8_LDB(B1, 0, 1); PG8_STAGE(PG8_SB(0, 0), b2, voffB);
            PG8_BAR; PG8_WAIT_L(0); PG8_MMA(0, 1, At, B1); PG8_BAR;
            PG8_LDA(At, 0, 1); PG8_STAGE(PG8_SA(0, 0), a2, voffA);
            PG8_BAR; PG8_WAIT_L(0); PG8_MMA(1, 0, At, B0); PG8_BAR; PG8_SCHED;
            PG8_STAGE(PG8_SB(0, 1), b2 + hstep, voffB);
            PG8_WAIT_V(6); PG8_BAR; PG8_MMA(1, 1, At, B1); PG8_BAR;
            PG8_LDB(B0, 1, 0); PG8_SCHED; PG8_LDA(At, 1, 0); PG8_STAGE(PG8_SA(0, 1), a2 + hstep, voffA);
            PG8_WAIT_L(8); PG8_BAR; PG8_WAIT_L(0); PG8_MMA(0, 0, At, B0); PG8_BAR; PG8_SCHED;
            PG8_LDB(B1, 1, 1); PG8_STAGE(PG8_SB(1, 0), b3, voffB);
            PG8_BAR; PG8_WAIT_L(0); PG8_MMA(0, 1, At, B1); PG8_BAR;
            PG8_LDA(At, 1, 1); PG8_STAGE(PG8_SA(1, 0), a3, voffA);
            PG8_BAR; PG8_WAIT_L(0); PG8_MMA(1, 0, At, B0); PG8_BAR; PG8_SCHED;
            PG8_STAGE(PG8_SB(1, 1), b3 + hstep, voffB);
            PG8_WAIT_V(6); PG8_BAR; PG8_MMA(1, 1, At, B1); PG8_BAR;
            }
        }
        if constexpr (ALIGN_EPI) { if (wr == 0) PG8_BAR; }
        if constexpr (!Epi::AFTER_DRAIN) { E(acc, cur, wr, wc, fr, fq); S.done(cur); }
        if (!has_next) break;
#pragma unroll
        for (int a = 0; a < 2; ++a)
#pragma unroll
            for (int b = 0; b < 2; ++b)
#pragma unroll
                for (int m = 0; m < 4; ++m)
#pragma unroll
                    for (int n = 0; n < 2; ++n) acc[a][b][m][n] = (f32x4){0.f, 0.f, 0.f, 0.f};
        cur = nxt; cA = nA; cB = nB; ++ui;
        if constexpr (ALIGN_EPI) { if (wr == 1) PG8_BAR; }
    }
    PG8_WAIT_V(0);
    if constexpr (!ALIGN_EPI) { if (wr == 0) PG8_BAR; }
    PG8_BAR;
    if constexpr (Epi::AFTER_DRAIN) { E.fused(acc, cur, wr, wc, fr, fq, lds, wid, lane); S.done(cur); }
#undef PG8_SA
#undef PG8_SB
#undef PG8_STAGE
#undef PG8_LDA
#undef PG8_LDB
#undef PG8_MMA
#undef PG8_WAIT_V
#undef PG8_WAIT_L
#undef PG8_BAR
#undef PG8_SCHED
}
}
constexpr int NWAVES = 8, NTHR = 512;
constexpr int BATCH = 4, SEQ = 8192, DM = 1024, MTOK = BATCH * SEQ;
constexpr int NP0 = 2560, NP0_REAL = 2328, NP1 = 4096, NQP = 2048;
constexpr int C_U = 0, C_V = 512, C_Q = 1024, C_KC = 1536, C_VC = 1664, C_KS = 1792, C_VS = 1920, C_KW = 2048, C_VW = 2176, C_GT = 2304;
constexpr int NCMP = 511, NCMP_PAD = 512;
constexpr int NEXP = 16384;
constexpr float EPS = 1e-6f;
#ifndef MK_N_LAUNCHES
#define MK_N_LAUNCHES 1
#endif
#ifndef FAST_GEMM
#define FAST_GEMM 1
#endif
constexpr int N_PHASES = 18;
constexpr size_t MiB = 1u << 20;
constexpr size_t WS_CTL = 0, CTL_ZERO_BYTES = 64 * 1024;
constexpr size_t WS_WIN0 = 1 * MiB, WS_WOUT0 = 6 * MiB, WS_WIN1 = 8 * MiB, WS_WOUT1 = 16 * MiB, WS_WQ = 18 * MiB  , WS_KEYS = 26 * MiB  ;
constexpr size_t WS_CW1 = 27 * MiB  ;
constexpr size_t WS_CW2 = 28 * MiB  , WS_WSTRIL = 28 * MiB + 64 * 1024  ;
constexpr size_t WS_BIAS1 = 28 * MiB + 256 * 1024  , WS_LB = 28 * MiB + 260 * 1024  ;
constexpr size_t WS_KCMP = 29 * MiB, WS_VCMP = 29 * MiB + 512 * 1024;
constexpr size_t WS_XN = 32 * MiB;
constexpr size_t WS_MIX = 96 * MiB;
constexpr size_t WS_TABU = 160 * MiB, WS_TABV = 192 * MiB;
constexpr size_t WS_EXP = 224 * MiB, WS_GATE = 240 * MiB;
constexpr size_t WS_P = 256 * MiB;
constexpr size_t WS_END = 512 * MiB;
constexpr int CW_BAR = 1024;
constexpr int RING_OFF = 0, RING_BYTES = 131072;
constexpr int LDSCTL_OFF = 143360, MISC_OFF = LDSCTL_OFF + 320;
constexpr int LDS_BYTES = 147456;
#define GAS __attribute__((address_space(1)))
#define LAS __attribute__((address_space(3)))
typedef unsigned short bf16;
typedef unsigned v4u __attribute__((ext_vector_type(4)));
typedef float f32x4 __attribute__((ext_vector_type(4)));
typedef short bf16x8 __attribute__((ext_vector_type(8)));
typedef GAS unsigned gu32;
typedef GAS unsigned long long gu64;
#define RLX_AGENT __ATOMIC_RELAXED, __HIP_MEMORY_SCOPE_AGENT
#define LDS_WAIT() asm volatile("s_waitcnt lgkmcnt(0)" ::: "memory")
#define VM_WAIT() asm volatile("s_waitcnt vmcnt(0)" ::: "memory")
__device__ __forceinline__ unsigned long long rt() { return __builtin_amdgcn_s_memrealtime(); }
__device__ __forceinline__ unsigned f2bf(float f) { unsigned u = __builtin_bit_cast(unsigned, f); return (u + 0x7fffu + ((u >> 16) & 1u)) >> 16; }
__device__ __forceinline__ unsigned pk2(float lo, float hi) { return f2bf(lo) | (f2bf(hi) << 16); }
#define XB_TMO      128
#define XB_XCNT(j)  (256  + 64 * (j))
#define XB_XSUB(j)  (1280 + 64 * (j))
#define XB_XGEN(j)  (2304 + 64 * (j))
#define XB_TOP      3328
#define XB_TOPGEN   3392
#define XCD_BAR_WORDS 3456
#define XB_SPIN_CAP (1u << 22)

__device__ __forceinline__ unsigned xb_ld(unsigned* p)              { return __hip_atomic_load(p, __ATOMIC_RELAXED, __HIP_MEMORY_SCOPE_AGENT); }
__device__ __forceinline__ unsigned xb_add(unsigned* p, unsigned v) { return __hip_atomic_fetch_add(p, v, __ATOMIC_RELAXED, __HIP_MEMORY_SCOPE_AGENT); }
__device__ __forceinline__ unsigned xb_xcc_id() { return (unsigned)__builtin_amdgcn_s_getreg((3 << 11) | 20) & 0xFu; }
#define XB_SPIN(cond, bar) do { unsigned _sp = 0; while (cond) { __builtin_amdgcn_s_sleep(1); \
    if ((++_sp & 255u) == 0u) { if (xb_ld(&(bar)[XB_TMO])) break; if (_sp > XB_SPIN_CAP) { atomicAdd(&(bar)[XB_TMO], 1u); break; } } } } while (0)

struct XcdBarrier {
    unsigned* bar; unsigned x;
    volatile LAS unsigned* st;
};

__device__ __forceinline__ XcdBarrier xcd_barrier_post(unsigned* bar, volatile LAS unsigned* st) {
    XcdBarrier b; b.bar = bar; b.x = xb_xcc_id(); b.st = st;
    if (threadIdx.x == 0) (void)xb_add(&bar[XB_XCNT(b.x)], 1u);
    return b;
}
__device__ __forceinline__ void xcd_barrier_complete(unsigned* bar, unsigned x, unsigned& nloc, unsigned& nx) {
    const unsigned G = gridDim.x * gridDim.y * gridDim.z;
    unsigned sum, cnt, mine, sp = 0u;
    for (;;) {
        sum = 0u; cnt = 0u; mine = 0u;
#pragma unroll
        for (unsigned j = 0; j < 16; ++j) { const unsigned c = xb_ld(&bar[XB_XCNT(j)]); sum += c; cnt += (c > 0u) ? 1u : 0u; mine = (j == x) ? c : mine; }
        if (sum == G) break;
        __builtin_amdgcn_s_sleep(1);
        if ((++sp & 255u) == 0u) { if (xb_ld(&bar[XB_TMO])) break; if (sp > XB_SPIN_CAP) { atomicAdd(&bar[XB_TMO], 1u); break; } }
    }
    nloc = mine > 0u ? mine : 1u; nx = cnt > 0u ? cnt : 1u;
}

__device__ __forceinline__ void xcd_barrier(const XcdBarrier& b) {
    asm volatile("s_waitcnt vmcnt(0)" ::: "memory");
    __syncthreads();
    if (threadIdx.x == 0) {
        unsigned* bar = b.bar;
        __builtin_amdgcn_s_waitcnt(0);
        unsigned nloc = b.st[0], nx = b.st[1];
        if (nloc == 0u) { xcd_barrier_complete(bar, b.x, nloc, nx); b.st[0] = nloc; b.st[1] = nx; }
        const unsigned old = xb_add(&bar[XB_XSUB(b.x)], 1u);
        const unsigned gen = old / nloc;
        if (old + 1u == (gen + 1u) * nloc) {
            __builtin_amdgcn_fence(__ATOMIC_RELEASE, "agent");
            asm volatile("s_waitcnt vmcnt(0)" ::: "memory");
            const unsigned og = xb_add(&bar[XB_TOP], 1u);
            const unsigned tg = og / nx;
            if (og + 1u == (tg + 1u) * nx) xb_add(&bar[XB_TOPGEN], 1u);
            else XB_SPIN(xb_ld(&bar[XB_TOPGEN]) == tg, bar);
            __builtin_amdgcn_fence(__ATOMIC_ACQUIRE, "agent");
            xb_add(&bar[XB_XGEN(b.x)], 1u);
            asm volatile("s_waitcnt vmcnt(0)" ::: "memory");
        } else {
            XB_SPIN(xb_ld(&bar[XB_XGEN(b.x)]) == gen, bar);
            __builtin_amdgcn_fence(__ATOMIC_ACQUIRE, "agent");
            asm volatile("s_waitcnt vmcnt(0)" ::: "memory");
        }
    }
    __syncthreads();
}
typedef __bf16 bf16x2_t __attribute__((ext_vector_type(2)));
typedef float f32x2 __attribute__((ext_vector_type(2)));
__device__ __forceinline__ float bf2f(bf16 v) { return __builtin_bit_cast(float, (unsigned)v << 16); }
__device__ __forceinline__ float bflo(unsigned w) { return __builtin_bit_cast(float, w << 16); }
__device__ __forceinline__ float bfhi(unsigned w) { return __builtin_bit_cast(float, w & 0xffff0000u); }
__device__ __forceinline__ float dot2bf(unsigned a, unsigned b, float acc) { return __builtin_amdgcn_fdot2_f32_bf16(__builtin_bit_cast(bf16x2_t, a), __builtin_bit_cast(bf16x2_t, b), acc, false); }
__device__ __forceinline__ float wave_sum(float v) {
#pragma unroll
    for (int o = 1; o < 64; o <<= 1) v += __shfl_xor(v, o);
    return v;
}
__device__ __forceinline__ float wave_max(float v) {
#pragma unroll
    for (int o = 1; o < 64; o <<= 1) v = fmaxf(v, __shfl_xor(v, o));
    return v;
}
using pg8::gelu_tanh; using pg8::sigmoidf_; using pg8::siluf_; using pg8::act_store; using pg8::kind_p0; using pg8::kind_p1; using pg8::h2f_bits;

__device__ __forceinline__ void rms_rows(const float* src, const float* w, bf16* dst_bf, float* dst_f, int gw, int NGW, int lane) {
    for (int m = gw; m < MTOK; m += NGW) {
        const f32x4* xr = (const f32x4*)(src + (size_t)m * DM) + lane;
        f32x4 v[4]; float s = 0.f;
#pragma unroll
        for (int j = 0; j < 4; ++j) { v[j] = xr[64 * j]; s += (v[j].x * v[j].x + v[j].y * v[j].y) + (v[j].z * v[j].z + v[j].w * v[j].w); }
        const float r = 1.0f / sqrtf(wave_sum(s) * (1.0f / DM) + EPS);
#pragma unroll
        for (int j = 0; j < 4; ++j) {
            const f32x4 wv = *((const f32x4*)w + lane + 64 * j);
            const f32x4 y = v[j] * r * wv;
            if (dst_bf) { unsigned long long o = (unsigned long long)pk2(y.x, y.y) | ((unsigned long long)pk2(y.z, y.w) << 32); *((unsigned long long*)(dst_bf + (size_t)m * DM) + lane + 64 * j) = o; }
            if (dst_f) *((f32x4*)(dst_f + (size_t)m * DM) + lane + 64 * j) = y;
        }
    }
}

__device__ __forceinline__ void tr_item(const float* W, int K, int N, bf16* WT, LAS float* scr, int item, int nblk, int lane) {
    const int kb = item / nblk, nb = item % nblk, k0 = 64 * kb, n0 = 32 * nb;
    const int nn = n0 + (lane & 31);
#pragma unroll 8
    for (int i = 0; i < 32; ++i) { const int kk = 2 * i + (lane >> 5); scr[kk * 33 + (lane & 31)] = (nn < N) ? W[(size_t)(k0 + kk) * N + nn] : 0.f; }
    LDS_WAIT(); asm volatile("" ::: "memory");
    const int c = lane & 7;
#pragma unroll
    for (int j = 0; j < 4; ++j) { const int n = (lane >> 3) + 8 * j; const LAS float* s = scr + (8 * c) * 33 + n;
        v4u o; o.x = pk2(s[0 * 33], s[1 * 33]); o.y = pk2(s[2 * 33], s[3 * 33]); o.z = pk2(s[4 * 33], s[5 * 33]); o.w = pk2(s[6 * 33], s[7 * 33]);
        *(v4u*)(WT + (size_t)(n0 + n) * K + k0 + 8 * c) = o; }
    LDS_WAIT(); asm volatile("" ::: "memory");
}
__device__ __forceinline__ void cvt_items(const float* src, bf16* dst, size_t n, int gw, int NGW, int lane) {
    const size_t nit = n / 512;
    for (size_t it = gw; it < nit; it += NGW) {
        const f32x4* s = (const f32x4*)(src + it * 512) + 2 * lane; const f32x4 a = s[0], b = s[1];
        v4u o; o.x = pk2(a.x, a.y); o.y = pk2(a.z, a.w); o.z = pk2(b.x, b.y); o.w = pk2(b.z, b.w);
        *((v4u*)(dst + it * 512) + lane) = o;
    }
}
template <class Epi>
__device__ __forceinline__ void naive_gemm(const bf16* A, const bf16* Wt, int M, int N, int K, const Epi& epi, int gtid, int gthreads) {
    const long total = (long)M * N;
    for (long idx = gtid; idx < total; idx += gthreads) {
        const int m = (int)(idx / N), n = (int)(idx % N);
        const v4u* a = (const v4u*)(A + (size_t)m * K); const v4u* w = (const v4u*)(Wt + (size_t)n * K);
        float a0 = 0.f, a1 = 0.f, a2 = 0.f, a3 = 0.f;
        for (int k = 0; k < K / 8; ++k) { const v4u av = a[k], wv = w[k]; a0 = dot2bf(av.x, wv.x, a0); a1 = dot2bf(av.y, wv.y, a1); a2 = dot2bf(av.z, wv.z, a2); a3 = dot2bf(av.w, wv.w, a3); }
        epi(m, n, (a0 + a1) + (a2 + a3));
    }
}
struct NEpiAct { bf16* O; int ldc; int which; const float* lb;
    __device__ __forceinline__ void operator()(int m, int n, float v) const {
        const int kind = which == 0 ? kind_p0(n) : which == 1 ? kind_p1(n) : pg8::AK_ID;
        const float lbv = (which == 1 && kind == pg8::AK_KK) ? lb[n - 1024] : 0.f;
        O[(size_t)m * ldc + n] = act_store(kind, v, lbv); } };
struct NEpiResid { const float* base; float* out; int ldc;
    __device__ __forceinline__ void operator()(int m, int n, float v) const { out[(size_t)m * ldc + n] = base[(size_t)m * ldc + n] + v; } };

__device__ __forceinline__ void naive_gmlp_unit(int u, const bf16* P0, const float* lnw, const float* Ws, const float* bs, bf16* MIX, LAS unsigned char* lds, int tid) {
    LAS float* Vn = (LAS float*)lds;
    const int g = u & 3, row0 = (u >> 2) * 128;
    {   const int r = tid >> 2, q = tid & 3;
        const bf16* src = P0 + (size_t)(row0 + r) * NP0 + C_V + g * 128 + q * 32;
        float v[32]; float s = 0.f;
#pragma unroll
        for (int i = 0; i < 32; ++i) { v[i] = bf2f(src[i]); s += v[i]; }
        s += __shfl_xor(s, 1); s += __shfl_xor(s, 2);
        const float mean = s * (1.0f / 128.0f); float q2 = 0.f;
#pragma unroll
        for (int i = 0; i < 32; ++i) { const float d = v[i] - mean; q2 += d * d; }
        q2 += __shfl_xor(q2, 1); q2 += __shfl_xor(q2, 2);
        const float rstd = 1.0f / sqrtf(q2 * (1.0f / 128.0f) + EPS);
#pragma unroll
        for (int i = 0; i < 32; ++i) Vn[r * 128 + q * 32 + i] = (v[i] - mean) * rstd * lnw[g * 128 + q * 32 + i];
    }
    __syncthreads();
    {   const int d = tid & 127, tq = tid >> 7;
        for (int t = tq * 32; t < tq * 32 + 32; ++t) {
            const float* wrow = Ws + ((size_t)g * 128 + t) * 128; float acc = 0.f;
            for (int s = 0; s <= t; ++s) acc += wrow[s] * Vn[s * 128 + d];
            const float mixed = acc + bs[g * 128 + t];
            const float uu = bf2f(P0[(size_t)(row0 + t) * NP0 + C_U + g * 128 + d]);
            MIX[(size_t)(row0 + t) * DM + g * 128 + d] = f2bf(uu * mixed);
        }
    }
    __syncthreads();
}
__device__ __forceinline__ void naive_compress_unit(int cu, const bf16* P0, const float* pos, const float* w1k, const float* w2k, const float* w1v, const float* w2v, bf16* KC, bf16* VC, LAS unsigned char* lds, int tid) {
    LAS float* blk = (LAS float*)lds; LAS float* h1p = blk + 2048; LAS float* h1 = h1p + 512;
    const int which = cu & 1, rest = cu >> 1, n = rest % NCMP, bg = rest / NCMP, g = bg & 1, b = bg >> 1;
    const float* w1 = which ? w1v : w1k; const float* w2 = which ? w2v : w2k; bf16* O = which ? VC : KC;
    const int col = (which ? C_VC : C_KC) + g * 64;
    for (int j = tid; j < 2048; j += NTHR) { const int l = j >> 6, d = j & 63; blk[j] = bf2f(P0[(size_t)(b * SEQ + 16 * n + l) * NP0 + col + d]) + pos[l * 64 + d]; }
    __syncthreads();
    {   const int hid = tid & 127, part = tid >> 7; float acc = 0.f;
        for (int j = part * 512; j < part * 512 + 512; ++j) acc += blk[j] * w1[(size_t)j * 128 + hid];
        h1p[part * 128 + hid] = acc; }
    __syncthreads();
    if (tid < 128) h1[tid] = gelu_tanh((h1p[tid] + h1p[128 + tid]) + (h1p[256 + tid] + h1p[384 + tid]));
    __syncthreads();
    if (tid < 64) { float acc = 0.f; for (int hh = 0; hh < 128; ++hh) acc += h1[hh] * w2[hh * 64 + tid]; O[((size_t)(b * 2 + g) * NCMP_PAD + n) * 64 + tid] = f2bf(acc); }
    __syncthreads();
}

constexpr int NSA_WAVE_LDS = 16384 + 1024 + 64;
__device__ __forceinline__ void nsa_dot4(const bf16* krow, const LAS float* Q, float (&s)[4]) {
    s[0] = s[1] = s[2] = s[3] = 0.f;
#pragma unroll 1
    for (int c = 0; c < 8; ++c) {
        const v4u kv = *((const v4u*)krow + c);
        const float k0 = bflo(kv.x), k1 = bfhi(kv.x), k2 = bflo(kv.y), k3 = bfhi(kv.y), k4 = bflo(kv.z), k5 = bfhi(kv.z), k6 = bflo(kv.w), k7 = bfhi(kv.w);
#pragma unroll
        for (int h = 0; h < 4; ++h) { const LAS f32x4* q = (const LAS f32x4*)(Q + h * 64 + c * 8); const f32x4 qa = q[0], qb = q[1];
            s[h] += (k0 * qa.x + k1 * qa.y) + (k2 * qa.z + k3 * qa.w) + (k4 * qb.x + k5 * qb.y) + (k6 * qb.z + k7 * qb.w); }
    }
}
__device__ __forceinline__ void naive_nsa_wave(int wu, const bf16* P0, const bf16* KC, const bf16* VC, bf16* MIX, LAS unsigned char* wlds, int lane) {
    LAS float* SC = (LAS float*)wlds; LAS float* Q = SC + 4096; LAS int* SEL = (LAS int*)(Q + 256);
    const int t = wu % SEQ, bg = wu / SEQ, g = bg & 1, b = bg >> 1;
    const size_t row = (size_t)b * SEQ + t;
    float slope[4];
#pragma unroll
    for (int h = 0; h < 4; ++h) slope[h] = exp2f(-(float)(g * 4 + h + 1));
#pragma unroll
    for (int h = 0; h < 4; ++h) Q[h * 64 + lane] = bf2f(P0[row * NP0 + C_Q + (g * 4 + h) * 64 + lane]);
    LDS_WAIT();
    const int nv = (t >= 31) ? min(NCMP, (t - 31) / 16 + 1) : 0;
    float o_cmp[4] = {0.f, 0.f, 0.f, 0.f};
    {
        float mx[4] = {-3e38f, -3e38f, -3e38f, -3e38f};
#pragma unroll 1
        for (int i = 0; i < 8; ++i) { const int n = lane + 64 * i; float s[4] = {-1e30f, -1e30f, -1e30f, -1e30f};
            if (n < nv) { nsa_dot4(KC + ((size_t)(b * 2 + g) * NCMP_PAD + n) * 64, Q, s);
#pragma unroll
                for (int h = 0; h < 4; ++h) { s[h] -= slope[h] * (float)(t - (16 * n + 31)); mx[h] = fmaxf(mx[h], s[h]); } }
#pragma unroll
            for (int h = 0; h < 4; ++h) SC[h * 1024 + n] = s[h]; }
        LDS_WAIT();
#pragma unroll
        for (int h = 0; h < 4; ++h) { const float m = wave_max(mx[h]); float sum = 0.f;
#pragma unroll 1
            for (int i = 0; i < 8; ++i) { const float s = SC[h * 1024 + lane + 64 * i]; const float e = (s > -1e29f) ? __expf(s - m) : 0.f; SC[h * 1024 + lane + 64 * i] = e; sum += e; }
            sum = wave_sum(sum); const float inv = 1.0f / fmaxf(sum, 1e-30f);
#pragma unroll 1
            for (int i = 0; i < 8; ++i) SC[h * 1024 + lane + 64 * i] *= inv; }
        LDS_WAIT();
#pragma unroll 2
        for (int n = 0; n < nv; ++n) { const float v = bf2f(VC[((size_t)(b * 2 + g) * NCMP_PAD + n) * 64 + lane]);
#pragma unroll
            for (int h = 0; h < 4; ++h) o_cmp[h] += SC[h * 1024 + n] * v; }
    }
    const int jcur = t >> 6;
    float c0, c1;
    {   float im[2];
#pragma unroll
        for (int k = 0; k < 2; ++k) { const int j = lane + 64 * k; float a = 0.f;
            for (int n = 4 * j - 1; n <= 4 * j + 3; ++n) if (n >= 0 && n < NCMP_PAD) a += (SC[n] + SC[1024 + n]) + (SC[2048 + n] + SC[3072 + n]);
            const bool forced = (j == 0) || (j == jcur) || (j == jcur - 1);
            im[k] = forced ? 1e9f : ((64 * j <= t) ? a : -1e30f); }
        c0 = im[0]; c1 = im[1]; }
    for (int it = 0; it < 16; ++it) {
        const float m = wave_max(fmaxf(c0, c1));
        const unsigned long long b0 = __ballot(c0 == m); int idx;
        if (b0) idx = __builtin_ctzll(b0); else idx = 64 + __builtin_ctzll(__ballot(c1 == m));
        if (lane == 0) SEL[it] = idx;
        if (lane == (idx & 63)) { if (idx < 64) c0 = -3e38f; else c1 = -3e38f; }
    }
    LDS_WAIT();
    float o_slc[4] = {0.f, 0.f, 0.f, 0.f}, inv_s[4];
    {   float mx[4] = {-3e38f, -3e38f, -3e38f, -3e38f};
#pragma unroll 1
        for (int it = 0; it < 16; ++it) { const int j = SEL[it]; const int kpos = 64 * j + lane; float s[4] = {-1e30f, -1e30f, -1e30f, -1e30f};
            if (kpos <= t) { nsa_dot4(P0 + ((size_t)b * SEQ + kpos) * NP0 + C_KS + g * 64, Q, s);
#pragma unroll
                for (int h = 0; h < 4; ++h) { s[h] -= slope[h] * (float)(t - kpos); mx[h] = fmaxf(mx[h], s[h]); } }
#pragma unroll
            for (int h = 0; h < 4; ++h) SC[h * 1024 + it * 64 + lane] = s[h]; }
        LDS_WAIT();
#pragma unroll
        for (int h = 0; h < 4; ++h) { const float m = wave_max(mx[h]); float sum = 0.f;
#pragma unroll 1
            for (int i = 0; i < 16; ++i) { const float s = SC[h * 1024 + i * 64 + lane]; const float e = (s > -1e29f) ? __expf(s - m) : 0.f; SC[h * 1024 + i * 64 + lane] = e; sum += e; }
            sum = wave_sum(sum); inv_s[h] = 1.0f / fmaxf(sum, 1e-30f); }
        LDS_WAIT();
#pragma unroll 1
        for (int it = 0; it < 16; ++it) { const int j = SEL[it]; if (j > jcur) continue;
#pragma unroll 2
            for (int kk = 0; kk < 64; ++kk) { const int kpos = 64 * j + kk; if (kpos > t) break;
                const float v = bf2f(P0[((size_t)b * SEQ + kpos) * NP0 + C_VS + g * 64 + lane]);
#pragma unroll
                for (int h = 0; h < 4; ++h) o_slc[h] += SC[h * 1024 + it * 64 + kk] * v; } }
    }
    float o_win[4] = {0.f, 0.f, 0.f, 0.f}, inv_w[4];
    {   float mx[4] = {-3e38f, -3e38f, -3e38f, -3e38f};
#pragma unroll 1
        for (int i = 0; i < 8; ++i) { const int kpos = t - 511 + 64 * i + lane; float s[4] = {-1e30f, -1e30f, -1e30f, -1e30f};
            if (kpos >= 0) { nsa_dot4(P0 + ((size_t)b * SEQ + kpos) * NP0 + C_KW + g * 64, Q, s);
#pragma unroll
                for (int h = 0; h < 4; ++h) { s[h] -= slope[h] * (float)(t - kpos); mx[h] = fmaxf(mx[h], s[h]); } }
#pragma unroll
            for (int h = 0; h < 4; ++h) SC[h * 1024 + i * 64 + lane] = s[h]; }
        LDS_WAIT();
#pragma unroll
        for (int h = 0; h < 4; ++h) { const float m = wave_max(mx[h]); float sum = 0.f;
#pragma unroll 1
            for (int i = 0; i < 8; ++i) { const float s = SC[h * 1024 + i * 64 + lane]; const float e = (s > -1e29f) ? __expf(s - m) : 0.f; SC[h * 1024 + i * 64 + lane] = e; sum += e; }
            sum = wave_sum(sum); inv_w[h] = 1.0f / fmaxf(sum, 1e-30f); }
        LDS_WAIT();
#pragma unroll 2
        for (int kk = 0; kk < 512; ++kk) { const int kpos = t - 511 + kk; if (kpos < 0) continue;
            const float v = bf2f(P0[((size_t)b * SEQ + kpos) * NP0 + C_VW + g * 64 + lane]);
#pragma unroll
            for (int h = 0; h < 4; ++h) o_win[h] += SC[h * 1024 + kk] * v; }
    }
#pragma unroll
    for (int h = 0; h < 4; ++h) { const bf16* gp = P0 + row * NP0 + C_GT + (g * 4 + h) * 3;
        const float o = bf2f(gp[0]) * o_cmp[h] + bf2f(gp[1]) * o_slc[h] * inv_s[h] + bf2f(gp[2]) * o_win[h] * inv_w[h];
        MIX[row * DM + 512 + (g * 4 + h) * 64 + lane] = f2bf(o); }
    LDS_WAIT();
}

__device__ __forceinline__ void naive_peer_select_wave(int wu, const bf16* QP, const bf16* KEYS, int* EXPO, float* GATEO, LAS unsigned char* wlds, int lane) {
    LAS float* Q = (LAS float*)wlds; LAS float* ST = Q + 256; LAS int* IT = (LAS int*)(ST + 32);
    const int tok = wu >> 3, h = wu & 7;
#pragma unroll
    for (int i = 0; i < 4; ++i) Q[lane + 64 * i] = bf2f(QP[(size_t)tok * NQP + h * 256 + lane + 64 * i]);
    LDS_WAIT();
    for (int p = 0; p < 2; ++p) {
        float c[2];
#pragma unroll
        for (int k = 0; k < 2; ++k) { const int n = lane + 64 * k; const v4u* kr = (const v4u*)(KEYS + ((size_t)(h * 2 + p) * 128 + n) * 128); float a = 0.f;
#pragma unroll 2
            for (int cc = 0; cc < 16; ++cc) { const v4u kv = kr[cc]; const LAS float* q = Q + p * 128 + cc * 8;
                a += (bflo(kv.x) * q[0] + bfhi(kv.x) * q[1]) + (bflo(kv.y) * q[2] + bfhi(kv.y) * q[3]) + (bflo(kv.z) * q[4] + bfhi(kv.z) * q[5]) + (bflo(kv.w) * q[6] + bfhi(kv.w) * q[7]); }
            c[k] = a; }
        float c0 = c[0], c1 = c[1];
        for (int it = 0; it < 16; ++it) {
            const float m = wave_max(fmaxf(c0, c1));
            const unsigned long long b0 = __ballot(c0 == m); int idx;
            if (b0) idx = __builtin_ctzll(b0); else idx = 64 + __builtin_ctzll(__ballot(c1 == m));
            if (lane == 0) { ST[p * 16 + it] = m; IT[p * 16 + it] = idx; }
            if (lane == (idx & 63)) { if (idx < 64) c0 = -3e38f; else c1 = -3e38f; }
        }
    }
    LDS_WAIT();
    float cd[4];
#pragma unroll
    for (int i = 0; i < 4; ++i) { const int f = lane + 64 * i; cd[i] = ST[f >> 4] + ST[16 + (f & 15)]; }
    float best = 0.f; int pos = 0;
    for (int it = 0; it < 16; ++it) {
        const float m = wave_max(fmaxf(fmaxf(cd[0], cd[1]), fmaxf(cd[2], cd[3])));
        int idx = -1;
#pragma unroll
        for (int i = 0; i < 4; ++i) { if (idx < 0) { const unsigned long long bb = __ballot(cd[i] == m); if (bb) idx = 64 * i + __builtin_ctzll(bb); } }
        if (lane == it) { best = m; pos = idx; }
#pragma unroll
        for (int i = 0; i < 4; ++i) if (idx == lane + 64 * i) cd[i] = -3e38f;
    }
    const float bmax = __shfl(best, 0);
    const float e = (lane < 16) ? __expf(best - bmax) : 0.f;
    const float sum = wave_sum(e);
    if (lane < 16) { const int ex = IT[pos >> 4] * 128 + IT[16 + (pos & 15)];
        EXPO[(size_t)tok * 128 + h * 16 + lane] = ex; GATEO[(size_t)tok * 128 + h * 16 + lane] = e / sum; }
    LDS_WAIT();
}

__device__ __forceinline__ void naive_peer_eval_wave(int tok, bf16* XN, const bf16* TU, const bf16* TV, const int* EXPI, const float* GATEI, float* xres, const float* nw_bf, const float* nw_f, int lane) {
    float x[16];
#pragma unroll
    for (int j = 0; j < 4; ++j) { const unsigned long long w = *((const unsigned long long*)(XN + (size_t)tok * DM) + lane + 64 * j);
        x[4 * j] = bflo((unsigned)w); x[4 * j + 1] = bfhi((unsigned)w); x[4 * j + 2] = bflo((unsigned)(w >> 32)); x[4 * j + 3] = bfhi((unsigned)(w >> 32)); }
    float acc[16];
#pragma unroll
    for (int i = 0; i < 16; ++i) acc[i] = 0.f;
    for (int e = 0; e < 128; ++e) {
        const int ex = EXPI[(size_t)tok * 128 + e]; const float gt = GATEI[(size_t)tok * 128 + e];
        const unsigned long long* ur = (const unsigned long long*)(TU + (size_t)ex * DM) + lane; float d = 0.f;
#pragma unroll
        for (int j = 0; j < 4; ++j) { const unsigned long long w = ur[64 * j];
            d += (bflo((unsigned)w) * x[4 * j] + bfhi((unsigned)w) * x[4 * j + 1]) + (bflo((unsigned)(w >> 32)) * x[4 * j + 2] + bfhi((unsigned)(w >> 32)) * x[4 * j + 3]); }
        d = wave_sum(d);
        const float wgt = gt * gelu_tanh(d);
        const unsigned long long* vr = (const unsigned long long*)(TV + (size_t)ex * DM) + lane;
#pragma unroll
        for (int j = 0; j < 4; ++j) { const unsigned long long w = vr[64 * j];
            acc[4 * j] += wgt * bflo((unsigned)w); acc[4 * j + 1] += wgt * bfhi((unsigned)w); acc[4 * j + 2] += wgt * bflo((unsigned)(w >> 32)); acc[4 * j + 3] += wgt * bfhi((unsigned)(w >> 32)); }
    }
    f32x4* xr = (f32x4*)(xres + (size_t)tok * DM) + lane; float ss = 0.f; f32x4 y[4];
#pragma unroll
    for (int j = 0; j < 4; ++j) { f32x4 r = xr[64 * j]; r.x += acc[4 * j]; r.y += acc[4 * j + 1]; r.z += acc[4 * j + 2]; r.w += acc[4 * j + 3]; y[j] = r; ss += (r.x * r.x + r.y * r.y) + (r.z * r.z + r.w * r.w); }
    const float rr = 1.0f / sqrtf(wave_sum(ss) * (1.0f / DM) + EPS);
#pragma unroll
    for (int j = 0; j < 4; ++j) {
        if (nw_f) { const f32x4 wv = *((const f32x4*)nw_f + lane + 64 * j); xr[64 * j] = y[j] * rr * wv; }
        else xr[64 * j] = y[j];
        if (nw_bf) { const f32x4 wv = *((const f32x4*)nw_bf + lane + 64 * j); const f32x4 z = y[j] * rr * wv;
            *((unsigned long long*)(XN + (size_t)tok * DM) + lane + 64 * j) = (unsigned long long)pk2(z.x, z.y) | ((unsigned long long)pk2(z.z, z.w) << 32); }
    }
}

__device__ __forceinline__ void naive_hgrn_block(int blk, const bf16* P1, const float* nw, bf16* OG, LAS unsigned char* lds, int tid) {
    constexpr int TB = 16;
    const int sq = tid >> 7, v = tid & 127, seq = blk * 4 + sq, b = seq >> 3, h = seq & 7;
    LAS float* QS = (LAS float*)lds + sq * (4 * TB * 128);
    LAS float* KS = QS + TB * 128; LAS float* FS = KS + TB * 128; LAS float* OS = FS + TB * 128;
    float st[128];
#pragma unroll
    for (int k = 0; k < 128; ++k) st[k] = 0.f;
    const float nwv = nw[h * 128 + v];
    for (int t0 = 0; t0 < SEQ; t0 += TB) {
        __syncthreads();
        for (int i = 0; i < TB; ++i) { const bf16* r = P1 + ((size_t)b * SEQ + t0 + i) * NP1 + h * 128 + v;
            QS[i * 128 + v] = bf2f(r[0]); const float kk = h2f_bits(r[1024]); KS[i * 128 + v] = kk; FS[i * 128 + v] = 1.0f - kk; }
        __syncthreads();
        for (int i = 0; i < TB; ++i) {
            const float vi = bf2f(P1[((size_t)b * SEQ + t0 + i) * NP1 + 2048 + h * 128 + v]); float o = 0.f;
#pragma unroll
            for (int k = 0; k < 128; ++k) { st[k] = FS[i * 128 + k] * st[k] + KS[i * 128 + k] * vi; o += QS[i * 128 + k] * st[k]; if ((k & 15) == 15) asm volatile("" ::: "memory"); }
            OS[i * 128 + v] = o;
        }
        __syncthreads();
        for (int i = 0; i < TB; ++i) { float ss = 0.f;
            for (int k = 0; k < 128; ++k) { const float o = OS[i * 128 + k]; ss += o * o; }
            const float rr = 1.0f / sqrtf(ss * (1.0f / 128.0f) + EPS);
            const float gate = bf2f(P1[((size_t)b * SEQ + t0 + i) * NP1 + 3072 + h * 128 + v]);
            OG[((size_t)b * SEQ + t0 + i) * DM + h * 128 + v] = f2bf(OS[i * 128 + v] * rr * nwv * gate); }
    }
    __syncthreads();
}
struct Args { const float* in[22]; float* out; unsigned char* ws; int ph_lo, ph_hi, li, pad; };
enum { I_X = 0, I_NMIX, I_NFFN, I_FNORM, I_EWIN, I_LNW, I_WS, I_BS, I_POS, I_CKW1, I_CKW2, I_CVW1, I_CVW2, I_EWOUT, I_OWIN, I_LB, I_HNW, I_OWOUT, I_PWQ, I_PKEYS, I_PU, I_PV };

__global__ void __launch_bounds__(NTHR, 2) fwd_kernel(Args args) {
    extern __shared__ __attribute__((aligned(16))) unsigned char lds_raw[];
    LAS unsigned char* lds = (LAS unsigned char*)lds_raw;
    volatile LAS unsigned* MISC = (volatile LAS unsigned*)(lds + MISC_OFF);
    const int tid = threadIdx.x, lane = tid & 63, wave = __builtin_amdgcn_readfirstlane(tid >> 6);
    const int G = gridDim.x, bx = blockIdx.x;
    const int gw = bx * NWAVES + wave, NGW = G * NWAVES, gtid = bx * NTHR + tid, gthreads = G * NTHR;
    unsigned char* ws = args.ws;
    gu32* ctl = (gu32*)(ws + WS_CTL);
    for (int u = tid; u < (LDS_BYTES - LDSCTL_OFF) / 4; u += NTHR) ((LAS unsigned*)(lds + LDSCTL_OFF))[u] = 0u;
    __syncthreads();
    XcdBarrier bar; bar.bar = (unsigned*)(ctl + CW_BAR); bar.x = 0; bar.st = nullptr;
    if (MK_N_LAUNCHES == 1) bar = xcd_barrier_post((unsigned*)(ctl + CW_BAR), MISC + 8);
    const int lo = args.ph_lo, hi = args.ph_hi;
#define IN(k) (lo <= (k) && (k) < hi)
#define SEAM(k) do { if (IN(k) && IN((k) + 1)) xcd_barrier(bar); } while (0)

    bf16* Win0t = (bf16*)(ws + WS_WIN0); bf16* Wout0t = (bf16*)(ws + WS_WOUT0); bf16* Win1t = (bf16*)(ws + WS_WIN1); bf16* Wout1t = (bf16*)(ws + WS_WOUT1);
    bf16* Wqt = (bf16*)(ws + WS_WQ); bf16* KEYS = (bf16*)(ws + WS_KEYS);
    bf16* WSTRIL = (bf16*)(ws + WS_WSTRIL); float* LBV = (float*)(ws + WS_LB);
    bf16* KCMP = (bf16*)(ws + WS_KCMP); bf16* VCMP = (bf16*)(ws + WS_VCMP);
    bf16* XN = (bf16*)(ws + WS_XN); bf16* MIX = (bf16*)(ws + WS_MIX);
    bf16* TABU = (bf16*)(ws + WS_TABU); bf16* TABV = (bf16*)(ws + WS_TABV);
    int* EXPB = (int*)(ws + WS_EXP); float* GATEB = (float*)(ws + WS_GATE);
    bf16* PB = (bf16*)(ws + WS_P);
    float* xres = args.out;

    if (IN(0)) {
        LAS float* scr = (LAS float*)(lds + wave * 16384);
        {
            const int n0 = (DM / 64) * (NP0 / 32), n1 = (DM / 64) * (DM / 32), n2 = (DM / 64) * (NP1 / 32), n3 = n1, n4 = (DM / 64) * (NQP / 32), n5 = n4;
            const int tot = n0 + n1 + n2 + n3 + n4 + n5;
            for (int it = gw; it < tot; it += NGW) { int r = it;
                if (r < n0) { tr_item(args.in[I_EWIN], DM, NP0_REAL, Win0t, scr, r, NP0 / 32, lane); continue; } r -= n0;
                if (r < n1) { tr_item(args.in[I_EWOUT], DM, DM, Wout0t, scr, r, DM / 32, lane); continue; } r -= n1;
                if (r < n2) { tr_item(args.in[I_OWIN], DM, NP1, Win1t, scr, r, NP1 / 32, lane); continue; } r -= n2;
                if (r < n3) { tr_item(args.in[I_OWOUT], DM, DM, Wout1t, scr, r, DM / 32, lane); continue; } r -= n3;
                if (r < n4) { tr_item(args.in[I_PWQ], DM, NQP, Wqt, scr, r, NQP / 32, lane); continue; } r -= n4;
                tr_item(args.in[I_PWQ] + (size_t)DM * NQP, DM, NQP, Wqt + (size_t)NQP * DM, scr, r, NQP / 32, lane); }
        }
        cvt_items(args.in[I_PKEYS], KEYS, (size_t)2 * 8 * 2 * 128 * 128, gw, NGW, lane);
        cvt_items(args.in[I_PU], TABU, (size_t)NEXP * DM, gw, NGW, lane);
        cvt_items(args.in[I_PV], TABV, (size_t)NEXP * DM, gw, NGW, lane);
        for (int i = gtid; i < 4 * 128 * 128; i += gthreads) { const int t = (i >> 7) & 127, s = i & 127; WSTRIL[i] = (s <= t) ? f2bf(args.in[I_WS][i]) : (bf16)0; }
        for (int i = gtid; i < DM; i += gthreads) LBV[i] = sigmoidf_(args.in[I_LB][DM + i] - args.in[I_LB][i]);
        rms_rows(args.in[I_X], args.in[I_NMIX], XN, nullptr, gw, NGW, lane);
    }
    SEAM(0);
    if (IN(1)) {
#if FAST_GEMM
        pg8::Gemm g{XN, Win0t, MTOK, NP0, DM}; pg8::StaticOrder S; S.init(MTOK, NP0, G, bx);
        pg8::EpiAct<0> E{PB, NP0, nullptr};
        pg8::gemm_phase<pg8::EpiAct<0>, pg8::StaticOrder, true, true>(lds + RING_OFF, g, S, E);
#else
        naive_gemm(XN, Win0t, MTOK, NP0, DM, NEpiAct{PB, NP0, 0, nullptr}, gtid, gthreads);
#endif
    }
    SEAM(1);
    if (IN(2)) {
        for (int u = bx; u < 1024; u += G) naive_gmlp_unit(u, PB, args.in[I_LNW], args.in[I_WS], args.in[I_BS], MIX, lds, tid);
        for (int cu = bx; cu < 2 * NCMP * 8; cu += G) naive_compress_unit(cu, PB, args.in[I_POS], args.in[I_CKW1], args.in[I_CKW2], args.in[I_CVW1], args.in[I_CVW2], KCMP, VCMP, lds, tid);
    }
    SEAM(2);
    if (IN(3)) {
        for (int wu = gw; wu < BATCH * 2 * SEQ; wu += NGW) naive_nsa_wave(wu, PB, KCMP, VCMP, MIX, lds + wave * NSA_WAVE_LDS, lane);
    }
    SEAM(3);
    if (IN(4)) {
#if FAST_GEMM
        pg8::Gemm g{MIX, Wout0t, MTOK, DM, DM}; pg8::StaticOrder S; S.init(MTOK, DM, G, bx);
        pg8::EpiResid E{args.in[I_X], xres, DM};
        pg8::gemm_phase<pg8::EpiResid, pg8::StaticOrder, true, true>(lds + RING_OFF, g, S, E);
#else
        naive_gemm(MIX, Wout0t, MTOK, DM, DM, NEpiResid{args.in[I_X], xres, DM}, gtid, gthreads);
#endif
    }
    SEAM(4);
    if (IN(5)) rms_rows(xres, args.in[I_NFFN], XN, nullptr, gw, NGW, lane);
    SEAM(5);
    if (IN(6)) {
#if FAST_GEMM
        pg8::Gemm g{XN, Wqt, MTOK, NQP, DM}; pg8::StaticOrder S; S.init(MTOK, NQP, G, bx);
        pg8::EpiAct<2> E{PB, NQP, nullptr};
        pg8::gemm_phase<pg8::EpiAct<2>, pg8::StaticOrder, true, true>(lds + RING_OFF, g, S, E);
#else
        naive_gemm(XN, Wqt, MTOK, NQP, DM, NEpiAct{PB, NQP, 2, nullptr}, gtid, gthreads);
#endif
    }
    SEAM(6);
    if (IN(7)) { for (int wu = gw; wu < MTOK * 8; wu += NGW) naive_peer_select_wave(wu, PB, KEYS, EXPB, GATEB, lds + wave * 2048, lane); }
    SEAM(7);
    if (IN(8)) { for (int tok = gw; tok < MTOK; tok += NGW) naive_peer_eval_wave(tok, XN, TABU, TABV, EXPB, GATEB, xres, nullptr, nullptr, lane); }
    SEAM(8);
    if (IN(9)) rms_rows(xres, args.in[I_NMIX] + DM, XN, nullptr, gw, NGW, lane);
    SEAM(9);
    if (IN(10)) {
#if FAST_GEMM
        pg8::Gemm g{XN, Win1t, MTOK, NP1, DM}; pg8::StaticOrder S; S.init(MTOK, NP1, G, bx);
        pg8::EpiAct<1> E{PB, NP1, LBV};
        pg8::gemm_phase<pg8::EpiAct<1>, pg8::StaticOrder, true, true>(lds + RING_OFF, g, S, E);
#else
        naive_gemm(XN, Win1t, MTOK, NP1, DM, NEpiAct{PB, NP1, 1, LBV}, gtid, gthreads);
#endif
    }
    SEAM(10);
    SEAM(11);
    if (IN(12)) { for (int blk = bx; blk < 8; blk += G) naive_hgrn_block(blk, PB, args.in[I_HNW], MIX, lds, tid); }
    SEAM(12);
    if (IN(13)) {
#if FAST_GEMM
        pg8::Gemm g{MIX, Wout1t, MTOK, DM, DM}; pg8::StaticOrder S; S.init(MTOK, DM, G, bx);
        pg8::EpiResid E{xres, xres, DM};
        pg8::gemm_phase<pg8::EpiResid, pg8::StaticOrder, true, true>(lds + RING_OFF, g, S, E);
#else
        naive_gemm(MIX, Wout1t, MTOK, DM, DM, NEpiResid{xres, xres, DM}, gtid, gthreads);
#endif
        cvt_items(args.in[I_PU] + (size_t)NEXP * DM, TABU, (size_t)NEXP * DM, gw, NGW, lane);
        cvt_items(args.in[I_PV] + (size_t)NEXP * DM, TABV, (size_t)NEXP * DM, gw, NGW, lane);
    }
    SEAM(13);
    if (IN(14)) rms_rows(xres, args.in[I_NFFN] + DM, XN, nullptr, gw, NGW, lane);
    SEAM(14);
    if (IN(15)) {
#if FAST_GEMM
        pg8::Gemm g{XN, Wqt + (size_t)NQP * DM, MTOK, NQP, DM}; pg8::StaticOrder S; S.init(MTOK, NQP, G, bx);
        pg8::EpiAct<2> E{PB, NQP, nullptr};
        pg8::gemm_phase<pg8::EpiAct<2>, pg8::StaticOrder, true, true>(lds + RING_OFF, g, S, E);
#else
        naive_gemm(XN, Wqt + (size_t)NQP * DM, MTOK, NQP, DM, NEpiAct{PB, NQP, 2, nullptr}, gtid, gthreads);
#endif
    }
    SEAM(15);
    if (IN(16)) { for (int wu = gw; wu < MTOK * 8; wu += NGW) naive_peer_select_wave(wu, PB, KEYS + (size_t)8 * 2 * 128 * 128, EXPB, GATEB, lds + wave * 2048, lane); }
    SEAM(16);
    if (IN(17)) { for (int tok = gw; tok < MTOK; tok += NGW) naive_peer_eval_wave(tok, XN, TABU, TABV, EXPB, GATEB, xres, nullptr, args.in[I_FNORM], lane); }
#undef IN
#undef SEAM
}

extern "C" void kernel_launch(void* const* d_in, const int* in_sizes, int n_in, void* d_out, int out_size, void* d_ws, size_t ws_size, hipStream_t stream) {
    static int grid = 0;
    if (grid == 0) {
        if (n_in != 22 || in_sizes[0] != MTOK * DM || out_size != MTOK * DM || ws_size < WS_END) { fprintf(stderr, "kernel_launch: unexpected shapes / workspace (n_in %d, ws %zu); nothing launched\n", n_in, ws_size); grid = -1; return; }
        int dev = 0, cus = 0, per_cu = 0;
        if (hipGetDevice(&dev) != hipSuccess || hipDeviceGetAttribute(&cus, hipDeviceAttributeMultiprocessorCount, dev) != hipSuccess) { grid = -1; return; }
        if (hipFuncSetAttribute((const void*)fwd_kernel, hipFuncAttributeMaxDynamicSharedMemorySize, LDS_BYTES) != hipSuccess) { fprintf(stderr, "kernel_launch: hipFuncSetAttribute failed\n"); grid = -1; return; }
        if (hipOccupancyMaxActiveBlocksPerMultiprocessor(&per_cu, (const void*)fwd_kernel, NTHR, LDS_BYTES) != hipSuccess || per_cu < 1) { fprintf(stderr, "kernel_launch: occupancy query reports %d workgroups per CU; nothing launched\n", per_cu); (void)hipGetLastError(); grid = -1; return; }
        grid = cus;
    }
    if (grid < 0) return;
    (void)hipMemsetAsync((char*)d_ws + WS_CTL, 0, CTL_ZERO_BYTES, stream);
    Args a{};
    for (int i = 0; i < 22; ++i) a.in[i] = (const float*)d_in[i];
    a.out = (float*)d_out; a.ws = (unsigned char*)d_ws;
    for (int li = 0; li < MK_N_LAUNCHES; ++li) {
        if (MK_N_LAUNCHES == 1) { a.ph_lo = 0; a.ph_hi = N_PHASES; } else { a.ph_lo = li; a.ph_hi = li + 1; }
        a.li = li;
        hipLaunchKernelGGL(fwd_kernel, dim3(grid), dim3(NTHR), LDS_BYTES, stream, a);
    }
}
```

```cpp
#include <hip/hip_runtime.h>
#include <cstdio>
#include <cstdint>
#ifndef GEMM_XCD2D
#define GEMM_XCD2D 0
#endif
namespace pg8 {
#define PG8_LAS __attribute__((address_space(3)))
typedef unsigned short bf16_t;
typedef short bf16x8 __attribute__((ext_vector_type(8)));
typedef float f32x4 __attribute__((ext_vector_type(4)));
typedef unsigned u32x4 __attribute__((ext_vector_type(4)));
constexpr int BM = 256, BK = 64, HALF = 128, HTB = HALF * BK * 2  , STAGE_BYTES = 8 * HTB, NXCD = 8, WGM = 1;

__host__ __device__ __forceinline__ int lds_byte(int r, int c) { const int st = (r >> 4) * 2 + (c >> 5), rr = r & 15, cc = c & 31, ob = rr * 64 + cc * 2; return st * 1024 + (ob ^ (((ob >> 9) & 1) << 5)); }
__host__ __device__ __forceinline__ void stage_rc(int b, int& R, int& C) { const int st = b / 1024, sb = b % 1024, swz = sb ^ (((sb >> 9) & 1) << 5); R = (st >> 1) * 16 + swz / 64; C = (st & 1) * 32 + (swz % 64) / 2; }
__host__ __device__ __forceinline__ int perm32(int rho) { const int n = rho >> 4, i = rho & 15; return 8 * (i >> 2) + 4 * n + (i & 3); }

struct Unit { int pm, pn; };
struct Gemm { const bf16_t* A; const bf16_t* Bt; int M, N, K; };

struct StaticOrder {
    int nM, nN, nwg, G, c;
    __host__ __device__ void init(int M, int N, int G_, int c_) { nM = M / BM; nN = N / BM; nwg = nM * nN; G = G_; c = c_; }
    __host__ __device__ bool next(int i, Unit& u) const {
        const long L = (long)i * G + c; if (L >= nwg) return false;
#if GEMM_XCD2D
        {
            const int CPX = (nN % 5 == 0) ? 5 : 4, ncg = nN / CPX;
            if (nN % CPX == 0 && ncg >= 1 && ncg <= NXCD && NXCD % ncg == 0 && nM % (NXCD / ncg) == 0 && nwg % NXCD == 0) {
                const int nrg = NXCD / ncg, xcd = (int)(L % NXCD), off = (int)(L / NXCD), cg = xcd % ncg, rg = xcd / ncg;
                u.pm = rg * (nM / nrg) + off / CPX; u.pn = cg * CPX + off % CPX; return true;
            }
        }
#endif
        int wgid = (int)L; { const int q = nwg / NXCD, r = nwg % NXCD, xcd = wgid % NXCD, off = wgid / NXCD; wgid = (xcd < r ? xcd * (q + 1) : r * (q + 1) + (xcd - r) * q) + off; }
        const int nig = WGM * nN, gid = wgid / nig, fm = gid * WGM, gsz = (nM - fm) < WGM ? (nM - fm) : WGM;
        u.pm = fm + ((wgid % nig) % gsz); u.pn = (wgid % nig) / gsz; return true;
    }
    __device__ __forceinline__ void a_ready(const Unit&) const {}
    __device__ __forceinline__ void done(const Unit&) const {}
};
__device__ __forceinline__ unsigned cvt_pk_bf16(float lo, float hi) { unsigned r; asm volatile("v_cvt_pk_bf16_f32 %0, %1, %2" : "=v"(r) : "v"(lo), "v"(hi)); return r; }
typedef float f32x2 __attribute__((ext_vector_type(2)));
__device__ __forceinline__ f32x2 gelu_pk(f32x2 v) {
    const f32x2 av = __builtin_elementwise_abs(v), d = av * 0.2316418882f + 1.0f;
    f32x2 t; t.x = __builtin_amdgcn_rcpf(d.x); t.y = __builtin_amdgcn_rcpf(d.y);
    f32x2 q = t * 0.5307027145f + (-0.7265760135f); q = q * t + 0.7107068705f; q = q * t + (-0.142248368f); q = q * t + 0.127414796f; q = q * t;
    const f32x2 s = (v * v) * (-0.72134752044f);
    f32x2 e; e.x = __builtin_amdgcn_exp2f(s.x); e.y = __builtin_amdgcn_exp2f(s.y);
    const f32x2 m = v * (q * e), r = v - m;
    f32x2 o; o.x = v.x < 0.f ? m.x : r.x; o.y = v.y < 0.f ? m.y : r.y; return o;
}

__device__ __forceinline__ float sigmoidf_(float x) { return __builtin_amdgcn_rcpf(1.0f + __builtin_amdgcn_exp2f(-1.4426950408889634f * x)); }
__device__ __forceinline__ float siluf_(float x) { return x * __builtin_amdgcn_rcpf(1.0f + __builtin_amdgcn_exp2f(-1.4426950408889634f * x)); }
__device__ __forceinline__ float gelu_tanh(float x) {
    const float x2 = x * x;
    const float t = x * __builtin_fmaf(x2, -2.0f * 1.4426950408889634f * 0.7978845608028654f * 0.044715f, -2.0f * 1.4426950408889634f * 0.7978845608028654f);
    return x * __builtin_amdgcn_rcpf(1.0f + __builtin_amdgcn_exp2f(t));
}
__device__ __forceinline__ unsigned short f2h_bits(float x) { _Float16 h = (_Float16)x; return __builtin_bit_cast(unsigned short, h); }
__device__ __forceinline__ float h2f_bits(unsigned short b) { _Float16 h = __builtin_bit_cast(_Float16, b); return (float)h; }
__device__ __forceinline__ unsigned short f2bf_rne(float f) { unsigned u = __builtin_bit_cast(unsigned, f); return (unsigned short)((u + 0x7fffu + ((u >> 16) & 1u)) >> 16); }
enum { AK_ID = 0, AK_GELU = 1, AK_SCALE8 = 2, AK_SIGMOID = 3, AK_SILU = 4, AK_KK = 5 };
__device__ __forceinline__ int kind_p0(int col) { return col < 1024 ? AK_GELU : col < 1536 ? AK_SCALE8 : col < 2304 ? AK_ID : AK_SIGMOID; }
__device__ __forceinline__ int kind_p1(int col) { return col < 1024 ? AK_SILU : col < 2048 ? AK_KK : col < 3072 ? AK_ID : AK_SILU; }
__device__ __forceinline__ float act_val(int kind, float v, float lbv) {
    switch (kind) {
        case AK_GELU: return gelu_tanh(v);
        case AK_SCALE8: return v * (0.125f * 1.4426950408889634f);
        case AK_SIGMOID: return sigmoidf_(v);
        case AK_SILU: return siluf_(v);
        case AK_KK: return (1.0f - lbv) * sigmoidf_(-v);
        default: return v;
    }
}
typedef __bf16 ebf16x2 __attribute__((ext_vector_type(2)));
typedef _Float16 ef16x2 __attribute__((ext_vector_type(2)));
__device__ __forceinline__ unsigned act_pack2(int kind, float a, float b, float lba, float lbb) {
    const float x = act_val(kind, a, lba), y = act_val(kind, b, lbb);
    if (kind == AK_KK) { ef16x2 h; h[0] = (_Float16)x; h[1] = (_Float16)y; return __builtin_bit_cast(unsigned, h); }
    ebf16x2 r; r[0] = (__bf16)x; r[1] = (__bf16)y; return __builtin_bit_cast(unsigned, r);
}
__device__ __forceinline__ unsigned short act_store(int kind, float v, float lbv) { return (unsigned short)(act_pack2(kind, v, v, lbv, lbv) & 0xffffu); }
#ifndef GEMM_WT_STORES
#define GEMM_WT_STORES 0
#endif
__device__ __forceinline__ void store16_wt(void* ptr, u32x4 v) {
#if GEMM_WT_STORES
    asm volatile("global_store_dwordx4 %0, %1, off sc1\n\ts_nop 1" :: "v"(ptr), "v"(v) : "memory");
#else
    *(u32x4*)ptr = v;
#endif
}
template <int WHICH> struct EpiAct {
    static constexpr bool PERM = true, AFTER_DRAIN = false;
    bf16_t* O; int ldc; const float* lb;
    __device__ __forceinline__ void operator()(const f32x4 (&acc)[2][2][4][2], const Unit& u, int wr, int wc, int fr, int fq) const {
        const int row0 = u.pm * BM + wr * 64 + fr; const int colt = u.pn * BM;
        const int kind = WHICH == 0 ? kind_p0(colt) : WHICH == 1 ? kind_p1(colt) : AK_ID;
        const int col0 = colt + wc * 32 + 8 * fq;
#pragma unroll
        for (int bj = 0; bj < 2; ++bj) {
            float lbv[8];
#pragma unroll
            for (int e = 0; e < 8; ++e) lbv[e] = (WHICH == 1 && kind == AK_KK) ? lb[col0 + bj * HALF + e - 1024] : 0.f;
#pragma unroll
            for (int ai = 0; ai < 2; ++ai)
#pragma unroll
                for (int m = 0; m < 4; ++m) {
                    const f32x4 v0 = acc[ai][bj][m][0], v1 = acc[ai][bj][m][1];
                    u32x4 w;
                    w.x = act_pack2(kind, v0[0], v0[1], lbv[0], lbv[1]);
                    w.y = act_pack2(kind, v0[2], v0[3], lbv[2], lbv[3]);
                    w.z = act_pack2(kind, v1[0], v1[1], lbv[4], lbv[5]);
                    w.w = act_pack2(kind, v1[2], v1[3], lbv[6], lbv[7]);
                    store16_wt(O + (size_t)(row0 + ai * HALF + m * 16) * ldc + col0 + bj * HALF, w);
                }
        }
    }
};
struct EpiResid {
    static constexpr bool PERM = false, AFTER_DRAIN = false;
    const float* base; float* out; int ldc;
    __device__ __forceinline__ void operator()(const f32x4 (&acc)[2][2][4][2], const Unit& u, int wr, int wc, int fr, int fq) const {
        const int row0 = u.pm * BM + wr * 64 + fr; const int col0 = u.pn * BM + wc * 32 + 4 * fq;
#pragma unroll
        for (int ai = 0; ai < 2; ++ai)
#pragma unroll
            for (int m = 0; m < 4; ++m) { const size_t off = (size_t)(row0 + ai * HALF + m * 16) * ldc + col0;
#pragma unroll
                for (int bj = 0; bj < 2; ++bj)
#pragma unroll
                    for (int n = 0; n < 2; ++n) { const f32x4 b = *(const f32x4*)(base + off + bj * HALF + n * 16); *(f32x4*)(out + off + bj * HALF + n * 16) = b + acc[ai][bj][m][n]; } }
    }
};
struct EpiResidNorm {
    static constexpr bool PERM = false, AFTER_DRAIN = false;
    const float* base; float* out; bf16_t* xb; float* rs; int ldc;
    __device__ __forceinline__ void operator()(const f32x4 (&acc)[2][2][4][2], const Unit& u, int wr, int wc, int fr, int fq) const {
        const int row0 = u.pm * BM + wr * 64 + fr; const int col0 = u.pn * BM + wc * 32 + 4 * fq;
#pragma unroll
        for (int ai = 0; ai < 2; ++ai)
#pragma unroll
            for (int m = 0; m < 4; ++m) { const int row = row0 + ai * HALF + m * 16; const size_t off = (size_t)row * ldc + col0; float ss = 0.f;
#pragma unroll
                for (int bj = 0; bj < 2; ++bj)
#pragma unroll
                    for (int n = 0; n < 2; ++n) { const f32x4 b = *(const f32x4*)(base + off + bj * HALF + n * 16); const f32x4 o = b + acc[ai][bj][m][n]; *(f32x4*)(out + off + bj * HALF + n * 16) = o;
                        ss += (o[0] * o[0] + o[1] * o[1]) + (o[2] * o[2] + o[3] * o[3]);
                        ebf16x2 p0, p1; p0[0] = (__bf16)o[0]; p0[1] = (__bf16)o[1]; p1[0] = (__bf16)o[2]; p1[1] = (__bf16)o[3];
                        typedef unsigned eu32x2 __attribute__((ext_vector_type(2))); eu32x2 w; w.x = __builtin_bit_cast(unsigned, p0); w.y = __builtin_bit_cast(unsigned, p1);
                        *(eu32x2*)(xb + off + bj * HALF + n * 16) = w; }
                { auto s1 = __builtin_amdgcn_permlane16_swap(__builtin_bit_cast(unsigned, ss), __builtin_bit_cast(unsigned, ss), false, false); const unsigned a_ = s1[0], b_ = s1[1]; ss = __builtin_bit_cast(float, a_) + __builtin_bit_cast(float, b_); }
                { auto s2 = __builtin_amdgcn_permlane32_swap(__builtin_bit_cast(unsigned, ss), __builtin_bit_cast(unsigned, ss), false, false); const unsigned a_ = s2[0], b_ = s2[1]; ss = __builtin_bit_cast(float, a_) + __builtin_bit_cast(float, b_); }
                if (fq == 0) rs[(size_t)row * 16 + u.pn * 4 + wc] = ss; }
    }
};
struct EpiRowScale {
    static constexpr bool PERM = true, AFTER_DRAIN = false;
    bf16_t* O; int ldc; const float* rs; float inv_n, eps;
    __device__ __forceinline__ void operator()(const f32x4 (&acc)[2][2][4][2], const Unit& u, int wr, int wc, int fr, int fq) const {
        const int row0 = u.pm * BM + wr * 64 + fr; const int col0 = u.pn * BM + wc * 32 + 8 * fq;
#pragma unroll
        for (int ai = 0; ai < 2; ++ai)
#pragma unroll
            for (int m = 0; m < 4; ++m) { const int row = row0 + ai * HALF + m * 16; const f32x4* rp = (const f32x4*)(rs + (size_t)row * 16); const f32x4 t0 = rp[0], t1 = rp[1], t2 = rp[2], t3 = rp[3];
                const float tot = (((t0[0] + t0[1]) + (t0[2] + t0[3])) + ((t1[0] + t1[1]) + (t1[2] + t1[3]))) + (((t2[0] + t2[1]) + (t2[2] + t2[3])) + ((t3[0] + t3[1]) + (t3[2] + t3[3])));
                const float r = 1.0f / __builtin_sqrtf(tot * inv_n + eps);
#pragma unroll
                for (int bj = 0; bj < 2; ++bj) { const f32x4 v0 = acc[ai][bj][m][0] * r, v1 = acc[ai][bj][m][1] * r; u32x4 w;
                    w.x = act_pack2(AK_ID, v0[0], v0[1], 0.f, 0.f); w.y = act_pack2(AK_ID, v0[2], v0[3], 0.f, 0.f); w.z = act_pack2(AK_ID, v1[0], v1[1], 0.f, 0.f); w.w = act_pack2(AK_ID, v1[2], v1[3], 0.f, 0.f);
                    *(u32x4*)(O + (size_t)row * ldc + col0 + bj * HALF) = w; } }
    }
};
template <bool BASE_BF> struct EpiResidBf {
    static constexpr bool PERM = true, AFTER_DRAIN = false;
    const void* base; bf16_t* out; int ldc;
    __device__ __forceinline__ void operator()(const f32x4 (&acc)[2][2][4][2], const Unit& u, int wr, int wc, int fr, int fq) const {
        const int row0 = u.pm * BM + wr * 64 + fr; const int col0 = u.pn * BM + wc * 32 + 8 * fq;
#pragma unroll
        for (int ai = 0; ai < 2; ++ai)
#pragma unroll
            for (int m = 0; m < 4; ++m) { const size_t off = (size_t)(row0 + ai * HALF + m * 16) * ldc + col0;
#pragma unroll
                for (int bj = 0; bj < 2; ++bj) { f32x4 b0, b1;
                    if (BASE_BF) { const u32x4 w = *(const u32x4*)((const bf16_t*)base + off + bj * HALF);
                        b0[0] = __builtin_bit_cast(float, w.x << 16); b0[1] = __builtin_bit_cast(float, w.x & 0xffff0000u); b0[2] = __builtin_bit_cast(float, w.y << 16); b0[3] = __builtin_bit_cast(float, w.y & 0xffff0000u);
                        b1[0] = __builtin_bit_cast(float, w.z << 16); b1[1] = __builtin_bit_cast(float, w.z & 0xffff0000u); b1[2] = __builtin_bit_cast(float, w.w << 16); b1[3] = __builtin_bit_cast(float, w.w & 0xffff0000u); }
                    else { const f32x4* bp = (const f32x4*)((const float*)base + off + bj * HALF); b0 = bp[0]; b1 = bp[1]; }
                    const f32x4 o0 = b0 + acc[ai][bj][m][0], o1 = b1 + acc[ai][bj][m][1];
                    u32x4 w2; w2.x = act_pack2(AK_ID, o0[0], o0[1], 0.f, 0.f); w2.y = act_pack2(AK_ID, o0[2], o0[3], 0.f, 0.f); w2.z = act_pack2(AK_ID, o1[0], o1[1], 0.f, 0.f); w2.w = act_pack2(AK_ID, o1[2], o1[3], 0.f, 0.f);
                    store16_wt(out + off + bj * HALF, w2); } }
    }
};
template <class Epi, class Sched, bool ALIGN_EPI = false, bool SP2 = false>
__device__ __forceinline__ void gemm_phase(PG8_LAS unsigned char* lds, const Gemm g, const Sched& S, const Epi& E) {
    int tid_o_ = threadIdx.x; asm volatile("" : "+v"(tid_o_));
    const int tid = tid_o_, wid = __builtin_amdgcn_readfirstlane(tid >> 6), lane = tid & 63, wr = wid >> 2, wc = wid & 3, fr = lane & 15, fq = lane >> 4;
    const int K = g.K, nt = K / BK;
    unsigned voffA[2], voffB[2];
#pragma unroll
    for (int i = 0; i < 2; ++i) { int R, C; stage_rc(tid * 16 + i * 8192, R, C); const int Rb = Epi::PERM ? ((R & ~31) + perm32(R & 31)) : R;
        voffA[i] = (unsigned)(R * K + C) * 2u; voffB[i] = (unsigned)(Rb * K + C) * 2u; }
    const size_t kstep = (size_t)(BK * 2);
    const size_t hstep = (size_t)HALF * K * 2;
    const size_t tstep = 2 * hstep;
    const unsigned ldsw = (unsigned)wid * 1024u;
    const int aoff = lds_byte(wr * 64 + fr, fq * 8), boff = lds_byte(wc * 32 + fr, fq * 8);
#define PG8_SA(b, h) (((b) * 2 + (h)) * HTB)
#define PG8_SB(b, h) ((4 + (b) * 2 + (h)) * HTB)
#define PG8_STAGE(bufoff, gbase, voff) do { _Pragma("unroll") for (int _i = 0; _i < 2; ++_i) \
        __builtin_amdgcn_global_load_lds((const unsigned*)((const char*)(gbase) + (voff)[_i]), (PG8_LAS unsigned*)(lds + (bufoff) + ldsw + _i * 8192), 16, 0, 0); } while (0)
#define PG8_LDA(dst, b, h) do { _Pragma("unroll") for (int m = 0; m < 4; ++m) _Pragma("unroll") for (int k = 0; k < 2; ++k) dst[m][k] = *(const PG8_LAS bf16x8*)(lds + PG8_SA(b, h) + aoff + m * 2048 + k * 1024); } while (0)
#define PG8_LDB(dst, b, h) do { _Pragma("unroll") for (int n = 0; n < 2; ++n) _Pragma("unroll") for (int k = 0; k < 2; ++k) dst[n][k] = *(const PG8_LAS bf16x8*)(lds + PG8_SB(b, h) + boff + n * 2048 + k * 1024); } while (0)
#define PG8_MMA(ai, bj, At, Bt) do { __builtin_amdgcn_s_setprio(1); _Pragma("unroll") for (int m = 0; m < 4; ++m) _Pragma("unroll") for (int n = 0; n < 2; ++n) _Pragma("unroll") for (int k = 0; k < 2; ++k) \
        acc[ai][bj][m][n] = __builtin_amdgcn_mfma_f32_16x16x32_bf16(Bt[n][k], At[m][k], acc[ai][bj][m][n], 0, 0, 0); __builtin_amdgcn_s_setprio(0); } while (0)
#define PG8_WAIT_V(n) asm volatile("s_waitcnt vmcnt(" #n ")" ::: "memory")
#define PG8_WAIT_L(n) asm volatile("s_waitcnt lgkmcnt(" #n ")" ::: "memory")
#define PG8_BAR __builtin_amdgcn_s_barrier()
#define PG8_SCHED __builtin_amdgcn_sched_barrier(0)
    Unit cur, nxt; int ui = 0;
    if (!S.next(0, cur)) return;
    f32x4 acc[2][2][4][2];
#pragma unroll
    for (int a = 0; a < 2; ++a)
#pragma unroll
        for (int b = 0; b < 2; ++b)
#pragma unroll
            for (int m = 0; m < 4; ++m)
#pragma unroll
                for (int n = 0; n < 2; ++n) acc[a][b][m][n] = (f32x4){0.f, 0.f, 0.f, 0.f};
    bf16x8 At[4][2], B0[2][2], B1[2][2];
    const char* cA = (const char*)g.A + (size_t)cur.pm * tstep; const char* cB = (const char*)g.Bt + (size_t)cur.pn * tstep;
    S.a_ready(cur);
    if constexpr (SP2) {
        PG8_STAGE(PG8_SB(0, 0), cB, voffB); PG8_STAGE(PG8_SB(0, 1), cB + hstep, voffB); PG8_STAGE(PG8_SA(0, 0), cA, voffA); PG8_STAGE(PG8_SA(0, 1), cA + hstep, voffA);
        if (wr == 1) PG8_BAR;
        PG8_WAIT_V(2); PG8_BAR;
        PG8_STAGE(PG8_SB(1, 0), cB + kstep, voffB); PG8_STAGE(PG8_SA(1, 0), cA + kstep, voffA); PG8_STAGE(PG8_SB(1, 1), cB + hstep + kstep, voffB);
        PG8_WAIT_V(6); PG8_BAR;
    } else {
        PG8_STAGE(PG8_SB(0, 0), cB, voffB); PG8_STAGE(PG8_SA(0, 0), cA, voffA); PG8_STAGE(PG8_SB(0, 1), cB + hstep, voffB); PG8_STAGE(PG8_SA(0, 1), cA + hstep, voffA);
        if (wr == 1) PG8_BAR;
        PG8_WAIT_V(4); PG8_BAR;
        PG8_STAGE(PG8_SB(1, 0), cB + kstep, voffB); PG8_STAGE(PG8_SA(1, 0), cA + kstep, voffA); PG8_STAGE(PG8_SB(1, 1), cB + hstep + kstep, voffB);
        PG8_WAIT_V(6); PG8_BAR;
    }
    for (;;) {
        const bool has_next = S.next(ui + 1, nxt);
        const char* nA = has_next ? (const char*)g.A + (size_t)nxt.pm * tstep : cA; const char* nB = has_next ? (const char*)g.Bt + (size_t)nxt.pn * tstep : cB;
        for (int t = 0; t < nt; t += 2) {
            const bool last = (t == nt - 2);
            const char* a1 = cA + (size_t)(t + 1) * kstep;
            const char* a2 = last ? nA : cA + (size_t)(t + 2) * kstep; const char* b2 = last ? nB : cB + (size_t)(t + 2) * kstep;
            const char* a3 = a2 + kstep; const char* b3 = b2 + kstep;
            if (last && has_next) S.a_ready(nxt);
            if constexpr (SP2) {
            PG8_LDB(B0, 0, 0); PG8_LDB(B1, 0, 1); PG8_SCHED; PG8_LDA(At, 0, 0); PG8_STAGE(PG8_SA(1, 1), a1 + hstep, voffA);
            PG8_WAIT_V(8); PG8_WAIT_L(0); PG8_BAR; PG8_MMA(0, 0, At, B0); PG8_MMA(0, 1, At, B1); PG8_BAR; PG8_SCHED;
            PG8_LDA(At, 0, 1); PG8_STAGE(PG8_SB(0, 0), b2, voffB); PG8_STAGE(PG8_SB(0, 1), b2 + hstep, voffB); PG8_STAGE(PG8_SA(0, 0), a2, voffA);
            PG8_WAIT_V(8); PG8_WAIT_L(0); PG8_BAR; PG8_MMA(1, 0, At, B0); PG8_MMA(1, 1, At, B1); PG8_BAR; PG8_SCHED;
            PG8_LDB(B0, 1, 0); PG8_LDB(B1, 1, 1); PG8_SCHED; PG8_LDA(At, 1, 0); PG8_STAGE(PG8_SA(0, 1), a2 + hstep, voffA);
            PG8_WAIT_V(8); PG8_WAIT_L(0); PG8_BAR; PG8_MMA(0, 0, At, B0); PG8_MMA(0, 1, At, B1); PG8_BAR; PG8_SCHED;
            PG8_LDA(At, 1, 1); PG8_STAGE(PG8_SB(1, 0), b3, voffB); PG8_STAGE(PG8_SB(1, 1), b3 + hstep, voffB); PG8_STAGE(PG8_SA(1, 0), a3, voffA);
            PG8_WAIT_V(8); PG8_WAIT_L(0); PG8_BAR; PG8_MMA(1, 0, At, B0); PG8_MMA(1, 1, At, B1); PG8_BAR; PG8_SCHED;
            } else {
            PG8_LDB(B0, 0, 0); PG8_SCHED; PG8_LDA(At, 0, 0); PG8_STAGE(PG8_SA(1, 1), a1 + hstep, voffA);
            PG8_WAIT_L(8); PG8_BAR; PG8_WAIT_L(0); PG8_MMA(0, 0, At, B0); PG8_BAR; PG8_SCHED;
            PG8_LDB(B1, 0, 1); PG8_STAGE(PG8_SB(0, 0), b2, voffB);
            PG8_BAR; PG8_WAIT_L(0); PG8_MMA(0, 1, At, B1); PG8_BAR;
            PG8_LDA(At, 0, 1); PG8_STAGE(PG8_SA(0, 0), a2, voffA);
            PG8_BAR; PG8_WAIT_L(0); PG8_MMA(1, 0, At, B0); PG8_BAR; PG8_SCHED;
            PG8_STAGE(PG8_SB(0, 1), b2 + hstep, voffB);
            PG8_WAIT_V(6); PG8_BAR; PG8_MMA(1, 1, At, B1); PG8_BAR;
            PG8_LDB(B0, 1, 0); PG8_SCHED; PG8_LDA(At, 1, 0); PG8_STAGE(PG8_SA(0, 1), a2 + hstep, voffA);
            PG8_WAIT_L(8); PG8_BAR; PG8_WAIT_L(0); PG8_MMA(0, 0, At, B0); PG8_BAR; PG8_SCHED;
            PG8_LDB(B1, 1, 1); PG8_STAGE(PG8_SB(1, 0), b3, voffB);
            PG8_BAR; PG8_WAIT_L(0); PG8_MMA(0, 1, At, B1); PG8_BAR;
            PG8_LDA(At, 1, 1); PG8_STAGE(PG8_SA(1, 0), a3, voffA);
            PG8_BAR; PG8_WAIT_L(0); PG8_MMA(1, 0, At, B0); PG8_BAR; PG8_SCHED;
            PG8_STAGE(PG8_SB(1, 1), b3 + hstep, voffB);
            PG8_WAIT_V(6); PG8_BAR; PG8_MMA(1, 1, At, B1); PG8_BAR;
            }
        }
        if constexpr (ALIGN_EPI) { if (wr == 0) PG8_BAR; }
        if constexpr (!Epi::AFTER_DRAIN) { E(acc, cur, wr, wc, fr, fq); S.done(cur); }
        if (!has_next) break;
#pragma unroll
        for (int a = 0; a < 2; ++a)
#pragma unroll
            for (int b = 0; b < 2; ++b)
#pragma unroll
                for (int m = 0; m < 4; ++m)
#pragma unroll
                    for (int n = 0; n < 2; ++n) acc[a][b][m][n] = (f32x4){0.f, 0.f, 0.f, 0.f};
        cur = nxt; cA = nA; cB = nB; ++ui;
        if constexpr (ALIGN_EPI) { if (wr == 1) PG8_BAR; }
    }
    PG8_WAIT_V(0);
    if constexpr (!ALIGN_EPI) { if (wr == 0) PG8_BAR; }
    PG8_BAR;
    if constexpr (Epi::AFTER_DRAIN) { E.fused(acc, cur, wr, wc, fr, fq, lds, wid, lane); S.done(cur); }
#undef PG8_SA
#undef PG8_SB
#undef PG8_STAGE
#undef PG8_LDA
#undef PG8_LDB
#undef PG8_MMA
#undef PG8_WAIT_V
#undef PG8_WAIT_L
#undef PG8_BAR
#undef PG8_SCHED
}
}
constexpr int NWAVES = 8, NTHR = 512;
constexpr int BATCH = 4, SEQ = 8192, DM = 1024, MTOK = BATCH * SEQ;
constexpr int NP0 = 2560, NP0_REAL = 2328, NP1 = 4096, NQP = 2048;
constexpr int C_U = 0, C_V = 512, C_Q = 1024, C_KC = 1536, C_VC = 1664, C_KS = 1792, C_VS = 1920, C_KW = 2048, C_VW = 2176, C_GT = 2304;
constexpr int NCMP = 511, NCMP_PAD = 512;
constexpr int NEXP = 16384;
constexpr float EPS = 1e-6f;
#ifndef MK_N_LAUNCHES
#define MK_N_LAUNCHES 1
#endif
#ifndef FAST_GEMM
#define FAST_GEMM 1
#endif
#ifndef FAST_PEVAL
#define FAST_PEVAL 1
#endif
#ifndef PEER_SORT
#define PEER_SORT 1
#endif
#ifndef NSA_FENCES
#define NSA_FENCES 1
#endif
#ifndef NSA_DMA
#define NSA_DMA 0
#endif
#ifndef NSA_DMA_WIN
#define NSA_DMA_WIN 1
#endif
#ifndef NSA_DMA_SLC
#define NSA_DMA_SLC 0
#endif
#ifndef NSA_PIPE_SLC
#define NSA_PIPE_SLC 1
#endif
#ifndef NSA_PIPE_WIN
#define NSA_PIPE_WIN 1
#endif
#ifndef NSA_PIPE
#define NSA_PIPE 1
#endif
#ifndef P2_C32
#define P2_C32 1
#endif
#ifndef P2_PIPE
#define P2_PIPE 1
#endif
#ifndef P2_NC
#define P2_NC 2
#endif
#ifndef TAB1_IN_P7
#define TAB1_IN_P7 0
#endif
#ifndef GEMM_ALIGN_RES
#define GEMM_ALIGN_RES true
#endif
#ifndef GEMM_ALIGN_ACT
#define GEMM_ALIGN_ACT true
#endif
#ifndef PEER_CHUNK
#define PEER_CHUNK 0
#endif
#ifndef PEER_EVAL4
#define PEER_EVAL4 1
#endif
#ifndef FAST_PSEL
#define FAST_PSEL 1
#endif
#ifndef FAST_P2
#define FAST_P2 1
#endif
#ifndef FAST_NSA
#define FAST_NSA 1
#endif
#ifndef FAST_HGRN
#define FAST_HGRN 1
#endif
constexpr int N_PHASES = 18;
#ifndef RESID_BF16
#define RESID_BF16 1
#endif
#ifndef FUSE_NORM
#define FUSE_NORM 0
#endif
constexpr size_t MiB = 1u << 20;
constexpr size_t WS_CTL = 0, CTL_ZERO_BYTES = 64 * 1024;
constexpr size_t WS_WIN0 = 1 * MiB, WS_WOUT0 = 6 * MiB, WS_WIN1 = 8 * MiB, WS_WOUT1 = 16 * MiB, WS_WQ = 18 * MiB  , WS_KEYS = 26 * MiB  ;
constexpr size_t WS_CW1 = 27 * MiB  ;
constexpr size_t WS_CW2 = 28 * MiB  , WS_WSTRIL = 28 * MiB + 64 * 1024  ;
constexpr size_t WS_BIAS1 = 28 * MiB + 256 * 1024  , WS_LB = 28 * MiB + 260 * 1024  ;
constexpr size_t WS_KCMP = 29 * MiB, WS_VCMP = 29 * MiB + 512 * 1024;
constexpr size_t WS_XN = 32 * MiB;
constexpr size_t WS_MIX = 96 * MiB;
constexpr size_t WS_TAB8 = 160 * MiB;
constexpr size_t WS_RS = 30 * MiB + 512 * 1024;
constexpr size_t WS_SCL = 30 * MiB;
constexpr size_t WS_EXP = 224 * MiB, WS_GATE = 240 * MiB;
constexpr size_t WS_P = 256 * MiB;
constexpr size_t WS_END = 512 * MiB;
constexpr int CW_BAR = 1024;
constexpr int RING_OFF = 0, RING_BYTES = 131072;
constexpr int LDSCTL_OFF = 143360, MISC_OFF = LDSCTL_OFF + 320;
constexpr int LDS_BYTES = 147456;
#define GAS __attribute__((address_space(1)))
#define LAS __attribute__((address_space(3)))
typedef unsigned short bf16;
typedef unsigned v4u __attribute__((ext_vector_type(4)));
typedef float f32x4 __attribute__((ext_vector_type(4)));
typedef short bf16x8 __attribute__((ext_vector_type(8)));
typedef GAS unsigned gu32;
typedef GAS unsigned long long gu64;
#define RLX_AGENT __ATOMIC_RELAXED, __HIP_MEMORY_SCOPE_AGENT
#define LDS_WAIT() asm volatile("s_waitcnt lgkmcnt(0)" ::: "memory")
#define VM_WAIT() asm volatile("s_waitcnt vmcnt(0)" ::: "memory")
__device__ __forceinline__ unsigned long long rt() { return __builtin_amdgcn_s_memrealtime(); }
__device__ __forceinline__ unsigned f2bf(float f) { unsigned u = __builtin_bit_cast(unsigned, f); return (u + 0x7fffu + ((u >> 16) & 1u)) >> 16; }
__device__ __forceinline__ unsigned pk2(float lo, float hi) { return f2bf(lo) | (f2bf(hi) << 16); }
#define XB_TMO      128
#define XB_XCNT(j)  (256  + 64 * (j))
#define XB_XSUB(j)  (1280 + 64 * (j))
#define XB_XGEN(j)  (2304 + 64 * (j))
#define XB_TOP      3328
#define XB_TOPGEN   3392
#define XCD_BAR_WORDS 3456
#define XB_SPIN_CAP (1u << 22)

__device__ __forceinline__ unsigned xb_ld(unsigned* p)              { return __hip_atomic_load(p, __ATOMIC_RELAXED, __HIP_MEMORY_SCOPE_AGENT); }
__device__ __forceinline__ unsigned xb_add(unsigned* p, unsigned v) { return __hip_atomic_fetch_add(p, v, __ATOMIC_RELAXED, __HIP_MEMORY_SCOPE_AGENT); }
__device__ __forceinline__ unsigned xb_xcc_id() { return (unsigned)__builtin_amdgcn_s_getreg((3 << 11) | 20) & 0xFu; }
#define XB_SPIN(cond, bar) do { unsigned _sp = 0; while (cond) { __builtin_amdgcn_s_sleep(1); \
    if ((++_sp & 255u) == 0u) { if (xb_ld(&(bar)[XB_TMO])) break; if (_sp > XB_SPIN_CAP) { atomicAdd(&(bar)[XB_TMO], 1u); break; } } } } while (0)

struct XcdBarrier {
    unsigned* bar; unsigned x;
    volatile LAS unsigned* st;
};

__device__ __forceinline__ XcdBarrier xcd_barrier_post(unsigned* bar, volatile LAS unsigned* st) {
    XcdBarrier b; b.bar = bar; b.x = xb_xcc_id(); b.st = st;
    if (threadIdx.x == 0) (void)xb_add(&bar[XB_XCNT(b.x)], 1u);
    return b;
}
__device__ __forceinline__ void xcd_barrier_complete(unsigned* bar, unsigned x, unsigned& nloc, unsigned& nx) {
    const unsigned G = gridDim.x * gridDim.y * gridDim.z;
    unsigned sum, cnt, mine, sp = 0u;
    for (;;) {
        sum = 0u; cnt = 0u; mine = 0u;
#pragma unroll
        for (unsigned j = 0; j < 16; ++j) { const unsigned c = xb_ld(&bar[XB_XCNT(j)]); sum += c; cnt += (c > 0u) ? 1u : 0u; mine = (j == x) ? c : mine; }
        if (sum == G) break;
        __builtin_amdgcn_s_sleep(1);
        if ((++sp & 255u) == 0u) { if (xb_ld(&bar[XB_TMO])) break; if (sp > XB_SPIN_CAP) { atomicAdd(&bar[XB_TMO], 1u); break; } }
    }
    nloc = mine > 0u ? mine : 1u; nx = cnt > 0u ? cnt : 1u;
}

__device__ __forceinline__ void xcd_barrier(const XcdBarrier& b) {
    asm volatile("s_waitcnt vmcnt(0)" ::: "memory");
    __syncthreads();
    if (threadIdx.x == 0) {
        unsigned* bar = b.bar;
        __builtin_amdgcn_s_waitcnt(0);
        unsigned nloc = b.st[0], nx = b.st[1];
        if (nloc == 0u) { xcd_barrier_complete(bar, b.x, nloc, nx); b.st[0] = nloc; b.st[1] = nx; }
        const unsigned old = xb_add(&bar[XB_XSUB(b.x)], 1u);
        const unsigned gen = old / nloc;
        if (old + 1u == (gen + 1u) * nloc) {
            __builtin_amdgcn_fence(__ATOMIC_RELEASE, "agent");
            asm volatile("s_waitcnt vmcnt(0)" ::: "memory");
            const unsigned og = xb_add(&bar[XB_TOP], 1u);
            const unsigned tg = og / nx;
            if (og + 1u == (tg + 1u) * nx) xb_add(&bar[XB_TOPGEN], 1u);
            else XB_SPIN(xb_ld(&bar[XB_TOPGEN]) == tg, bar);
            __builtin_amdgcn_fence(__ATOMIC_ACQUIRE, "agent");
            xb_add(&bar[XB_XGEN(b.x)], 1u);
            asm volatile("s_waitcnt vmcnt(0)" ::: "memory");
        } else {
            XB_SPIN(xb_ld(&bar[XB_XGEN(b.x)]) == gen, bar);
            __builtin_amdgcn_fence(__ATOMIC_ACQUIRE, "agent");
            asm volatile("s_waitcnt vmcnt(0)" ::: "memory");
        }
    }
    __syncthreads();
}
typedef __bf16 bf16x2_t __attribute__((ext_vector_type(2)));
typedef float f32x2 __attribute__((ext_vector_type(2)));
typedef float f32x16 __attribute__((ext_vector_type(16)));
#define MFMA32(a, b, c) __builtin_amdgcn_mfma_f32_32x32x16_bf16((a), (b), (c), 0, 0, 0)
__device__ __forceinline__ float bf2f(bf16 v) { return __builtin_bit_cast(float, (unsigned)v << 16); }
__device__ __forceinline__ float bflo(unsigned w) { return __builtin_bit_cast(float, w << 16); }
__device__ __forceinline__ float bfhi(unsigned w) { return __builtin_bit_cast(float, w & 0xffff0000u); }
__device__ __forceinline__ float dot2bf(unsigned a, unsigned b, float acc) { return __builtin_amdgcn_fdot2_f32_bf16(__builtin_bit_cast(bf16x2_t, a), __builtin_bit_cast(bf16x2_t, b), acc, false); }
__device__ __forceinline__ unsigned ord_key(float s) { const int u = __builtin_bit_cast(int, s); return (unsigned)(u ^ ((u >> 31) | (int)0x80000000)); }
__device__ __forceinline__ float ord_dec(unsigned k) { const unsigned u = (k & 0x80000000u) ? (k & 0x7fffffffu) : ~k; return __builtin_bit_cast(float, u); }
__device__ __forceinline__ float wave_sum(float v) {
#pragma unroll
    for (int o = 1; o < 64; o <<= 1) v += __shfl_xor(v, o);
    return v;
}
__device__ __forceinline__ float wave_max(float v) {
#pragma unroll
    for (int o = 1; o < 64; o <<= 1) v = fmaxf(v, __shfl_xor(v, o));
    return v;
}
using pg8::gelu_tanh; using pg8::sigmoidf_; using pg8::siluf_; using pg8::act_store; using pg8::kind_p0; using pg8::kind_p1; using pg8::h2f_bits;

__device__ __forceinline__ void rms_rows(const float* src, const float* w, bf16* dst_bf, float* dst_f, int gw, int NGW, int lane) {
    for (int m = gw; m < MTOK; m += NGW) {
        const f32x4* xr = (const f32x4*)(src + (size_t)m * DM) + lane;
        f32x4 v[4]; float s = 0.f;
#pragma unroll
        for (int j = 0; j < 4; ++j) { v[j] = xr[64 * j]; s += (v[j].x * v[j].x + v[j].y * v[j].y) + (v[j].z * v[j].z + v[j].w * v[j].w); }
        const float r = 1.0f / sqrtf(wave_sum(s) * (1.0f / DM) + EPS);
#pragma unroll
        for (int j = 0; j < 4; ++j) {
            const f32x4 wv = *((const f32x4*)w + lane + 64 * j);
            const f32x4 y = v[j] * r * wv;
            if (dst_bf) { unsigned long long o = (unsigned long long)pk2(y.x, y.y) | ((unsigned long long)pk2(y.z, y.w) << 32); *((unsigned long long*)(dst_bf + (size_t)m * DM) + lane + 64 * j) = o; }
            if (dst_f) *((f32x4*)(dst_f + (size_t)m * DM) + lane + 64 * j) = y;
        }
    }
}

__device__ __forceinline__ void rms_rows_bf(const bf16* src, const float* w, bf16* dst_bf, int gw, int NGW, int lane) {
    for (int m = gw; m < MTOK; m += NGW) {
        const v4u* xb = (const v4u*)(src + (size_t)m * DM + 16 * lane); const v4u b0 = xb[0], b1 = xb[1];
        float v[16] = {bflo(b0.x), bfhi(b0.x), bflo(b0.y), bfhi(b0.y), bflo(b0.z), bfhi(b0.z), bflo(b0.w), bfhi(b0.w), bflo(b1.x), bfhi(b1.x), bflo(b1.y), bfhi(b1.y), bflo(b1.z), bfhi(b1.z), bflo(b1.w), bfhi(b1.w)};
        float s = 0.f;
#pragma unroll
        for (int i = 0; i < 16; ++i) s += v[i] * v[i];
        const float rr = 1.0f / sqrtf(wave_sum(s) * (1.0f / DM) + EPS);
        unsigned o[8];
#pragma unroll
        for (int c = 0; c < 4; ++c) { const f32x4 wv = *(const f32x4*)(w + 16 * lane + 4 * c);
            o[2 * c] = pk2(v[4 * c] * rr * wv.x, v[4 * c + 1] * rr * wv.y); o[2 * c + 1] = pk2(v[4 * c + 2] * rr * wv.z, v[4 * c + 3] * rr * wv.w); }
        v4u* d = (v4u*)(dst_bf + (size_t)m * DM + 16 * lane); d[0] = (v4u){o[0], o[1], o[2], o[3]}; d[1] = (v4u){o[4], o[5], o[6], o[7]};
    }
}
__device__ __forceinline__ void tr_item(const float* W, int K, int N, bf16* WT, LAS float* scr, int item, int nblk, int lane, const float* kscale = nullptr) {
    const int kb = item / nblk, nb = item % nblk, k0 = 64 * kb, n0 = 32 * nb;
    const int nn = n0 + (lane & 31);
#pragma unroll 8
    for (int i = 0; i < 32; ++i) { const int kk = 2 * i + (lane >> 5); scr[kk * 33 + (lane & 31)] = (nn < N) ? W[(size_t)(k0 + kk) * N + nn] * (kscale ? kscale[k0 + kk] : 1.0f) : 0.f; }
    LDS_WAIT(); asm volatile("" ::: "memory");
    const int c = lane & 7;
#pragma unroll
    for (int j = 0; j < 4; ++j) { const int n = (lane >> 3) + 8 * j; const LAS float* s = scr + (8 * c) * 33 + n;
        v4u o; o.x = pk2(s[0 * 33], s[1 * 33]); o.y = pk2(s[2 * 33], s[3 * 33]); o.z = pk2(s[4 * 33], s[5 * 33]); o.w = pk2(s[6 * 33], s[7 * 33]);
        *(v4u*)(WT + (size_t)(n0 + n) * K + k0 + 8 * c) = o; }
    LDS_WAIT(); asm volatile("" ::: "memory");
}
__device__ __forceinline__ void cvt_items(const float* src, bf16* dst, size_t n, int gw, int NGW, int lane) {
    const size_t nit = n / 512;
    for (size_t it = gw; it < nit; it += NGW) {
        const f32x4* s = (const f32x4*)(src + it * 512) + 2 * lane; const f32x4 a = s[0], b = s[1];
        v4u o; o.x = pk2(a.x, a.y); o.y = pk2(a.z, a.w); o.z = pk2(b.x, b.y); o.w = pk2(b.z, b.w);
        *((v4u*)(dst + it * 512) + lane) = o;
    }
}
template <class Epi>
__device__ __forceinline__ void naive_gemm(const bf16* A, const bf16* Wt, int M, int N, int K, const Epi& epi, int gtid, int gthreads) {
    const long total = (long)M * N;
    for (long idx = gtid; idx < total; idx += gthreads) {
        const int m = (int)(idx / N), n = (int)(idx % N);
        const v4u* a = (const v4u*)(A + (size_t)m * K); const v4u* w = (const v4u*)(Wt + (size_t)n * K);
        float a0 = 0.f, a1 = 0.f, a2 = 0.f, a3 = 0.f;
        for (int k = 0; k < K / 8; ++k) { const v4u av = a[k], wv = w[k]; a0 = dot2bf(av.x, wv.x, a0); a1 = dot2bf(av.y, wv.y, a1); a2 = dot2bf(av.z, wv.z, a2); a3 = dot2bf(av.w, wv.w, a3); }
        epi(m, n, (a0 + a1) + (a2 + a3));
    }
}
struct NEpiAct { bf16* O; int ldc; int which; const float* lb;
    __device__ __forceinline__ void operator()(int m, int n, float v) const {
        const int kind = which == 0 ? kind_p0(n) : which == 1 ? kind_p1(n) : pg8::AK_ID;
        const float lbv = (which == 1 && kind == pg8::AK_KK) ? lb[n - 1024] : 0.f;
        O[(size_t)m * ldc + n] = act_store(kind, v, lbv); } };
struct NEpiResid { const float* base; float* out; int ldc;
    __device__ __forceinline__ void operator()(int m, int n, float v) const { out[(size_t)m * ldc + n] = base[(size_t)m * ldc + n] + v; } };

__device__ __forceinline__ void naive_gmlp_unit(int u, const bf16* P0, const float* lnw, const float* Ws, const float* bs, bf16* MIX, LAS unsigned char* lds, int tid) {
    LAS float* Vn = (LAS float*)lds;
    const int g = u & 3, row0 = (u >> 2) * 128;
    {   const int r = tid >> 2, q = tid & 3;
        const bf16* src = P0 + (size_t)(row0 + r) * NP0 + C_V + g * 128 + q * 32;
        float v[32]; float s = 0.f;
#pragma unroll
        for (int i = 0; i < 32; ++i) { v[i] = bf2f(src[i]); s += v[i]; }
        s += __shfl_xor(s, 1); s += __shfl_xor(s, 2);
        const float mean = s * (1.0f / 128.0f); float q2 = 0.f;
#pragma unroll
        for (int i = 0; i < 32; ++i) { const float d = v[i] - mean; q2 += d * d; }
        q2 += __shfl_xor(q2, 1); q2 += __shfl_xor(q2, 2);
        const float rstd = 1.0f / sqrtf(q2 * (1.0f / 128.0f) + EPS);
#pragma unroll
        for (int i = 0; i < 32; ++i) Vn[r * 128 + q * 32 + i] = (v[i] - mean) * rstd * lnw[g * 128 + q * 32 + i];
    }
    __syncthreads();
    {   const int d = tid & 127, tq = tid >> 7;
        for (int t = tq * 32; t < tq * 32 + 32; ++t) {
            const float* wrow = Ws + ((size_t)g * 128 + t) * 128; float acc = 0.f;
            for (int s = 0; s <= t; ++s) acc += wrow[s] * Vn[s * 128 + d];
            const float mixed = acc + bs[g * 128 + t];
            const float uu = bf2f(P0[(size_t)(row0 + t) * NP0 + C_U + g * 128 + d]);
            MIX[(size_t)(row0 + t) * DM + g * 128 + d] = f2bf(uu * mixed);
        }
    }
    __syncthreads();
}
__device__ __forceinline__ void naive_compress_unit(int cu, const bf16* P0, const float* pos, const float* w1k, const float* w2k, const float* w1v, const float* w2v, bf16* KC, bf16* VC, LAS unsigned char* lds, int tid) {
    LAS float* blk = (LAS float*)lds; LAS float* h1p = blk + 2048; LAS float* h1 = h1p + 512;
    const int which = cu & 1, rest = cu >> 1, n = rest % NCMP, bg = rest / NCMP, g = bg & 1, b = bg >> 1;
    const float* w1 = which ? w1v : w1k; const float* w2 = which ? w2v : w2k; bf16* O = which ? VC : KC;
    const int col = (which ? C_VC : C_KC) + g * 64;
    for (int j = tid; j < 2048; j += NTHR) { const int l = j >> 6, d = j & 63; blk[j] = bf2f(P0[(size_t)(b * SEQ + 16 * n + l) * NP0 + col + d]) + pos[l * 64 + d]; }
    __syncthreads();
    {   const int hid = tid & 127, part = tid >> 7; float acc = 0.f;
        for (int j = part * 512; j < part * 512 + 512; ++j) acc += blk[j] * w1[(size_t)j * 128 + hid];
        h1p[part * 128 + hid] = acc; }
    __syncthreads();
    if (tid < 128) h1[tid] = gelu_tanh((h1p[tid] + h1p[128 + tid]) + (h1p[256 + tid] + h1p[384 + tid]));
    __syncthreads();
    if (tid < 64) { float acc = 0.f; for (int hh = 0; hh < 128; ++hh) acc += h1[hh] * w2[hh * 64 + tid]; O[((size_t)(b * 2 + g) * NCMP_PAD + n) * 64 + tid] = f2bf(acc); }
    __syncthreads();
}

constexpr int NSA_WAVE_LDS = 16384 + 1024 + 64;
__device__ __forceinline__ void nsa_dot4(const bf16* krow, const LAS float* Q, float (&s)[4]) {
    s[0] = s[1] = s[2] = s[3] = 0.f;
#pragma unroll 1
    for (int c = 0; c < 8; ++c) {
        const v4u kv = *((const v4u*)krow + c);
        const float k0 = bflo(kv.x), k1 = bfhi(kv.x), k2 = bflo(kv.y), k3 = bfhi(kv.y), k4 = bflo(kv.z), k5 = bfhi(kv.z), k6 = bflo(kv.w), k7 = bfhi(kv.w);
#pragma unroll
        for (int h = 0; h < 4; ++h) { const LAS f32x4* q = (const LAS f32x4*)(Q + h * 64 + c * 8); const f32x4 qa = q[0], qb = q[1];
            s[h] += (k0 * qa.x + k1 * qa.y) + (k2 * qa.z + k3 * qa.w) + (k4 * qb.x + k5 * qb.y) + (k6 * qb.z + k7 * qb.w); }
    }
}
__device__ __forceinline__ void naive_nsa_wave(int wu, const bf16* P0, const bf16* KC, const bf16* VC, bf16* MIX, LAS unsigned char* wlds, int lane) {
    LAS float* SC = (LAS float*)wlds; LAS float* Q = SC + 4096; LAS int* SEL = (LAS int*)(Q + 256);
    const int t = wu % SEQ, bg = wu / SEQ, g = bg & 1, b = bg >> 1;
    const size_t row = (size_t)b * SEQ + t;
    float slope[4];
#pragma unroll
    for (int h = 0; h < 4; ++h) slope[h] = exp2f(-(float)(g * 4 + h + 1));
#pragma unroll
    for (int h = 0; h < 4; ++h) Q[h * 64 + lane] = bf2f(P0[row * NP0 + C_Q + (g * 4 + h) * 64 + lane]);
    LDS_WAIT();
    const int nv = (t >= 31) ? min(NCMP, (t - 31) / 16 + 1) : 0;
    float o_cmp[4] = {0.f, 0.f, 0.f, 0.f};
    {
        float mx[4] = {-3e38f, -3e38f, -3e38f, -3e38f};
#pragma unroll 1
        for (int i = 0; i < 8; ++i) { const int n = lane + 64 * i; float s[4] = {-1e30f, -1e30f, -1e30f, -1e30f};
            if (n < nv) { nsa_dot4(KC + ((size_t)(b * 2 + g) * NCMP_PAD + n) * 64, Q, s);
#pragma unroll
                for (int h = 0; h < 4; ++h) { s[h] -= slope[h] * (float)(t - (16 * n + 31)); mx[h] = fmaxf(mx[h], s[h]); } }
#pragma unroll
            for (int h = 0; h < 4; ++h) SC[h * 1024 + n] = s[h]; }
        LDS_WAIT();
#pragma unroll
        for (int h = 0; h < 4; ++h) { const float m = wave_max(mx[h]); float sum = 0.f;
#pragma unroll 1
            for (int i = 0; i < 8; ++i) { const float s = SC[h * 1024 + lane + 64 * i]; const float e = (s > -1e29f) ? __expf(s - m) : 0.f; SC[h * 1024 + lane + 64 * i] = e; sum += e; }
            sum = wave_sum(sum); const float inv = 1.0f / fmaxf(sum, 1e-30f);
#pragma unroll 1
            for (int i = 0; i < 8; ++i) SC[h * 1024 + lane + 64 * i] *= inv; }
        LDS_WAIT();
#pragma unroll 2
        for (int n = 0; n < nv; ++n) { const float v = bf2f(VC[((size_t)(b * 2 + g) * NCMP_PAD + n) * 64 + lane]);
#pragma unroll
            for (int h = 0; h < 4; ++h) o_cmp[h] += SC[h * 1024 + n] * v; }
    }
    const int jcur = t >> 6;
    float c0, c1;
    {   float im[2];
#pragma unroll
        for (int k = 0; k < 2; ++k) { const int j = lane + 64 * k; float a = 0.f;
            for (int n = 4 * j - 1; n <= 4 * j + 3; ++n) if (n >= 0 && n < NCMP_PAD) a += (SC[n] + SC[1024 + n]) + (SC[2048 + n] + SC[3072 + n]);
            const bool forced = (j == 0) || (j == jcur) || (j == jcur - 1);
            im[k] = forced ? 1e9f : ((64 * j <= t) ? a : -1e30f); }
        c0 = im[0]; c1 = im[1]; }
    for (int it = 0; it < 16; ++it) {
        const float m = wave_max(fmaxf(c0, c1));
        const unsigned long long b0 = __ballot(c0 == m); int idx;
        if (b0) idx = __builtin_ctzll(b0); else idx = 64 + __builtin_ctzll(__ballot(c1 == m));
        if (lane == 0) SEL[it] = idx;
        if (lane == (idx & 63)) { if (idx < 64) c0 = -3e38f; else c1 = -3e38f; }
    }
    LDS_WAIT();
    float o_slc[4] = {0.f, 0.f, 0.f, 0.f}, inv_s[4];
    {   float mx[4] = {-3e38f, -3e38f, -3e38f, -3e38f};
#pragma unroll 1
        for (int it = 0; it < 16; ++it) { const int j = SEL[it]; const int kpos = 64 * j + lane; float s[4] = {-1e30f, -1e30f, -1e30f, -1e30f};
            if (kpos <= t) { nsa_dot4(P0 + ((size_t)b * SEQ + kpos) * NP0 + C_KS + g * 64, Q, s);
#pragma unroll
                for (int h = 0; h < 4; ++h) { s[h] -= slope[h] * (float)(t - kpos); mx[h] = fmaxf(mx[h], s[h]); } }
#pragma unroll
            for (int h = 0; h < 4; ++h) SC[h * 1024 + it * 64 + lane] = s[h]; }
        LDS_WAIT();
#pragma unroll
        for (int h = 0; h < 4; ++h) { const float m = wave_max(mx[h]); float sum = 0.f;
#pragma unroll 1
            for (int i = 0; i < 16; ++i) { const float s = SC[h * 1024 + i * 64 + lane]; const float e = (s > -1e29f) ? __expf(s - m) : 0.f; SC[h * 1024 + i * 64 + lane] = e; sum += e; }
            sum = wave_sum(sum); inv_s[h] = 1.0f / fmaxf(sum, 1e-30f); }
        LDS_WAIT();
#pragma unroll 1
        for (int it = 0; it < 16; ++it) { const int j = SEL[it]; if (j > jcur) continue;
#pragma unroll 2
            for (int kk = 0; kk < 64; ++kk) { const int kpos = 64 * j + kk; if (kpos > t) break;
                const float v = bf2f(P0[((size_t)b * SEQ + kpos) * NP0 + C_VS + g * 64 + lane]);
#pragma unroll
                for (int h = 0; h < 4; ++h) o_slc[h] += SC[h * 1024 + it * 64 + kk] * v; } }
    }
    float o_win[4] = {0.f, 0.f, 0.f, 0.f}, inv_w[4];
    {   float mx[4] = {-3e38f, -3e38f, -3e38f, -3e38f};
#pragma unroll 1
        for (int i = 0; i < 8; ++i) { const int kpos = t - 511 + 64 * i + lane; float s[4] = {-1e30f, -1e30f, -1e30f, -1e30f};
            if (kpos >= 0) { nsa_dot4(P0 + ((size_t)b * SEQ + kpos) * NP0 + C_KW + g * 64, Q, s);
#pragma unroll
                for (int h = 0; h < 4; ++h) { s[h] -= slope[h] * (float)(t - kpos); mx[h] = fmaxf(mx[h], s[h]); } }
#pragma unroll
            for (int h = 0; h < 4; ++h) SC[h * 1024 + i * 64 + lane] = s[h]; }
        LDS_WAIT();
#pragma unroll
        for (int h = 0; h < 4; ++h) { const float m = wave_max(mx[h]); float sum = 0.f;
#pragma unroll 1
            for (int i = 0; i < 8; ++i) { const float s = SC[h * 1024 + i * 64 + lane]; const float e = (s > -1e29f) ? __expf(s - m) : 0.f; SC[h * 1024 + i * 64 + lane] = e; sum += e; }
            sum = wave_sum(sum); inv_w[h] = 1.0f / fmaxf(sum, 1e-30f); }
        LDS_WAIT();
#pragma unroll 2
        for (int kk = 0; kk < 512; ++kk) { const int kpos = t - 511 + kk; if (kpos < 0) continue;
            const float v = bf2f(P0[((size_t)b * SEQ + kpos) * NP0 + C_VW + g * 64 + lane]);
#pragma unroll
            for (int h = 0; h < 4; ++h) o_win[h] += SC[h * 1024 + kk] * v; }
    }
#pragma unroll
    for (int h = 0; h < 4; ++h) { const bf16* gp = P0 + row * NP0 + C_GT + (g * 4 + h) * 3;
        const float o = bf2f(gp[0]) * o_cmp[h] + bf2f(gp[1]) * o_slc[h] * inv_s[h] + bf2f(gp[2]) * o_win[h] * inv_w[h];
        MIX[row * DM + 512 + (g * 4 + h) * 64 + lane] = f2bf(o); }
    LDS_WAIT();
}

__device__ __forceinline__ void naive_peer_select_wave(int wu, const bf16* QP, const bf16* KEYS, int* EXPO, float* GATEO, LAS unsigned char* wlds, int lane) {
    LAS float* Q = (LAS float*)wlds; LAS float* ST = Q + 256; LAS int* IT = (LAS int*)(ST + 32);
    const int tok = wu >> 3, h = wu & 7;
#pragma unroll
    for (int i = 0; i < 4; ++i) Q[lane + 64 * i] = bf2f(QP[(size_t)tok * NQP + h * 256 + lane + 64 * i]);
    LDS_WAIT();
    for (int p = 0; p < 2; ++p) {
        float c[2];
#pragma unroll
        for (int k = 0; k < 2; ++k) { const int n = lane + 64 * k; const v4u* kr = (const v4u*)(KEYS + ((size_t)(h * 2 + p) * 128 + n) * 128); float a = 0.f;
#pragma unroll 2
            for (int cc = 0; cc < 16; ++cc) { const v4u kv = kr[cc]; const LAS float* q = Q + p * 128 + cc * 8;
                a += (bflo(kv.x) * q[0] + bfhi(kv.x) * q[1]) + (bflo(kv.y) * q[2] + bfhi(kv.y) * q[3]) + (bflo(kv.z) * q[4] + bfhi(kv.z) * q[5]) + (bflo(kv.w) * q[6] + bfhi(kv.w) * q[7]); }
            c[k] = a; }
        float c0 = c[0], c1 = c[1];
        for (int it = 0; it < 16; ++it) {
            const float m = wave_max(fmaxf(c0, c1));
            const unsigned long long b0 = __ballot(c0 == m); int idx;
            if (b0) idx = __builtin_ctzll(b0); else idx = 64 + __builtin_ctzll(__ballot(c1 == m));
            if (lane == 0) { ST[p * 16 + it] = m; IT[p * 16 + it] = idx; }
            if (lane == (idx & 63)) { if (idx < 64) c0 = -3e38f; else c1 = -3e38f; }
        }
    }
    LDS_WAIT();
    float cd[4];
#pragma unroll
    for (int i = 0; i < 4; ++i) { const int f = lane + 64 * i; cd[i] = ST[f >> 4] + ST[16 + (f & 15)]; }
    float best = 0.f; int pos = 0;
    for (int it = 0; it < 16; ++it) {
        const float m = wave_max(fmaxf(fmaxf(cd[0], cd[1]), fmaxf(cd[2], cd[3])));
        int idx = -1;
#pragma unroll
        for (int i = 0; i < 4; ++i) { if (idx < 0) { const unsigned long long bb = __ballot(cd[i] == m); if (bb) idx = 64 * i + __builtin_ctzll(bb); } }
        if (lane == it) { best = m; pos = idx; }
#pragma unroll
        for (int i = 0; i < 4; ++i) if (idx == lane + 64 * i) cd[i] = -3e38f;
    }
    const float bmax = __shfl(best, 0);
    const float e = (lane < 16) ? __expf(best - bmax) : 0.f;
    const float sum = wave_sum(e);
    if (lane < 16) { const int ex = IT[pos >> 4] * 128 + IT[16 + (pos & 15)];
        EXPO[(size_t)tok * 128 + h * 16 + lane] = ex; GATEO[(size_t)tok * 128 + h * 16 + lane] = e / sum; }
    LDS_WAIT();
}

__device__ __forceinline__ void naive_peer_eval_wave(int tok, bf16* XN, const bf16* TU, const bf16* TV, const int* EXPI, const float* GATEI, float* xres, const float* nw_bf, const float* nw_f, int lane) {
    float x[16];
#pragma unroll
    for (int j = 0; j < 4; ++j) { const unsigned long long w = *((const unsigned long long*)(XN + (size_t)tok * DM) + lane + 64 * j);
        x[4 * j] = bflo((unsigned)w); x[4 * j + 1] = bfhi((unsigned)w); x[4 * j + 2] = bflo((unsigned)(w >> 32)); x[4 * j + 3] = bfhi((unsigned)(w >> 32)); }
    float acc[16];
#pragma unroll
    for (int i = 0; i < 16; ++i) acc[i] = 0.f;
    for (int e = 0; e < 128; ++e) {
        const int ex = EXPI[(size_t)tok * 128 + e]; const float gt = GATEI[(size_t)tok * 128 + e];
        const unsigned long long* ur = (const unsigned long long*)(TU + (size_t)ex * DM) + lane; float d = 0.f;
#pragma unroll
        for (int j = 0; j < 4; ++j) { const unsigned long long w = ur[64 * j];
            d += (bflo((unsigned)w) * x[4 * j] + bfhi((unsigned)w) * x[4 * j + 1]) + (bflo((unsigned)(w >> 32)) * x[4 * j + 2] + bfhi((unsigned)(w >> 32)) * x[4 * j + 3]); }
        d = wave_sum(d);
        const float wgt = gt * gelu_tanh(d);
        const unsigned long long* vr = (const unsigned long long*)(TV + (size_t)ex * DM) + lane;
#pragma unroll
        for (int j = 0; j < 4; ++j) { const unsigned long long w = vr[64 * j];
            acc[4 * j] += wgt * bflo((unsigned)w); acc[4 * j + 1] += wgt * bfhi((unsigned)w); acc[4 * j + 2] += wgt * bflo((unsigned)(w >> 32)); acc[4 * j + 3] += wgt * bfhi((unsigned)(w >> 32)); }
    }
    f32x4* xr = (f32x4*)(xres + (size_t)tok * DM) + lane; float ss = 0.f; f32x4 y[4];
#pragma unroll
    for (int j = 0; j < 4; ++j) { f32x4 r = xr[64 * j]; r.x += acc[4 * j]; r.y += acc[4 * j + 1]; r.z += acc[4 * j + 2]; r.w += acc[4 * j + 3]; y[j] = r; ss += (r.x * r.x + r.y * r.y) + (r.z * r.z + r.w * r.w); }
    const float rr = 1.0f / sqrtf(wave_sum(ss) * (1.0f / DM) + EPS);
#pragma unroll
    for (int j = 0; j < 4; ++j) {
        if (nw_f) { const f32x4 wv = *((const f32x4*)nw_f + lane + 64 * j); xr[64 * j] = y[j] * rr * wv; }
        else xr[64 * j] = y[j];
        if (nw_bf) { const f32x4 wv = *((const f32x4*)nw_bf + lane + 64 * j); const f32x4 z = y[j] * rr * wv;
            *((unsigned long long*)(XN + (size_t)tok * DM) + lane + 64 * j) = (unsigned long long)pk2(z.x, z.y) | ((unsigned long long)pk2(z.z, z.w) << 32); }
    }
}

__device__ __forceinline__ void naive_hgrn_block(int blk, const bf16* P1, const float* nw, bf16* OG, LAS unsigned char* lds, int tid) {
    constexpr int TB = 16;
    const int sq = tid >> 7, v = tid & 127, seq = blk * 4 + sq, b = seq >> 3, h = seq & 7;
    LAS float* QS = (LAS float*)lds + sq * (4 * TB * 128);
    LAS float* KS = QS + TB * 128; LAS float* FS = KS + TB * 128; LAS float* OS = FS + TB * 128;
    float st[128];
#pragma unroll
    for (int k = 0; k < 128; ++k) st[k] = 0.f;
    const float nwv = nw[h * 128 + v];
    for (int t0 = 0; t0 < SEQ; t0 += TB) {
        __syncthreads();
        for (int i = 0; i < TB; ++i) { const bf16* r = P1 + ((size_t)b * SEQ + t0 + i) * NP1 + h * 128 + v;
            QS[i * 128 + v] = bf2f(r[0]); const float kk = h2f_bits(r[1024]); KS[i * 128 + v] = kk; FS[i * 128 + v] = 1.0f - kk; }
        __syncthreads();
        for (int i = 0; i < TB; ++i) {
            const float vi = bf2f(P1[((size_t)b * SEQ + t0 + i) * NP1 + 2048 + h * 128 + v]); float o = 0.f;
#pragma unroll
            for (int k = 0; k < 128; ++k) { st[k] = FS[i * 128 + k] * st[k] + KS[i * 128 + k] * vi; o += QS[i * 128 + k] * st[k]; if ((k & 15) == 15) asm volatile("" ::: "memory"); }
            OS[i * 128 + v] = o;
        }
        __syncthreads();
        for (int i = 0; i < TB; ++i) { float ss = 0.f;
            for (int k = 0; k < 128; ++k) { const float o = OS[i * 128 + k]; ss += o * o; }
            const float rr = 1.0f / sqrtf(ss * (1.0f / 128.0f) + EPS);
            const float gate = bf2f(P1[((size_t)b * SEQ + t0 + i) * NP1 + 3072 + h * 128 + v]);
            OG[((size_t)b * SEQ + t0 + i) * DM + h * 128 + v] = f2bf(OS[i * 128 + v] * rr * nwv * gate); }
    }
    __syncthreads();
}
constexpr int HG_PQ = 136, HG_PK = 72;
constexpr int HG_QB = 0, HG_QT = 17408, HG_KT = 34816, HG_KH = 52224, HG_VT = 70656, HG_EB = 89088, HG_QP = 89600, HG_SS = 93696, HG_OT = 94720;
constexpr int HG_NSC = 8, HG_NCH = 16;
__device__ __forceinline__ unsigned pkbf(float lo, float hi) { bf16x2_t v; v[0] = (__bf16)lo; v[1] = (__bf16)hi; return __builtin_bit_cast(unsigned, v); }
__device__ __forceinline__ bf16x8 pack8(const f32x16& x, int sp) {
    v4u p; p.x = pkbf(x[8 * sp], x[8 * sp + 1]); p.y = pkbf(x[8 * sp + 2], x[8 * sp + 3]); p.z = pkbf(x[8 * sp + 4], x[8 * sp + 5]); p.w = pkbf(x[8 * sp + 6], x[8 * sp + 7]);
    return __builtin_bit_cast(bf16x8, p);
}
typedef unsigned u32x2 __attribute__((ext_vector_type(2)));
__device__ __forceinline__ bf16x8 ld2x8(const LAS bf16* p) {
    const u32x2 lo = *(const LAS u32x2*)p, hi = *(const LAS u32x2*)(p + 8); v4u v; v.x = lo.x; v.y = lo.y; v.z = hi.x; v.w = hi.y; return __builtin_bit_cast(bf16x8, v);
}
struct HgRaw { unsigned kkw[8], vvw[8], qw[8]; };
template <bool FULL>
__device__ __forceinline__ void hgrn_load(const bf16* P1, size_t row0, int h, int tid, HgRaw& R) {
    const int kp = tid & 63, sg = tid >> 6, k0 = 2 * kp;
    const bf16* base = P1 + (row0 + 8 * sg) * NP1 + h * 128 + k0;
#pragma unroll
    for (int i = 0; i < 8; ++i) { R.kkw[i] = *(const unsigned*)(base + (size_t)i * NP1 + 1024); R.vvw[i] = *(const unsigned*)(base + (size_t)i * NP1 + 2048); if (FULL) R.qw[i] = *(const unsigned*)(base + (size_t)i * NP1); }
}
template <bool FULL>
__device__ __forceinline__ void hgrn_prep(const HgRaw& R, LAS unsigned char* lds, int tid, float& gsum) {
    const int kp = tid & 63, sg = tid >> 6, k0 = 2 * kp;
    LAS float* QP = (LAS float*)(lds + HG_QP);
    const unsigned (&kkw)[8] = R.kkw; const unsigned (&vvw)[8] = R.vvw; const unsigned (&qw)[8] = R.qw;
    float ka[8], kb[8], ca[8], cb[8]; float ra = 0.f, rb = 0.f;
#pragma unroll
    for (int i = 0; i < 8; ++i) { ka[i] = h2f_bits((unsigned short)(kkw[i] & 0xffffu)); kb[i] = h2f_bits((unsigned short)(kkw[i] >> 16)); ra += __builtin_amdgcn_logf(1.0f - ka[i]); rb += __builtin_amdgcn_logf(1.0f - kb[i]); ca[i] = ra; cb[i] = rb; }
    *(LAS f32x2*)(QP + sg * 128 + k0) = (f32x2){ra, rb};
    __syncthreads();
    float offa = 0.f, offb = 0.f, brefa = 0.f, brefb = 0.f, bla = 0.f, blb = 0.f;
#pragma unroll
    for (int gq = 0; gq < 8; ++gq) { const f32x2 t = *(const LAS f32x2*)(QP + gq * 128 + k0); if (gq < sg) { offa += t.x; offb += t.y; } if (gq < 4) { brefa += t.x; brefb += t.y; } bla += t.x; blb += t.y; }
    if (sg == 0) { *(LAS f32x2*)((LAS float*)(lds + HG_EB) + k0) = (f32x2){__builtin_amdgcn_exp2f(bla), __builtin_amdgcn_exp2f(blb)}; gsum += bla; }
    if (sg == 1) gsum += blb;
    LAS bf16* QB = (LAS bf16*)(lds + HG_QB); LAS bf16* QT = (LAS bf16*)(lds + HG_QT); LAS bf16* KT = (LAS bf16*)(lds + HG_KT);
    unsigned kha[4], khb[4], vta[4], vtb[4];
    const float Fa = __builtin_amdgcn_exp2f(brefa), Fb = __builtin_amdgcn_exp2f(brefb), Ea = __builtin_amdgcn_exp2f(bla - brefa), Eb = __builtin_amdgcn_exp2f(blb - brefb);
#pragma unroll
    for (int i = 0; i < 8; i += 2) {
        const float a0 = offa + ca[i] - brefa, a1 = offa + ca[i + 1] - brefa, b0 = offb + cb[i] - brefb, b1 = offb + cb[i + 1] - brefb;
        const float pa0 = __builtin_amdgcn_exp2f(a0), pa1 = __builtin_amdgcn_exp2f(a1), pb0 = __builtin_amdgcn_exp2f(b0), pb1 = __builtin_amdgcn_exp2f(b1);
        const float na0 = __builtin_amdgcn_exp2f(-a0), na1 = __builtin_amdgcn_exp2f(-a1), nb0 = __builtin_amdgcn_exp2f(-b0), nb1 = __builtin_amdgcn_exp2f(-b1);
        const float kta0 = ka[i] * na0, kta1 = ka[i + 1] * na1, ktb0 = kb[i] * nb0, ktb1 = kb[i + 1] * nb1;
        kha[i >> 1] = pkbf(kta0 * Ea, kta1 * Ea);
        khb[i >> 1] = pkbf(ktb0 * Eb, ktb1 * Eb);
        vta[i >> 1] = (vvw[i] & 0xffffu) | (vvw[i + 1] << 16);
        vtb[i >> 1] = (vvw[i] >> 16) | (vvw[i + 1] & 0xffff0000u);
        if (FULL) {
            const int s0 = 8 * sg + i;
            const float qa0 = bflo(qw[i]) * pa0, qb0 = bfhi(qw[i]) * pb0, qa1 = bflo(qw[i + 1]) * pa1, qb1 = bfhi(qw[i + 1]) * pb1;
            *(LAS unsigned*)(QT + s0 * HG_PQ + k0) = pkbf(qa0, qb0); *(LAS unsigned*)(QT + (s0 + 1) * HG_PQ + k0) = pkbf(qa1, qb1);
            *(LAS unsigned*)(QB + s0 * HG_PQ + k0) = pkbf(qa0 * Fa, qb0 * Fb); *(LAS unsigned*)(QB + (s0 + 1) * HG_PQ + k0) = pkbf(qa1 * Fa, qb1 * Fb);
            *(LAS unsigned*)(KT + s0 * HG_PQ + k0) = pkbf(kta0, ktb0); *(LAS unsigned*)(KT + (s0 + 1) * HG_PQ + k0) = pkbf(kta1, ktb1);
        }
    }
    { v4u a; a.x = kha[0]; a.y = kha[1]; a.z = kha[2]; a.w = kha[3]; *(LAS v4u*)(lds + HG_KH + (k0 * HG_PK + 8 * sg) * 2) = a; a.x = khb[0]; a.y = khb[1]; a.z = khb[2]; a.w = khb[3]; *(LAS v4u*)(lds + HG_KH + ((k0 + 1) * HG_PK + 8 * sg) * 2) = a; }
    { v4u a; a.x = vta[0]; a.y = vta[1]; a.z = vta[2]; a.w = vta[3]; *(LAS v4u*)(lds + HG_VT + (k0 * HG_PK + 8 * sg) * 2) = a; a.x = vtb[0]; a.y = vtb[1]; a.z = vtb[2]; a.w = vtb[3]; *(LAS v4u*)(lds + HG_VT + ((k0 + 1) * HG_PK + 8 * sg) * 2) = a; }
    __syncthreads();
}
template <int NKT>
__device__ __forceinline__ void hgrn_state_update(f32x16 (&st)[NKT], int kt0, int vt, LAS unsigned char* lds, int r, int hh) {
    const LAS float* EB = (const LAS float*)(lds + HG_EB); const LAS bf16* KH = (const LAS bf16*)(lds + HG_KH); const LAS bf16* VT = (const LAS bf16*)(lds + HG_VT);
#pragma unroll
    for (int a = 0; a < NKT; ++a) {
#pragma unroll
        for (int g = 0; g < 4; ++g) { const f32x4 e = *(const LAS f32x4*)(EB + 32 * (kt0 + a) + 8 * g + 4 * hh); st[a][4 * g] *= e.x; st[a][4 * g + 1] *= e.y; st[a][4 * g + 2] *= e.z; st[a][4 * g + 3] *= e.w; }
    }
#pragma unroll
    for (int ss = 0; ss < 4; ++ss) {
        const bf16x8 b = *(const LAS bf16x8*)(VT + (32 * vt + r) * HG_PK + 16 * ss + 8 * hh);
#pragma unroll
        for (int a = 0; a < NKT; ++a) { const bf16x8 av = *(const LAS bf16x8*)(KH + (32 * (kt0 + a) + r) * HG_PK + 16 * ss + 8 * hh); st[a] = MFMA32(av, b, st[a]); }
    }
}
__device__ __forceinline__ void hgrn_pass_a(int unit, const bf16* P1, float* LST, float* GST, LAS unsigned char* lds, int tid) {
    const int j = unit & 7, bh = unit >> 3, h = bh & 7, b = bh >> 3;
    const int lane = tid & 63, w = tid >> 6, r = lane & 31, hh = lane >> 5, kt = w >> 1, vt0 = 2 * (w & 1);
    f32x16 s0[1], s1[1];
#pragma unroll
    for (int i = 0; i < 16; ++i) { s0[0][i] = 0.f; s1[0][i] = 0.f; }
    float gsum = 0.f;
    HgRaw Rc, Rn;
    hgrn_load<false>(P1, (size_t)b * SEQ + j * 1024, h, tid, Rc); Rn = Rc;
    for (int c = 0; c < HG_NCH; ++c) {
        const size_t row0 = (size_t)b * SEQ + j * 1024 + c * 64;
        if (c + 1 < HG_NCH) hgrn_load<false>(P1, row0 + 64, h, tid, Rn);
        hgrn_prep<false>(Rc, lds, tid, gsum);
        Rc = Rn;
        hgrn_state_update<1>(s0, kt, vt0, lds, r, hh);
        hgrn_state_update<1>(s1, kt, vt0 + 1, lds, r, hh);
        __syncthreads();
    }
    float* L = LST + (size_t)unit * 16384;
#pragma unroll
    for (int i = 0; i < 16; ++i) { const int k = 32 * kt + (i & 3) + 8 * (i >> 2) + 4 * hh; L[k * 128 + 32 * vt0 + r] = s0[0][i]; L[k * 128 + 32 * (vt0 + 1) + r] = s1[0][i]; }
    if (tid < 128) GST[unit * 128 + 2 * (tid & 63) + (tid >> 6)] = gsum;
}
__device__ __forceinline__ void hgrn_pass_c(int unit, const bf16* P1, const float* LST, const float* GST, const float* nw, bf16* OG, LAS unsigned char* lds, int tid) {
    const int j = unit & 7, bh = unit >> 3, h = bh & 7, b = bh >> 3;
    const int lane = tid & 63, w = tid >> 6, r = lane & 31, hh = lane >> 5, vt = w >> 1, tt = w & 1;
    f32x16 st[4];
#pragma unroll
    for (int a = 0; a < 4; ++a)
#pragma unroll
        for (int i = 0; i < 16; ++i) st[a][i] = 0.f;
    for (int p = 0; p < j; ++p) {
        const float* L = LST + (size_t)(unit - j + p) * 16384; const float* Gp = GST + (unit - j + p) * 128;
#pragma unroll
        for (int a = 0; a < 4; ++a) {
#pragma unroll
            for (int g = 0; g < 4; ++g) { const int k = 32 * a + 8 * g + 4 * hh; const f32x4 gv = *(const f32x4*)(Gp + k);
                st[a][4 * g] = __builtin_amdgcn_exp2f(gv.x) * st[a][4 * g] + L[k * 128 + 32 * vt + r]; st[a][4 * g + 1] = __builtin_amdgcn_exp2f(gv.y) * st[a][4 * g + 1] + L[(k + 1) * 128 + 32 * vt + r];
                st[a][4 * g + 2] = __builtin_amdgcn_exp2f(gv.z) * st[a][4 * g + 2] + L[(k + 2) * 128 + 32 * vt + r]; st[a][4 * g + 3] = __builtin_amdgcn_exp2f(gv.w) * st[a][4 * g + 3] + L[(k + 3) * 128 + 32 * vt + r]; }
            asm volatile("" ::: "memory");
        }
    }
    const LAS bf16* QB = (const LAS bf16*)(lds + HG_QB); const LAS bf16* QT = (const LAS bf16*)(lds + HG_QT); const LAS bf16* KT = (const LAS bf16*)(lds + HG_KT); const LAS bf16* VT = (const LAS bf16*)(lds + HG_VT);
    LAS float* SS = (LAS float*)(lds + HG_SS); LAS float* OT = (LAS float*)(lds + HG_OT);
    float gdummy = 0.f;
    HgRaw Rc;
    hgrn_load<true>(P1, (size_t)b * SEQ + j * 1024, h, tid, Rc);
    for (int c = 0; c < HG_NCH; ++c) {
        const size_t row0 = (size_t)b * SEQ + j * 1024 + c * 64;
        hgrn_prep<true>(Rc, lds, tid, gdummy);
        if (c + 1 < HG_NCH) hgrn_load<true>(P1, row0 + 64, h, tid, Rc);
        f32x16 o;
#pragma unroll
        for (int i = 0; i < 16; ++i) o[i] = 0.f;
#pragma unroll
        for (int st_ = 0; st_ < 2; ++st_) {
            if (st_ <= tt) {
                f32x16 at;
#pragma unroll
                for (int i = 0; i < 16; ++i) at[i] = 0.f;
#pragma unroll
                for (int ks = 0; ks < 8; ++ks) { const bf16x8 a = *(const LAS bf16x8*)(KT + (32 * st_ + r) * HG_PQ + 16 * ks + 8 * hh); const bf16x8 bq = *(const LAS bf16x8*)(QT + (32 * tt + r) * HG_PQ + 16 * ks + 8 * hh); at = MFMA32(a, bq, at); }
                if (st_ == tt) {
#pragma unroll
                    for (int i = 0; i < 16; ++i) { const int s = (i & 3) + 8 * (i >> 2) + 4 * hh; if (s > r) at[i] = 0.f; }
                }
#pragma unroll
                for (int sp = 0; sp < 2; ++sp) { const bf16x8 bfrag = pack8(at, sp); const bf16x8 afrag = ld2x8(VT + (32 * vt + r) * HG_PK + 32 * st_ + 16 * sp + 4 * hh); o = MFMA32(afrag, bfrag, o); }
            }
        }
#pragma unroll
        for (int a = 0; a < 4; ++a)
#pragma unroll
            for (int sp = 0; sp < 2; ++sp) { const bf16x8 afrag = pack8(st[a], sp); const bf16x8 bfrag = ld2x8(QB + (32 * tt + r) * HG_PQ + 32 * a + 16 * sp + 4 * hh); o = MFMA32(afrag, bfrag, o); }
        hgrn_state_update<4>(st, 0, vt, lds, r, hh);
        float ss = 0.f;
#pragma unroll
        for (int i = 0; i < 16; ++i) ss += o[i] * o[i];
        ss += __shfl_xor(ss, 32);
        if (hh == 0) SS[vt * 64 + 32 * tt + r] = ss;
#pragma unroll
        for (int g = 0; g < 4; ++g) { f32x4 v; v.x = o[4 * g]; v.y = o[4 * g + 1]; v.z = o[4 * g + 2]; v.w = o[4 * g + 3]; *(LAS f32x4*)(OT + (32 * tt + r) * 132 + 32 * vt + 8 * g + 4 * hh) = v; }
        __syncthreads();
        {   const int t = tid >> 3, cc = tid & 7;
            const float tot = (SS[t] + SS[64 + t]) + (SS[128 + t] + SS[192 + t]);
            const float rr = 1.0f / sqrtf(tot * (1.0f / 128.0f) + EPS);
            const v4u* gp = (const v4u*)(P1 + (row0 + t) * NP1 + 3072 + h * 128 + 16 * cc); const v4u g0 = gp[0], g1 = gp[1];
            const f32x4* np = (const f32x4*)(nw + h * 128 + 16 * cc);
            const LAS f32x4* op = (const LAS f32x4*)(OT + t * 132 + 16 * cc);
            const f32x4 o0 = op[0] * rr * np[0], o1 = op[1] * rr * np[1], o2 = op[2] * rr * np[2], o3 = op[3] * rr * np[3];
            v4u w0, w1;
            w0.x = pkbf(o0.x * bflo(g0.x), o0.y * bfhi(g0.x)); w0.y = pkbf(o0.z * bflo(g0.y), o0.w * bfhi(g0.y)); w0.z = pkbf(o1.x * bflo(g0.z), o1.y * bfhi(g0.z)); w0.w = pkbf(o1.z * bflo(g0.w), o1.w * bfhi(g0.w));
            w1.x = pkbf(o2.x * bflo(g1.x), o2.y * bfhi(g1.x)); w1.y = pkbf(o2.z * bflo(g1.y), o2.w * bfhi(g1.y)); w1.z = pkbf(o3.x * bflo(g1.z), o3.y * bfhi(g1.z)); w1.w = pkbf(o3.z * bflo(g1.w), o3.w * bfhi(g1.w));
            v4u* dst = (v4u*)(OG + (row0 + t) * DM + h * 128 + 16 * cc); dst[0] = w0; dst[1] = w1;
        }
    }
    __syncthreads();
}
constexpr int NS_P = 72;
constexpr int NS_TILE = 64 * NS_P * 2;
constexpr int NS_IMP = 4 * NS_TILE, NS_TL = NS_IMP + 32768, NS_UN = NS_TL + 1024, NS_OT = NS_UN + 256;
constexpr float NS_LOG2E = 1.4426950408889634f;
enum { NK_CMP1 = 0, NK_CMP2 = 1, NK_SLC = 2, NK_WIN = 3 };
struct NsaSrc { const bf16* K; const bf16* V; int pitch; };
struct NsaLane {
    bf16x8 qf[4]; float slope2;
    int tloc; int nmax; unsigned long long sel_lo, sel_hi;
};
__device__ __forceinline__ unsigned wave_max_u32(unsigned v) {
#pragma unroll
    for (int o = 1; o < 64; o <<= 1) { const unsigned t = (unsigned)__shfl_xor((int)v, o); v = v > t ? v : t; }
    return v;
}
__device__ __forceinline__ unsigned umax_(unsigned a, unsigned b) { return a > b ? a : b; }
__device__ __forceinline__ unsigned wave_max_u32_fast(unsigned v) {
    v = umax_(v, (unsigned)__builtin_amdgcn_update_dpp(0, (int)v, 0xB1, 0xf, 0xf, false));
    v = umax_(v, (unsigned)__builtin_amdgcn_update_dpp(0, (int)v, 0x4E, 0xf, 0xf, false));
    v = umax_(v, (unsigned)__builtin_amdgcn_update_dpp(0, (int)v, 0x141, 0xf, 0xf, false));
    v = umax_(v, (unsigned)__builtin_amdgcn_update_dpp(0, (int)v, 0x140, 0xf, 0xf, false));
    { auto sw = __builtin_amdgcn_permlane16_swap(v, v, false, false); const unsigned a = sw[0], b = sw[1]; v = umax_(a, b); }
    { auto sw = __builtin_amdgcn_permlane32_swap(v, v, false, false); const unsigned a = sw[0], b = sw[1]; v = umax_(a, b); }
    return v;
}
__device__ __forceinline__ void nsa_gload(const NsaSrc& S, int row0, int tid, v4u& kreg, v4u& vreg) {
    const int kr = row0 + (tid >> 3), vr = row0 + (tid & 63);
    kreg = *(const v4u*)(S.K + (size_t)(kr < 0 ? 0 : kr) * S.pitch + 8 * (tid & 7));
    vreg = *(const v4u*)(S.V + (size_t)(vr < 0 ? 0 : vr) * S.pitch + 8 * (tid >> 6));
}
__device__ __forceinline__ void nsa_lstore(LAS unsigned char* buf, int tid, const v4u& kreg, const v4u& vreg) {
    *(LAS v4u*)(buf + ((tid >> 3) * NS_P + 8 * (tid & 7)) * 2) = kreg;
    LAS bf16* vt = (LAS bf16*)(buf + NS_TILE) + (8 * (tid >> 6)) * NS_P + (tid & 63);
    vt[0 * NS_P] = (bf16)(vreg.x & 0xffffu); vt[1 * NS_P] = (bf16)(vreg.x >> 16); vt[2 * NS_P] = (bf16)(vreg.y & 0xffffu); vt[3 * NS_P] = (bf16)(vreg.y >> 16);
    vt[4 * NS_P] = (bf16)(vreg.z & 0xffffu); vt[5 * NS_P] = (bf16)(vreg.z >> 16); vt[6 * NS_P] = (bf16)(vreg.w & 0xffffu); vt[7 * NS_P] = (bf16)(vreg.w >> 16);
}
template <int KIND, int MODE>
__device__ __forceinline__ void nsa_compute_m(const LAS unsigned char* buf, int blk, int j0, const NsaLane& L, float& m, float& l, float inv_l, f32x16 (&O)[2], LAS float* impw, int r, int hh) {
    const LAS bf16* Ks = (const LAS bf16*)buf; const LAS bf16* Vt = (const LAS bf16*)(buf + NS_TILE);
    bool rowsel = true;
    if (KIND == NK_SLC) rowsel = (((blk < 64 ? L.sel_lo : L.sel_hi) >> (blk & 63)) & 1ull) != 0ull;
    f32x16 sa[2];
#pragma unroll
    for (int kt = 0; kt < 2; ++kt) {
        { const bf16x8 a = *(const LAS bf16x8*)(Ks + (32 * kt + r) * NS_P + 8 * hh); const f32x16 z16 = {}; sa[kt] = MFMA32(a, L.qf[0], z16); }
#pragma unroll
        for (int s = 1; s < 4; ++s) { const bf16x8 a = *(const LAS bf16x8*)(Ks + (32 * kt + r) * NS_P + 16 * s + 8 * hh); sa[kt] = MFMA32(a, L.qf[s], sa[kt]); }
    }
    const float NEG = -__builtin_inff();
    float cb[2], mxk[2];
#pragma unroll
    for (int kt = 0; kt < 2; ++kt) {
        int lim;
        if (KIND == NK_CMP1 || KIND == NK_CMP2) { lim = L.nmax - 64 * blk - 32 * kt - 4 * hh; cb[kt] = -L.slope2 * (float)(64 * j0 + L.tloc - 31 - 16 * (64 * blk + 32 * kt + 4 * hh)); }
        else { lim = L.tloc - 32 * kt - 4 * hh; cb[kt] = -L.slope2 * (float)(64 * j0 + L.tloc - 64 * blk - 32 * kt - 4 * hh); }
        if (KIND == NK_SLC) cb[kt] = rowsel ? cb[kt] : NEG;
        float mx = NEG;
#pragma unroll
        for (int i = 0; i < 16; ++i) {
            const int kc = (i & 3) + 8 * (i >> 2);
            const float kcf = (KIND == NK_CMP1 || KIND == NK_CMP2) ? 16.0f * (float)kc : (float)kc;
            float s2 = __builtin_fmaf(L.slope2, kcf, sa[kt][i]);
            if (MODE == 1) s2 = (kc <= lim) ? s2 : NEG; else if (MODE == 2) s2 = (kc > lim) ? s2 : NEG;
            sa[kt][i] = s2; mx = fmaxf(mx, s2);
        }
        mxk[kt] = mx;
    }
    if (KIND == NK_CMP2) {
#pragma unroll
        for (int kt = 0; kt < 2; ++kt) { const float off = m - cb[kt];
#pragma unroll
            for (int i = 0; i < 16; ++i) sa[kt][i] = __builtin_amdgcn_exp2f(sa[kt][i] - off) * inv_l; }
#pragma unroll
        for (int kt = 0; kt < 2; ++kt)
#pragma unroll
            for (int gq = 0; gq < 4; ++gq) {
                float a = (sa[kt][4 * gq] + sa[kt][4 * gq + 1]) + (sa[kt][4 * gq + 2] + sa[kt][4 * gq + 3]), last = sa[kt][4 * gq + 3];
                a += __builtin_bit_cast(float, __builtin_amdgcn_update_dpp(0, __builtin_bit_cast(int, a), 0xB1, 0xf, 0xf, false)); a += __builtin_bit_cast(float, __builtin_amdgcn_update_dpp(0, __builtin_bit_cast(int, a), 0x4E, 0xf, 0xf, false));
                last += __builtin_bit_cast(float, __builtin_amdgcn_update_dpp(0, __builtin_bit_cast(int, last), 0xB1, 0xf, 0xf, false)); last += __builtin_bit_cast(float, __builtin_amdgcn_update_dpp(0, __builtin_bit_cast(int, last), 0x4E, 0xf, 0xf, false));
                const int jg = 16 * blk + 8 * kt + 2 * gq + hh;
                if ((r & 3) == 0 && jg < 128) { LAS float* ip = impw + (r >> 2) * 128 + jg;
                    __hip_atomic_fetch_add(ip, a, __ATOMIC_RELAXED, __HIP_MEMORY_SCOPE_WORKGROUP);
                    if (jg + 1 < 128) __hip_atomic_fetch_add(ip + 1, last, __ATOMIC_RELAXED, __HIP_MEMORY_SCOPE_WORKGROUP); }
            }
    } else {
        float mt = fmaxf(mxk[0] + cb[0], mxk[1] + cb[1]);
        { auto sw = __builtin_amdgcn_permlane32_swap(__builtin_bit_cast(unsigned, mt), __builtin_bit_cast(unsigned, mt), false, false); const unsigned a_ = sw[0], b_ = sw[1]; mt = fmaxf(__builtin_bit_cast(float, a_), __builtin_bit_cast(float, b_)); }
        const float mn = fmaxf(m, mt), alpha = __builtin_amdgcn_exp2f(m - mn); m = mn;
        float ls = 0.f;
#pragma unroll
        for (int kt = 0; kt < 2; ++kt) { const float off = mn - cb[kt];
#pragma unroll
            for (int i = 0; i < 16; ++i) { const float p = __builtin_amdgcn_exp2f(sa[kt][i] - off); sa[kt][i] = p; ls += p; } }
        l = l * alpha + ls;
        if (KIND == NK_CMP1) return;
#pragma unroll
        for (int dt = 0; dt < 2; ++dt)
#pragma unroll
            for (int i = 0; i < 16; ++i) O[dt][i] *= alpha;
    }
#pragma unroll
    for (int kt = 0; kt < 2; ++kt)
#pragma unroll
        for (int sp = 0; sp < 2; ++sp) { const bf16x8 pb = pack8(sa[kt], sp);
#pragma unroll
            for (int dt = 0; dt < 2; ++dt) { const bf16x8 va = ld2x8(Vt + (32 * dt + r) * NS_P + 32 * kt + 16 * sp + 4 * hh); O[dt] = MFMA32(va, pb, O[dt]); } }
}
template <int KIND>
__device__ __forceinline__ void nsa_compute(const LAS unsigned char* buf, int blk, int j0, const NsaLane& L, float& m, float& l, float inv_l, f32x16 (&O)[2], LAS float* impw, int r, int hh) {
    if (KIND == NK_CMP1 || KIND == NK_CMP2) {
        const int nmin = (64 * j0 >= 31) ? ((64 * j0 - 31) >> 4) : -1;
        if (64 * blk + 63 <= nmin) nsa_compute_m<KIND, 0>(buf, blk, j0, L, m, l, inv_l, O, impw, r, hh); else nsa_compute_m<KIND, 1>(buf, blk, j0, L, m, l, inv_l, O, impw, r, hh);
        return; }
    if (blk == j0) { nsa_compute_m<KIND, 1>(buf, blk, j0, L, m, l, inv_l, O, impw, r, hh); return; }
    if (KIND == NK_WIN && blk == j0 - 8) { nsa_compute_m<KIND, 2>(buf, blk, j0, L, m, l, inv_l, O, impw, r, hh); return; }
    nsa_compute_m<KIND, 0>(buf, blk, j0, L, m, l, inv_l, O, impw, r, hh);
}
#if NSA_PIPE
#if NSA_FENCES
#define NSA_FENCE __builtin_amdgcn_sched_barrier(0)
#else
#define NSA_FENCE
#endif
__device__ __forceinline__ void nsa_lstore2(LAS unsigned char* kb, LAS unsigned char* vb, int tid, const v4u& kreg, const v4u& vreg) {
    *(LAS v4u*)(kb + ((tid >> 3) * NS_P + 8 * (tid & 7)) * 2) = kreg;
    LAS bf16* vt = (LAS bf16*)vb + (8 * (tid >> 6)) * NS_P + (tid & 63);
    vt[0 * NS_P] = (bf16)(vreg.x & 0xffffu); vt[1 * NS_P] = (bf16)(vreg.x >> 16); vt[2 * NS_P] = (bf16)(vreg.y & 0xffffu); vt[3 * NS_P] = (bf16)(vreg.y >> 16);
    vt[4 * NS_P] = (bf16)(vreg.z & 0xffffu); vt[5 * NS_P] = (bf16)(vreg.z >> 16); vt[6 * NS_P] = (bf16)(vreg.w & 0xffffu); vt[7 * NS_P] = (bf16)(vreg.w >> 16);
}
__device__ __forceinline__ void nsa_qk(const LAS unsigned char* kn, const NsaLane& L, f32x16 (&sn)[2], int r, int hh) {
    const LAS bf16* Ks = (const LAS bf16*)kn;
#pragma unroll
    for (int kt = 0; kt < 2; ++kt) {
        { const bf16x8 a = *(const LAS bf16x8*)(Ks + (32 * kt + r) * NS_P + 8 * hh); const f32x16 z16 = {}; sn[kt] = MFMA32(a, L.qf[0], z16); }
#pragma unroll
        for (int s = 1; s < 4; ++s) { const bf16x8 a = *(const LAS bf16x8*)(Ks + (32 * kt + r) * NS_P + 16 * s + 8 * hh); sn[kt] = MFMA32(a, L.qf[s], sn[kt]); }
    }
}
template <int KIND, int MODE>
__device__ __forceinline__ void nsa_step_m(const LAS unsigned char* kn, const LAS unsigned char* vp, int blk, int j0, const NsaLane& L, float& m, float& l, f32x16 (&O)[2], f32x16 (&sa)[2], f32x16 (&sn)[2], int r, int hh) {
    const LAS bf16* Ks = (const LAS bf16*)kn; const LAS bf16* Vt = (const LAS bf16*)vp;
    bf16x8 kf[8];
#define NS_KF(c) (*(const LAS bf16x8*)(Ks + (32 * ((c) >> 2) + r) * NS_P + 16 * ((c) & 3) + 8 * hh))
    kf[0] = NS_KF(0); kf[1] = NS_KF(1); kf[2] = NS_KF(2);
    bool rowsel = true;
    if (KIND == NK_SLC) rowsel = (((blk < 64 ? L.sel_lo : L.sel_hi) >> (blk & 63)) & 1ull) != 0ull;
    const float NEG = -__builtin_inff();
    const f32x16 z16 = {};
    float cb[2], mxk[2];
#pragma unroll
    for (int kt = 0; kt < 2; ++kt) {
        const int lim = L.tloc - 32 * kt - 4 * hh; cb[kt] = -L.slope2 * (float)(64 * j0 + L.tloc - 64 * blk - 32 * kt - 4 * hh);
        if (KIND == NK_SLC) cb[kt] = rowsel ? cb[kt] : NEG;
        float mx = NEG;
#pragma unroll
        for (int q4 = 0; q4 < 4; ++q4) {
            if (4 * kt + q4 + 3 < 8) kf[4 * kt + q4 + 3] = NS_KF(4 * kt + q4 + 3);
            if (q4 == 0) sn[kt] = MFMA32(kf[4 * kt], L.qf[0], z16); else sn[kt] = MFMA32(kf[4 * kt + q4], L.qf[q4], sn[kt]);
#pragma unroll
            for (int i = 4 * q4; i < 4 * q4 + 4; ++i) {
                const int kc = (i & 3) + 8 * (i >> 2);
                float s2 = __builtin_fmaf(L.slope2, (float)kc, sa[kt][i]);
                if (MODE == 1) s2 = (kc <= lim) ? s2 : NEG; else if (MODE == 2) s2 = (kc > lim) ? s2 : NEG;
                sa[kt][i] = s2; mx = fmaxf(mx, s2);
            }
            NSA_FENCE;
        }
        mxk[kt] = mx;
    }
    float mt = fmaxf(mxk[0] + cb[0], mxk[1] + cb[1]);
    { auto sw = __builtin_amdgcn_permlane32_swap(__builtin_bit_cast(unsigned, mt), __builtin_bit_cast(unsigned, mt), false, false); const unsigned a_ = sw[0], b_ = sw[1]; mt = fmaxf(__builtin_bit_cast(float, a_), __builtin_bit_cast(float, b_)); }
    const float mn = fmaxf(m, mt), alpha = __builtin_amdgcn_exp2f(m - mn); m = mn;
#undef NS_KF
    bf16x8 vf[2][2][2];
#define NS_VF(kt, sp, dt) ld2x8(Vt + (32 * (dt) + r) * NS_P + 32 * (kt) + 16 * (sp) + 4 * hh)
#pragma unroll
    for (int sp = 0; sp < 2; ++sp)
#pragma unroll
        for (int dt = 0; dt < 2; ++dt) vf[0][sp][dt] = NS_VF(0, sp, dt);
#pragma unroll
    for (int dt = 0; dt < 2; ++dt)
#pragma unroll
        for (int i = 0; i < 16; ++i) O[dt][i] *= alpha;
    float ls = 0.f;
    const float off0 = mn - cb[0], off1 = mn - cb[1];
#pragma unroll
    for (int i = 0; i < 16; ++i) { const float p = __builtin_amdgcn_exp2f(sa[0][i] - off0); sa[0][i] = p; ls += p; }
    bf16x8 pb0[2]; pb0[0] = pack8(sa[0], 0); pb0[1] = pack8(sa[0], 1);
    NSA_FENCE;
#pragma unroll
    for (int j = 0; j < 4; ++j) {
        vf[1][j >> 1][j & 1] = NS_VF(1, j >> 1, j & 1);
        O[j & 1] = MFMA32(vf[0][j >> 1][j & 1], pb0[j >> 1], O[j & 1]);
#pragma unroll
        for (int i = 4 * j; i < 4 * j + 4; ++i) { const float p = __builtin_amdgcn_exp2f(sa[1][i] - off1); sa[1][i] = p; ls += p; }
        NSA_FENCE;
    }
    l = l * alpha + ls;
#pragma unroll
    for (int sp = 0; sp < 2; ++sp) { const bf16x8 pb = pack8(sa[1], sp);
#pragma unroll
        for (int dt = 0; dt < 2; ++dt) O[dt] = MFMA32(vf[1][sp][dt], pb, O[dt]); }
#undef NS_VF
}
template <int MODE>
__device__ __forceinline__ void nsa_mask(f32x16 (&sa)[2], const NsaLane& L, int hh) {
    const float NEG = -__builtin_inff();
#pragma unroll
    for (int kt = 0; kt < 2; ++kt) { const int lim = L.tloc - 32 * kt - 4 * hh;
#pragma unroll
        for (int i = 0; i < 16; ++i) { const int kc = (i & 3) + 8 * (i >> 2); const bool keep = (MODE == 1) ? (kc <= lim) : (kc > lim); sa[kt][i] = keep ? sa[kt][i] : NEG; } }
}
template <int KIND>
__device__ __forceinline__ void nsa_step(const LAS unsigned char* kn, const LAS unsigned char* vp, int blk, int j0, const NsaLane& L, float& m, float& l, f32x16 (&O)[2], f32x16 (&sa)[2], f32x16 (&sn)[2], int r, int hh) {
    if (blk == j0) nsa_mask<1>(sa, L, hh);
    else if (KIND == NK_WIN && blk == j0 - 8) nsa_mask<2>(sa, L, hh);
    nsa_step_m<KIND, 0>(kn, vp, blk, j0, L, m, l, O, sa, sn, r, hh);
}
template <int KIND>
__device__ __forceinline__ void nsa_run_pipe(const NsaSrc& S, const LAS int* TL, int n, int j0, const NsaLane& L, float& m, float& l, f32x16 (&O)[2], LAS unsigned char* lds, unsigned long long wun_lo, unsigned long long wun_hi, int tid, int r, int hh) {
    __syncthreads();
    v4u ka_, va_;
    if (n > 0) nsa_gload(S, 64 * TL[0], tid, ka_, va_);
    f32x16 sA[2], sB[2];
    int vcur = 0, pblk = 0; bool pact = false; LAS unsigned char* pv = lds + NS_TILE;
#define NSA_STEP(i_, KB, kreg, vreg, sp_, sn_) { const int ii = (i_); const bool has = ii < n; \
        LAS unsigned char* vb = lds + (vcur == 0 ? NS_TILE : (vcur == 1 ? 3 * NS_TILE : NS_IMP)); \
        if (has) nsa_lstore2(KB, vb, tid, kreg, vreg); \
        int blk = 0; bool act = false; \
        if (has) { blk = TL[ii]; if (ii + 1 < n) nsa_gload(S, 64 * TL[ii + 1], tid, kreg, vreg); \
            act = (KIND != NK_SLC) || ((((blk < 64 ? wun_lo : wun_hi) >> (blk & 63)) & 1ull) != 0ull); } \
        __syncthreads(); \
        if (pact) nsa_step<KIND>(KB, pv, pblk, j0, L, m, l, O, sp_, sn_, r, hh); \
        else if (act) nsa_qk(KB, L, sn_, r, hh); \
        pblk = blk; pact = act; pv = vb; vcur = (vcur == 2) ? 0 : vcur + 1; }
    for (int i = 0; i <= n; i += 2) {
        NSA_STEP(i, lds, ka_, va_, sB, sA)
        if (i + 1 <= n) NSA_STEP(i + 1, lds + 2 * NS_TILE, ka_, va_, sA, sB)
    }
#undef NSA_STEP
}
#endif
#if NSA_DMA
#define ND_SBAR() __builtin_amdgcn_sched_barrier(0)
#define ND_PIN(x) asm volatile("" : "+v"(x))
#define ND_WAIT_BAR(N) asm volatile("s_waitcnt vmcnt(" #N ") lgkmcnt(0)\n\ts_barrier" ::: "memory")
#define ND_MX3(a, b, c) __builtin_fmaxf(__builtin_fmaxf((a), (b)), (c))
constexpr int ND_SLOT = 8192, ND_K = 0, ND_V = 3 * ND_SLOT;
constexpr float ND_THR = 8.0f;
typedef LAS const char* nd_lptr;
typedef short nd_s16x4 __attribute__((ext_vector_type(4)));
__device__ __forceinline__ unsigned nd_cvtpk(float lo, float hi) { unsigned r; asm("v_cvt_pk_bf16_f32 %0, %1, %2" : "=v"(r) : "v"(lo), "v"(hi)); return r; }
__device__ __forceinline__ void nd_glds16(const void* g, unsigned lds_base) {
    unsigned sv; asm volatile("s_mov_b32 %0, m0\n\ts_mov_b32 m0, %2\n\ts_nop 0\n\tglobal_load_lds_dwordx4 %1, off\n\ts_mov_b32 m0, %0" : "=&s"(sv) : "v"(g), "s"(lds_base) : "memory"); }
__device__ __forceinline__ void nd_kload2(bf16x8* kf, nd_lptr kp, int d0) { kf[2 * d0] = *(const LAS bf16x8*)(kp + d0 * 2048); kf[2 * d0 + 1] = *(const LAS bf16x8*)(kp + d0 * 2048 + 512); }
__device__ __forceinline__ nd_s16x4 nd_vtr(nd_lptr p) { return __builtin_bit_cast(nd_s16x4, __builtin_amdgcn_ds_read_tr16_b64_v4i16((LAS nd_s16x4*)p)); }
__device__ __forceinline__ float nd_max16(const f32x16& p) {
    float a = ND_MX3(p[0], p[1], p[2]), b = ND_MX3(p[3], p[4], p[5]);
    a = ND_MX3(a, p[6], p[7]); b = ND_MX3(b, p[8], p[9]); a = ND_MX3(a, p[10], p[11]); b = ND_MX3(b, p[12], p[13]); a = ND_MX3(a, p[14], p[15]);
    return __builtin_fmaxf(a, b); }
template <int MODE>
__device__ __forceinline__ void nd_mask(f32x16& p0, f32x16& p1, int tloc, int hi) {
    const float NEG = -__builtin_inff(); const int lim = tloc - 4 * hi;
#pragma unroll
    for (int i = 0; i < 16; ++i) { const int kc = (i & 3) + 8 * (i >> 2);
        if (MODE == 1) { if (kc > lim) p0[i] = NEG; if (kc + 32 > lim) p1[i] = NEG; } else { if (kc <= lim) p0[i] = NEG; if (kc + 32 <= lim) p1[i] = NEG; } }
}
template <int KIND>
__device__ __forceinline__ void nsa_run_dma(const bf16* Kg, const bf16* Vg, const LAS int* TL, int n, int j0, const NsaLane& L, float& m_out, float& l_out, f32x16 (&o)[2], LAS unsigned char* lds, int tid, int r32, int hi) {
    const int lane = tid & 63; const int wid = __builtin_amdgcn_readfirstlane(tid >> 6);
    const unsigned lds0 = (unsigned)(size_t)lds;
    const bf16* ksrc = Kg + (size_t)lane * NP0 + wid * 8;
    const bf16* vsrc = Vg + (size_t)(16 * (wid & 3) + (lane >> 2)) * NP0 + (wid >> 2) * 32 + (lane & 3) * 8;
    const unsigned kdst = lds0 + ND_K + wid * 1024, vdst = lds0 + ND_V + wid * 1024;
#define ND_TL(t) TL[(t) < n ? (t) : n - 1]
#define ND_DMA_K(t, slot) nd_glds16(ksrc + (size_t)ND_TL(t) * (64 * NP0), (unsigned)__builtin_amdgcn_readfirstlane(kdst + (slot)))
#define ND_DMA_V(t, slot) nd_glds16(vsrc + (size_t)ND_TL(t) * (64 * NP0), (unsigned)__builtin_amdgcn_readfirstlane(vdst + (slot)))
    const nd_lptr vp0 = (nd_lptr)lds + ND_V + ((lane >> 4) & 1) * 32 + (lane & 3) * 8 + (4 * hi + ((lane & 15) >> 2)) * 64;
    const nd_lptr kp0 = (nd_lptr)lds + ND_K + hi * 1024 + r32 * 16;
    __syncthreads();
    ND_DMA_K(0, 0); ND_DMA_V(0, 0); ND_DMA_K(1, ND_SLOT); ND_DMA_K(2, 2 * ND_SLOT);
    f32x16 bias16;
#pragma unroll
    for (int i = 0; i < 16; ++i) bias16[i] = L.slope2 * (float)((i & 3) + 8 * (i >> 2));
    ND_PIN(bias16);
    const float NEGI = -__builtin_inff();
    const float posq = (float)(64 * j0 + L.tloc - 4 * hi), s32 = 32.0f * L.slope2;
    float mhat = 0.f, l_reg = 0.f, fsc = 1.0f; bool resc = false;
    f32x16 pA0, pA1, pB0, pB1; bf16x8 kf[8]; nd_s16x4 vlo[8], vhi[8]; v4u pw0, pw1, pw2, pw3;
    int sl_prev = 0, sl_cur = 0, sl_next = ND_SLOT;
#define ND_ROT() do { sl_prev = sl_cur; sl_cur = sl_next; sl_next = (sl_next == 2 * ND_SLOT) ? 0 : sl_next + ND_SLOT; } while (0)
#define ND_EX(v, nm) __builtin_amdgcn_exp2f((v) + (nm))
#define ND_RESC() do { if (resc) { _Pragma("unroll") for (int d_ = 0; d_ < 2; ++d_) _Pragma("unroll") for (int i_ = 0; i_ < 16; ++i_) o[d_][i_] *= fsc; } } while (0)
    ND_WAIT_BAR(3);
#pragma unroll
    for (int d0 = 0; d0 < 4; ++d0) nd_kload2(kf, kp0, d0);
    pA0 = MFMA32(kf[0], L.qf[0], bias16); pA1 = MFMA32(kf[1], L.qf[0], bias16); pA0 = MFMA32(kf[2], L.qf[1], pA0); pA1 = MFMA32(kf[3], L.qf[1], pA1);
    pA0 = MFMA32(kf[4], L.qf[2], pA0); pA1 = MFMA32(kf[5], L.qf[2], pA1); pA0 = MFMA32(kf[6], L.qf[3], pA0); pA1 = MFMA32(kf[7], L.qf[3], pA1);
    nd_mask<1>(pA0, pA1, L.tloc, hi);
    {   const float cb0 = -L.slope2 * (posq - (float)(64 * j0)), cb1 = cb0 + s32;
        float rm = __builtin_fmaxf(nd_max16(pA0) + cb0, nd_max16(pA1) + cb1);
        { auto sw = __builtin_amdgcn_permlane32_swap(__builtin_bit_cast(unsigned, rm), __builtin_bit_cast(unsigned, rm), false, false); const unsigned a_ = sw[0], b_ = sw[1]; rm = __builtin_fmaxf(__builtin_bit_cast(float, a_), __builtin_bit_cast(float, b_)); }
        mhat = rm; const float nm0 = cb0 - mhat, nm1 = cb1 - mhat;
#pragma unroll
        for (int i = 0; i < 16; ++i) { pA0[i] = ND_EX(pA0[i], nm0); pA1[i] = ND_EX(pA1[i], nm1); } }
    ND_WAIT_BAR(0);
    ND_DMA_K(3, 0); ND_DMA_V(1, ND_SLOT); ND_ROT();
#pragma unroll
    for (int d0 = 0; d0 < 4; ++d0) nd_kload2(kf, kp0 + sl_cur, d0);
    ND_WAIT_BAR(2);
#define ND_PKW(P, i) nd_cvtpk(P[i], P[(i) + 1])
#define ND_PAF(k) __builtin_bit_cast(bf16x8, pw##k)
#define ND_VFR(i) (bf16x8){vlo[i][0], vlo[i][1], vlo[i][2], vlo[i][3], vhi[i][0], vhi[i][1], vhi[i][2], vhi[i][3]}
#define ND_VRD(i) do { vlo[i] = nd_vtr(vp_ + (((i) >> 2) * 4096 + ((i) & 3) * 1024)); vhi[i] = nd_vtr(vp_ + (((i) >> 2) * 4096 + ((i) & 3) * 1024 + 512)); } while (0)
#define ND_KRD(d0) do { nd_kload2(kf, kp0 + sl_next, d0); ND_SBAR(); } while (0)
#define ND_GAPA(MF, a0, a1, a2, a3, W0, W1, PW) do { MF; sacc += a0; sacc += a1; sacc += a2; sacc += a3; W0; W1; ND_PIN(PW); ND_PIN(sacc); ND_SBAR(); } while (0)
#define ND_GAPB(MF, X, i, nm) do { MF; X[i] = ND_EX(X[i], nm); X[(i) + 1] = ND_EX(X[(i) + 1], nm); X[(i) + 2] = ND_EX(X[(i) + 2], nm); X[(i) + 3] = ND_EX(X[(i) + 3], nm); ND_PIN(X); ND_SBAR(); } while (0)
#define ND_STEP(C0, C1, P0, P1, t) do { ND_SBAR(); \
    const nd_lptr vp_ = vp0 + sl_prev; const int blk = __builtin_amdgcn_readfirstlane(ND_TL(t)); \
    float sacc = P0[0] + P0[1]; \
                       ND_GAPA(C0 = MFMA32(kf[0], L.qf[0], bias16), P0[2], P0[3], P0[4], P0[5],     pw0[0] = ND_PKW(P0, 0),  pw0[1] = ND_PKW(P0, 2),  pw0); \
                       ND_GAPA(C1 = MFMA32(kf[1], L.qf[0], bias16), P0[6], P0[7], P0[8], P0[9],     pw0[2] = ND_PKW(P0, 4),  pw0[3] = ND_PKW(P0, 6),  pw0); \
                       ND_GAPA(C0 = MFMA32(kf[2], L.qf[1], C0),     P0[10], P0[11], P0[12], P0[13], pw1[0] = ND_PKW(P0, 8),  pw1[1] = ND_PKW(P0, 10), pw1); \
                       ND_GAPA(C1 = MFMA32(kf[3], L.qf[1], C1),     P0[14], P0[15], P1[0], P1[1],   pw1[2] = ND_PKW(P0, 12), pw1[3] = ND_PKW(P0, 14), pw1); \
    ND_VRD(0); ND_SBAR(); ND_GAPA(C0 = MFMA32(kf[4], L.qf[2], C0),     P1[2], P1[3], P1[4], P1[5],     pw2[0] = ND_PKW(P1, 0),  pw2[1] = ND_PKW(P1, 2),  pw2); \
    ND_VRD(4); ND_SBAR(); ND_GAPA(C1 = MFMA32(kf[5], L.qf[2], C1),     P1[6], P1[7], P1[8], P1[9],     pw2[2] = ND_PKW(P1, 4),  pw2[3] = ND_PKW(P1, 6),  pw2); \
    ND_VRD(1); ND_SBAR(); ND_GAPA(C0 = MFMA32(kf[6], L.qf[3], C0),     P1[10], P1[11], P1[12], P1[13], pw3[0] = ND_PKW(P1, 8),  pw3[1] = ND_PKW(P1, 10), pw3); \
    ND_VRD(5); ND_SBAR(); ND_GAPA(C1 = MFMA32(kf[7], L.qf[3], C1),     P1[14], P1[15], 0.f, 0.f,       pw3[2] = ND_PKW(P1, 12), pw3[3] = ND_PKW(P1, 14), pw3); \
    l_reg += sacc; \
    ND_DMA_K((t) + 3, sl_cur); ND_DMA_V((t) + 1, sl_next); \
    float cb0 = -L.slope2 * (posq - (float)(64 * blk)), cb1 = cb0 + s32; \
    if (KIND == NK_SLC) { const bool rowsel = (((blk < 64 ? L.sel_lo : L.sel_hi) >> (blk & 63)) & 1ull) != 0ull; cb0 = rowsel ? cb0 : NEGI; cb1 = rowsel ? cb1 : NEGI; } \
    if (KIND == NK_WIN && blk == j0 - 8) nd_mask<2>(C0, C1, L.tloc, hi); \
    {   float rm = __builtin_fmaxf(nd_max16(C0) + cb0, nd_max16(C1) + cb1); \
        { auto sw = __builtin_amdgcn_permlane32_swap(__builtin_bit_cast(unsigned, rm), __builtin_bit_cast(unsigned, rm), false, false); const unsigned a_ = sw[0], b_ = sw[1]; rm = __builtin_fmaxf(__builtin_bit_cast(float, a_), __builtin_bit_cast(float, b_)); } \
        rm -= mhat; resc = false; \
        if (__builtin_expect(__any(rm > ND_THR), 0)) { const float dl = __builtin_fmaxf(rm, 0.f); mhat += dl; fsc = __builtin_amdgcn_exp2f(-dl); l_reg *= fsc; resc = true; } } \
    const float nm0 = cb0 - mhat, nm1 = cb1 - mhat; ND_SBAR(); \
    ND_VRD(2); ND_SBAR(); ND_GAPB(o[0] = MFMA32(ND_VFR(0), ND_PAF(0), o[0]), C0, 0, nm0); \
    ND_VRD(6); ND_SBAR(); ND_GAPB(o[1] = MFMA32(ND_VFR(4), ND_PAF(0), o[1]), C0, 4, nm0); \
    ND_VRD(3); ND_SBAR(); ND_GAPB(o[0] = MFMA32(ND_VFR(1), ND_PAF(1), o[0]), C0, 8, nm0); \
    ND_VRD(7); ND_SBAR(); ND_GAPB(o[1] = MFMA32(ND_VFR(5), ND_PAF(1), o[1]), C0, 12, nm0); \
    ND_KRD(0); ND_GAPB(o[0] = MFMA32(ND_VFR(2), ND_PAF(2), o[0]), C1, 0, nm1);    ND_KRD(1); ND_GAPB(o[1] = MFMA32(ND_VFR(6), ND_PAF(2), o[1]), C1, 4, nm1); \
    ND_KRD(2); ND_GAPB(o[0] = MFMA32(ND_VFR(3), ND_PAF(3), o[0]), C1, 8, nm1);    ND_KRD(3); ND_GAPB(o[1] = MFMA32(ND_VFR(7), ND_PAF(3), o[1]), C1, 12, nm1); \
    } while (0)
#define ND_DRAIN(P0, P1) do { float sacc = P0[0] + P0[1]; \
      _Pragma("unroll") for (int i_ = 2; i_ < 16; ++i_) sacc += P0[i_]; \
      _Pragma("unroll") for (int i_ = 0; i_ < 16; ++i_) sacc += P1[i_]; \
      l_reg += sacc; \
      pw0 = (v4u){ND_PKW(P0, 0), ND_PKW(P0, 2), ND_PKW(P0, 4), ND_PKW(P0, 6)}; pw1 = (v4u){ND_PKW(P0, 8), ND_PKW(P0, 10), ND_PKW(P0, 12), ND_PKW(P0, 14)}; \
      pw2 = (v4u){ND_PKW(P1, 0), ND_PKW(P1, 2), ND_PKW(P1, 4), ND_PKW(P1, 6)}; pw3 = (v4u){ND_PKW(P1, 8), ND_PKW(P1, 10), ND_PKW(P1, 12), ND_PKW(P1, 14)}; \
      const nd_lptr vp_ = vp0 + sl_prev; _Pragma("unroll") for (int i_ = 0; i_ < 8; ++i_) ND_VRD(i_); \
      o[0] = MFMA32(ND_VFR(0), ND_PAF(0), o[0]); o[1] = MFMA32(ND_VFR(4), ND_PAF(0), o[1]); o[0] = MFMA32(ND_VFR(1), ND_PAF(1), o[0]); o[1] = MFMA32(ND_VFR(5), ND_PAF(1), o[1]); \
      o[0] = MFMA32(ND_VFR(2), ND_PAF(2), o[0]); o[1] = MFMA32(ND_VFR(6), ND_PAF(2), o[1]); o[0] = MFMA32(ND_VFR(3), ND_PAF(3), o[0]); o[1] = MFMA32(ND_VFR(7), ND_PAF(3), o[1]); } while (0)
    int t = 1;
    for (; t + 1 < n; t += 2) {
        ND_STEP(pB0, pB1, pA0, pA1, t);     ND_WAIT_BAR(2); ND_RESC(); ND_ROT();
        ND_STEP(pA0, pA1, pB0, pB1, t + 1); ND_WAIT_BAR(2); ND_RESC(); ND_ROT();
    }
    if (t < n) { ND_STEP(pB0, pB1, pA0, pA1, t); ND_WAIT_BAR(2); ND_RESC(); ND_ROT(); ND_DRAIN(pB0, pB1); }
    else ND_DRAIN(pA0, pA1);
    asm volatile("s_waitcnt vmcnt(0) lgkmcnt(0)\n\ts_barrier" ::: "memory");
    m_out = mhat; l_out = l_reg;
#undef ND_TL
#undef ND_DMA_K
#undef ND_DMA_V
#undef ND_ROT
#undef ND_EX
#undef ND_RESC
#undef ND_PKW
#undef ND_PAF
#undef ND_VFR
#undef ND_VRD
#undef ND_KRD
#undef ND_GAPA
#undef ND_GAPB
#undef ND_STEP
#undef ND_DRAIN
}
#endif
template <int KIND>
__device__ __forceinline__ void nsa_run(const NsaSrc& S, const LAS int* TL, int n, int j0, const NsaLane& L, float& m, float& l, float inv_l, f32x16 (&O)[2], LAS unsigned char* lds, LAS float* impw, unsigned long long wun_lo, unsigned long long wun_hi, int tid, int r, int hh) {
    __syncthreads();
    v4u ka_, va_, kb_, vb_;
    if (n > 0) nsa_gload(S, 64 * TL[0], tid, ka_, va_);
    if (n > 1) nsa_gload(S, 64 * TL[1], tid, kb_, vb_);
    for (int i = 0; i < n; i += 2) {
        {   LAS unsigned char* buf = lds;
            nsa_lstore(buf, tid, ka_, va_);
            __syncthreads();
            const int blk = TL[i];
            if (i + 2 < n) nsa_gload(S, 64 * TL[i + 2], tid, ka_, va_);
            bool act = true;
            if (KIND == NK_SLC) act = (((blk < 64 ? wun_lo : wun_hi) >> (blk & 63)) & 1ull) != 0ull;
            if (act) nsa_compute<KIND>(buf, blk, j0, L, m, l, inv_l, O, impw, r, hh);
        }
        if (i + 1 < n) {
            LAS unsigned char* buf = lds + 2 * NS_TILE;
            nsa_lstore(buf, tid, kb_, vb_);
            __syncthreads();
            const int blk = TL[i + 1];
            if (i + 3 < n) nsa_gload(S, 64 * TL[i + 3], tid, kb_, vb_);
            bool act = true;
            if (KIND == NK_SLC) act = (((blk < 64 ? wun_lo : wun_hi) >> (blk & 63)) & 1ull) != 0ull;
            if (act) nsa_compute<KIND>(buf, blk, j0, L, m, l, inv_l, O, impw, r, hh);
        }
    }
}
__device__ __forceinline__ void nsa_unit(int unit, const bf16* P0, const bf16* KC, const bf16* VC, bf16* MIX, LAS unsigned char* lds, int tid) {
    const int bg = unit & 7, j0 = unit >> 3, g = bg & 1, b = bg >> 1;
    const int lane = tid & 63, w = __builtin_amdgcn_readfirstlane(tid >> 6), r = lane & 31, hh = lane >> 5, hd = r & 3;
    LAS float* IMP = (LAS float*)(lds + NS_IMP); LAS float* impw = IMP + w * 1024;
    LAS int* TL = (LAS int*)(lds + NS_TL); LAS unsigned* UN = (LAS unsigned*)(lds + NS_UN);
    NsaLane L;
    L.tloc = 8 * w + (r >> 2);
    const int t = 64 * j0 + L.tloc; const size_t row = (size_t)b * SEQ + t;
    L.nmax = t >= 31 ? min(NCMP - 1, (t - 31) >> 4) : -1;
    L.slope2 = exp2f(-(float)(g * 4 + hd + 1)) * NS_LOG2E;
#pragma unroll
    for (int s = 0; s < 4; ++s) L.qf[s] = *(const bf16x8*)(P0 + row * NP0 + C_Q + (g * 4 + hd) * 64 + 16 * s + 8 * hh);
    L.sel_lo = 0ull; L.sel_hi = 0ull;
#pragma unroll
    for (int i = 0; i < 4; ++i) *(LAS f32x4*)(impw + 4 * lane + 256 * i) = (f32x4){0.f, 0.f, 0.f, 0.f};
    if (tid < 4) UN[tid] = 0u;
    const int ncnt = min(NCMP, 4 * j0 + 3), nct = (ncnt + 63) >> 6;
    __syncthreads();
    if (tid < 16) TL[tid] = tid;
    const NsaSrc Sc{KC + (size_t)(b * 2 + g) * NCMP_PAD * 64, VC + (size_t)(b * 2 + g) * NCMP_PAD * 64, 64};
    f32x16 O[2];
    LAS float* otl = (LAS float*)(lds + NS_OT) + w * 2048 + lane;
#pragma unroll
    for (int dt = 0; dt < 2; ++dt)
#pragma unroll
        for (int i = 0; i < 16; ++i) O[dt][i] = 0.f;
    float m = -1e30f, l = 0.f;
    nsa_run<NK_CMP1>(Sc, TL, nct, j0, L, m, l, 0.f, O, lds, impw, 0ull, 0ull, tid, r, hh);
    l += __shfl_xor(l, 32);
    const float inv_c = 1.0f / fmaxf(l, 1e-30f);
    nsa_run<NK_CMP2>(Sc, TL, nct, j0, L, m, l, inv_c, O, lds, impw, 0ull, 0ull, tid, r, hh);
    const float g0 = bf2f(P0[row * NP0 + C_GT + (g * 4 + hd) * 3]);
#pragma unroll
    for (int dt = 0; dt < 2; ++dt)
#pragma unroll
        for (int i = 0; i < 16; ++i) { otl[(dt * 16 + i) * 64] = g0 * O[dt][i]; O[dt][i] = 0.f; }
    LDS_WAIT();
    unsigned long long wun_lo = 0ull, wun_hi = 0ull;
    if (j0 < 16) { const unsigned long long all = (2ull << j0) - 1ull; L.sel_lo = all; wun_lo = all; }
    else {
        unsigned ka[8], kb[8];
#pragma unroll
        for (int tk = 0; tk < 8; ++tk) {
#pragma unroll
            for (int q = 0; q < 2; ++q) { const int j = lane + 64 * q; const float v = impw[tk * 128 + j];
                const bool forced = (j == 0) || (j == j0) || (j == j0 - 1);
                const float val = forced ? 1e9f : (j <= j0 ? v : -1e30f);
                const unsigned key = (ord_key(val) & ~0x7Fu) | (unsigned)(127 - j);
                if (q == 0) ka[tk] = key; else kb[tk] = key; }
        }
        unsigned long long vun_lo = 0ull, vun_hi = 0ull;
#pragma unroll 1
        for (int it = 0; it < 16; ++it) {
#pragma unroll
            for (int tk = 0; tk < 8; ++tk) {
                const unsigned mx = wave_max_u32_fast(ka[tk] > kb[tk] ? ka[tk] : kb[tk]);
                const int idx = 127 - (int)(mx & 0x7Fu);
                const unsigned long long blo = idx < 64 ? (1ull << idx) : 0ull, bhi = idx < 64 ? 0ull : (1ull << (idx - 64));
                if (ka[tk] == mx) ka[tk] = 0u; if (kb[tk] == mx) kb[tk] = 0u;
                if ((r >> 2) == tk) { L.sel_lo |= blo; L.sel_hi |= bhi; }
                vun_lo |= blo; vun_hi |= bhi;
            }
        }
        wun_lo = ((unsigned long long)(unsigned)__builtin_amdgcn_readfirstlane((int)(vun_lo >> 32)) << 32) | (unsigned)__builtin_amdgcn_readfirstlane((int)vun_lo);
        wun_hi = ((unsigned long long)(unsigned)__builtin_amdgcn_readfirstlane((int)(vun_hi >> 32)) << 32) | (unsigned)__builtin_amdgcn_readfirstlane((int)vun_hi);
    }
    if (lane == 0) { atomicOr((unsigned*)(UN + 0), (unsigned)wun_lo); atomicOr((unsigned*)(UN + 1), (unsigned)(wun_lo >> 32)); atomicOr((unsigned*)(UN + 2), (unsigned)wun_hi); atomicOr((unsigned*)(UN + 3), (unsigned)(wun_hi >> 32)); }
    __syncthreads();
    int nsl = 0;
    {   unsigned long long ulo = (unsigned long long)UN[0] | ((unsigned long long)UN[1] << 32), uhi = (unsigned long long)UN[2] | ((unsigned long long)UN[3] << 32);
        if (j0 < 64) ulo &= ~(1ull << j0); else uhi &= ~(1ull << (j0 - 64));
        nsl = 1 + __builtin_popcountll(ulo) + __builtin_popcountll(uhi);
        if (tid == 0) { TL[0] = j0; int n = 1;
            while (uhi) { const int bpos = 63 - __builtin_clzll(uhi); TL[n++] = 64 + bpos; uhi &= ~(1ull << bpos); }
            while (ulo) { const int bpos = 63 - __builtin_clzll(ulo); TL[n++] = bpos; ulo &= ~(1ull << bpos); } }
    }
    const NsaSrc Ss{P0 + (size_t)b * SEQ * NP0 + C_KS + g * 64, P0 + (size_t)b * SEQ * NP0 + C_VS + g * 64, NP0};
    m = -1e30f; l = 0.f;
#if NSA_DMA && NSA_DMA_SLC
    nsa_run_dma<NK_SLC>(Ss.K, Ss.V, TL, nsl, j0, L, m, l, O, lds, tid, r, hh);
#elif NSA_PIPE && NSA_PIPE_SLC
    nsa_run_pipe<NK_SLC>(Ss, TL, nsl, j0, L, m, l, O, lds, wun_lo, wun_hi, tid, r, hh);
#else
    nsa_run<NK_SLC>(Ss, TL, nsl, j0, L, m, l, 0.f, O, lds, impw, wun_lo, wun_hi, tid, r, hh);
#endif
    l += __shfl_xor(l, 32);
    {   const float g1 = bf2f(P0[((size_t)b * SEQ + 64 * j0 + L.tloc) * NP0 + C_GT + (g * 4 + hd) * 3 + 1]);
        const float sc = g1 / fmaxf(l, 1e-30f);
#pragma unroll
        for (int dt = 0; dt < 2; ++dt)
#pragma unroll
            for (int i = 0; i < 16; ++i) { otl[(dt * 16 + i) * 64] += sc * O[dt][i]; O[dt][i] = 0.f; } }
    const int nw_ = min(9, j0 + 1);
    __syncthreads();
    if (tid < nw_) TL[tid] = j0 - tid;
    const NsaSrc Sw{P0 + (size_t)b * SEQ * NP0 + C_KW + g * 64, P0 + (size_t)b * SEQ * NP0 + C_VW + g * 64, NP0};
    m = -1e30f; l = 0.f;
#ifdef NSA_WIN_REP
    for (int rep2_ = 0; rep2_ < 2; ++rep2_) {
        m = -1e30f; l = 0.f;
#pragma unroll
        for (int dt = 0; dt < 2; ++dt)
#pragma unroll
            for (int i = 0; i < 16; ++i) O[dt][i] = 0.f;
        asm volatile("" ::: "memory");
#endif
#if NSA_DMA && NSA_DMA_WIN
    nsa_run_dma<NK_WIN>(Sw.K, Sw.V, TL, nw_, j0, L, m, l, O, lds, tid, r, hh);
#elif NSA_PIPE && NSA_PIPE_WIN
    nsa_run_pipe<NK_WIN>(Sw, TL, nw_, j0, L, m, l, O, lds, 0ull, 0ull, tid, r, hh);
#else
    nsa_run<NK_WIN>(Sw, TL, nw_, j0, L, m, l, 0.f, O, lds, impw, 0ull, 0ull, tid, r, hh);
#endif
#ifdef NSA_WIN_REP
    }
#endif
    l += __shfl_xor(l, 32);
    {   const float g2 = bf2f(P0[((size_t)b * SEQ + 64 * j0 + L.tloc) * NP0 + C_GT + (g * 4 + hd) * 3 + 2]);
        const float sc = g2 / fmaxf(l, 1e-30f);
#pragma unroll
        for (int dt = 0; dt < 2; ++dt)
#pragma unroll
            for (int i = 0; i < 16; ++i) O[dt][i] = otl[(dt * 16 + i) * 64] + sc * O[dt][i]; }
    bf16* orow = MIX + ((size_t)b * SEQ + 64 * j0 + L.tloc) * DM + 512 + (g * 4 + hd) * 64;
#pragma unroll
    for (int dt = 0; dt < 2; ++dt)
#pragma unroll
        for (int gq = 0; gq < 4; ++gq) { u32x2 v; v.x = pkbf(O[dt][4 * gq], O[dt][4 * gq + 1]); v.y = pkbf(O[dt][4 * gq + 2], O[dt][4 * gq + 3]); *(u32x2*)(orow + 32 * dt + 8 * gq + 4 * hh) = v; }
    __syncthreads();
}
constexpr int GM_P = 136;
__device__ __forceinline__ void gmlp_unit(int u, const bf16* P0, const float* lnw, const bf16* WSTRIL, const float* bs, bf16* MIX, LAS unsigned char* lds, int tid) {
    LAS bf16* VnT = (LAS bf16*)lds;
    const int g = u & 3, row0 = (u >> 2) * 128;
    {   const int rr = tid >> 2, q = tid & 3;
        const v4u* src = (const v4u*)(P0 + (size_t)(row0 + rr) * NP0 + C_V + g * 128 + q * 32);
        float v[32]; float s = 0.f;
#pragma unroll
        for (int c = 0; c < 4; ++c) { const v4u x = src[c]; v[8 * c] = bflo(x.x); v[8 * c + 1] = bfhi(x.x); v[8 * c + 2] = bflo(x.y); v[8 * c + 3] = bfhi(x.y); v[8 * c + 4] = bflo(x.z); v[8 * c + 5] = bfhi(x.z); v[8 * c + 6] = bflo(x.w); v[8 * c + 7] = bfhi(x.w); }
#pragma unroll
        for (int i = 0; i < 32; ++i) s += v[i];
        s += __shfl_xor(s, 1); s += __shfl_xor(s, 2);
        const float mean = s * (1.0f / 128.0f); float q2 = 0.f;
#pragma unroll
        for (int i = 0; i < 32; ++i) { const float d = v[i] - mean; q2 += d * d; }
        q2 += __shfl_xor(q2, 1); q2 += __shfl_xor(q2, 2);
        const float rstd = 1.0f / sqrtf(q2 * (1.0f / 128.0f) + EPS);
        const f32x4* lw = (const f32x4*)(lnw + g * 128 + q * 32);
#pragma unroll
        for (int c = 0; c < 8; ++c) { const f32x4 w4 = lw[c];
            VnT[(q * 32 + 4 * c + 0) * GM_P + rr] = (bf16)(pkbf((v[4 * c + 0] - mean) * rstd * w4.x, 0.f) & 0xffffu);
            VnT[(q * 32 + 4 * c + 1) * GM_P + rr] = (bf16)(pkbf((v[4 * c + 1] - mean) * rstd * w4.y, 0.f) & 0xffffu);
            VnT[(q * 32 + 4 * c + 2) * GM_P + rr] = (bf16)(pkbf((v[4 * c + 2] - mean) * rstd * w4.z, 0.f) & 0xffffu);
            VnT[(q * 32 + 4 * c + 3) * GM_P + rr] = (bf16)(pkbf((v[4 * c + 3] - mean) * rstd * w4.w, 0.f) & 0xffffu); }
    }
    __syncthreads();
    {   const int lane = tid & 63, w = tid >> 6, r = lane & 31, hh = lane >> 5, tt = w >> 1, dh = w & 1;
        f32x16 acc[2];
#pragma unroll
        for (int i = 0; i < 16; ++i) { acc[0][i] = 0.f; acc[1][i] = 0.f; }
        const bf16* wrow = WSTRIL + ((size_t)(g * 128 + 32 * tt + r)) * 128 + 8 * hh;
        const int nks = 2 * (tt + 1);
        for (int ks = 0; ks < nks; ++ks) {
            const bf16x8 a = *(const bf16x8*)(wrow + 16 * ks);
#pragma unroll
            for (int dd = 0; dd < 2; ++dd) { const bf16x8 bv = *(const LAS bf16x8*)(VnT + (32 * (2 * dh + dd) + r) * GM_P + 16 * ks + 8 * hh); acc[dd] = MFMA32(a, bv, acc[dd]); }
        }
#pragma unroll
        for (int dd = 0; dd < 2; ++dd)
#pragma unroll
            for (int i = 0; i < 16; ++i) { const int t = 32 * tt + (i & 3) + 8 * (i >> 2) + 4 * hh, d = 32 * (2 * dh + dd) + r;
                const float mixed = acc[dd][i] + bs[g * 128 + t];
                const float uu = bf2f(P0[(size_t)(row0 + t) * NP0 + C_U + g * 128 + d]);
                MIX[(size_t)(row0 + t) * DM + g * 128 + d] = (bf16)(pkbf(uu * mixed, 0.f) & 0xffffu); }
    }
    __syncthreads();
}
__device__ __forceinline__ void gmlp_run(int ubase, int ucnt, int ustep, const bf16* P0, const float* lnw, const bf16* WSTRIL, const float* bs, bf16* MIX, LAS unsigned char* lds, int tid) {
    const int g = ubase & 3;
    const int rr = tid >> 2, q = tid & 3;
    const int lane = tid & 63, w = tid >> 6, r = lane & 31, hh = lane >> 5, tt = w >> 1, dh = w & 1;
    const int nks = 2 * (tt + 1);
    bf16x8 a[8];
    const bf16* wrow = WSTRIL + ((size_t)(g * 128 + 32 * tt + r)) * 128 + 8 * hh;
#pragma unroll
    for (int ks = 0; ks < 8; ++ks) a[ks] = *(const bf16x8*)(wrow + 16 * ks);
    float bsv[16];
#pragma unroll
    for (int i = 0; i < 16; ++i) bsv[i] = bs[g * 128 + 32 * tt + (i & 3) + 8 * (i >> 2) + 4 * hh];
    f32x4 lw[8];
#pragma unroll
    for (int c = 0; c < 8; ++c) lw[c] = *((const f32x4*)(lnw + g * 128 + q * 32) + c);
    v4u vraw[4];
    {   const v4u* src = (const v4u*)(P0 + (size_t)((ubase >> 2) * 128 + rr) * NP0 + C_V + g * 128 + q * 32);
#pragma unroll
        for (int c = 0; c < 4; ++c) vraw[c] = src[c]; }
    for (int k = 0; k < ucnt; ++k) {
        const int u = ubase + ustep * k, row0 = (u >> 2) * 128;
        LAS bf16* VnT = (LAS bf16*)(lds + (k & 1) * (128 * GM_P * 2));
        bf16 uu[2][16];
#pragma unroll
        for (int dd = 0; dd < 2; ++dd)
#pragma unroll
            for (int i = 0; i < 16; ++i) { const int t = 32 * tt + (i & 3) + 8 * (i >> 2) + 4 * hh, d = 32 * (2 * dh + dd) + r;
                uu[dd][i] = P0[(size_t)(row0 + t) * NP0 + C_U + g * 128 + d]; }
        {   float v[32]; float s = 0.f;
#pragma unroll
            for (int c = 0; c < 4; ++c) { const v4u x = vraw[c]; v[8 * c] = bflo(x.x); v[8 * c + 1] = bfhi(x.x); v[8 * c + 2] = bflo(x.y); v[8 * c + 3] = bfhi(x.y); v[8 * c + 4] = bflo(x.z); v[8 * c + 5] = bfhi(x.z); v[8 * c + 6] = bflo(x.w); v[8 * c + 7] = bfhi(x.w); }
            if (k + 1 < ucnt) { const v4u* src = (const v4u*)(P0 + (size_t)(((u + ustep) >> 2) * 128 + rr) * NP0 + C_V + g * 128 + q * 32);
#pragma unroll
                for (int c = 0; c < 4; ++c) vraw[c] = src[c]; }
#pragma unroll
            for (int i = 0; i < 32; ++i) s += v[i];
            s += __shfl_xor(s, 1); s += __shfl_xor(s, 2);
            const float mean = s * (1.0f / 128.0f); float q2 = 0.f;
#pragma unroll
            for (int i = 0; i < 32; ++i) { const float d = v[i] - mean; q2 += d * d; }
            q2 += __shfl_xor(q2, 1); q2 += __shfl_xor(q2, 2);
            const float rstd = 1.0f / sqrtf(q2 * (1.0f / 128.0f) + EPS);
#pragma unroll
            for (int c = 0; c < 8; ++c) { const f32x4 w4 = lw[c];
                VnT[(q * 32 + 4 * c + 0) * GM_P + rr] = (bf16)(pkbf((v[4 * c + 0] - mean) * rstd * w4.x, 0.f) & 0xffffu);
                VnT[(q * 32 + 4 * c + 1) * GM_P + rr] = (bf16)(pkbf((v[4 * c + 1] - mean) * rstd * w4.y, 0.f) & 0xffffu);
                VnT[(q * 32 + 4 * c + 2) * GM_P + rr] = (bf16)(pkbf((v[4 * c + 2] - mean) * rstd * w4.z, 0.f) & 0xffffu);
                VnT[(q * 32 + 4 * c + 3) * GM_P + rr] = (bf16)(pkbf((v[4 * c + 3] - mean) * rstd * w4.w, 0.f) & 0xffffu); }
        }
        __syncthreads();
        f32x16 acc[2];
#pragma unroll
        for (int i = 0; i < 16; ++i) { acc[0][i] = 0.f; acc[1][i] = 0.f; }
#pragma unroll
        for (int ks = 0; ks < 8; ++ks) if (ks < nks) {
#pragma unroll
            for (int dd = 0; dd < 2; ++dd) { const bf16x8 bv = *(const LAS bf16x8*)(VnT + (32 * (2 * dh + dd) + r) * GM_P + 16 * ks + 8 * hh); acc[dd] = MFMA32(a[ks], bv, acc[dd]); }
        }
#pragma unroll
        for (int dd = 0; dd < 2; ++dd)
#pragma unroll
            for (int i = 0; i < 16; ++i) { const int t = 32 * tt + (i & 3) + 8 * (i >> 2) + 4 * hh, d = 32 * (2 * dh + dd) + r;
                MIX[(size_t)(row0 + t) * DM + g * 128 + d] = (bf16)(pkbf(bf2f(uu[dd][i]) * (acc[dd][i] + bsv[i]), 0.f) & 0xffffu); }
    }
    __syncthreads();
}
__device__ __forceinline__ void compress_unit(int cu, const bf16* P0, const bf16* W1T, const bf16* W2T, const float* BIAS1, bf16* KC, bf16* VC, LAS unsigned char* lds, int tid) {
    LAS bf16* H1 = (LAS bf16*)lds;
    const int nt8 = cu & 7, which = (cu >> 3) & 1, bg = cu >> 4, g = bg & 1, b = bg >> 1, n0 = 64 * nt8;
    const int lane = tid & 63, w = tid >> 6, r = lane & 31, hh = lane >> 5;
    const bf16* w1t = W1T + (size_t)which * 128 * 2048; const bf16* w2t = W2T + (size_t)which * 64 * 128; bf16* O = which ? VC : KC;
    const int col = (which ? C_VC : C_KC) + g * 64;
    {   const int mt = w & 1, ht = w >> 1;
        int n = n0 + 32 * mt + r; if (n > NCMP - 1) n = NCMP - 1;
        const bf16* arow = P0 + ((size_t)b * SEQ + 16 * n) * NP0 + col + 8 * hh;
        const bf16* brow = w1t + (size_t)(32 * ht + r) * 2048 + 8 * hh;
        f32x16 acc;
#pragma unroll
        for (int i = 0; i < 16; ++i) acc[i] = 0.f;
#if P2_PIPE
        bf16x8 A0[8], B0[8], A1[8], B1[8];
#define CU_LD(A, B, kb) { _Pragma("unroll") for (int j = 0; j < 8; ++j) { const int ks = 8 * (kb) + j; A[j] = *(const bf16x8*)(arow + (size_t)(ks >> 2) * NP0 + 16 * (ks & 3)); B[j] = *(const bf16x8*)(brow + 16 * ks); } }
#define CU_MM(A, B) { _Pragma("unroll") for (int j = 0; j < 8; ++j) acc = MFMA32(A[j], B[j], acc); }
        CU_LD(A0, B0, 0);
#pragma unroll 1
        for (int kb = 0; kb < 16; kb += 2) {
            CU_LD(A1, B1, kb + 1); CU_MM(A0, B0);
            if (kb + 2 < 16) CU_LD(A0, B0, kb + 2);
            CU_MM(A1, B1);
        }
#undef CU_LD
#undef CU_MM
#else
#pragma unroll 8
        for (int ks = 0; ks < 128; ++ks) {
            const bf16x8 a = *(const bf16x8*)(arow + (size_t)(ks >> 2) * NP0 + 16 * (ks & 3));
            const bf16x8 bv = *(const bf16x8*)(brow + 16 * ks);
            acc = MFMA32(a, bv, acc);
        }
#endif
        const float bias = BIAS1[which * 128 + 32 * ht + r];
#pragma unroll
        for (int i = 0; i < 16; ++i) { const int nn = 32 * mt + (i & 3) + 8 * (i >> 2) + 4 * hh; H1[nn * GM_P + 32 * ht + r] = (bf16)(pkbf(gelu_tanh(acc[i] + bias), 0.f) & 0xffffu); }
    }
    __syncthreads();
    if (w < 4) {
        const int mt = w & 1, dt = w >> 1;
        f32x16 acc;
#pragma unroll
        for (int i = 0; i < 16; ++i) acc[i] = 0.f;
#pragma unroll
        for (int ks = 0; ks < 8; ++ks) { const bf16x8 a = *(const LAS bf16x8*)(H1 + (32 * mt + r) * GM_P + 16 * ks + 8 * hh); const bf16x8 bv = *(const bf16x8*)(w2t + (size_t)(32 * dt + r) * 128 + 16 * ks + 8 * hh); acc = MFMA32(a, bv, acc); }
#pragma unroll
        for (int i = 0; i < 16; ++i) { const int n = n0 + 32 * mt + (i & 3) + 8 * (i >> 2) + 4 * hh;
            O[((size_t)(b * 2 + g) * NCMP_PAD + n) * 64 + 32 * dt + r] = (n < NCMP) ? (bf16)(pkbf(acc[i], 0.f) & 0xffffu) : (bf16)0; }
    }
    __syncthreads();
}

__device__ __forceinline__ void compress_unit32(int cu, const bf16* P0, const bf16* W1F, const bf16* W2T, const float* BIAS1, bf16* KC, bf16* VC, LAS unsigned char* lds, int tid) {
    const int nt = cu & 15, which = (cu >> 4) & 1, bg = cu >> 5, g = bg & 1, b = bg >> 1, n0 = 32 * nt;
    const int lane = tid & 63, w = tid >> 6, r = lane & 31, hh = lane >> 5;
    const int col = (which ? C_VC : C_KC) + g * 64;
    LAS unsigned char* WIN = lds;
    LAS float* RED = (LAS float*)(lds + 528 * 128);
    LAS bf16* H1 = (LAS bf16*)(lds + 528 * 128 + 32 * 132 * 4);
    {   v4u x[9];
#pragma unroll
        for (int j = 0; j < 9; ++j) { const int it = tid + 512 * j, row = it >> 3, c = it & 7; int t = 16 * n0 + row; if (t > SEQ - 1) t = SEQ - 1;
            if (it < 528 * 8) x[j] = *(const v4u*)(P0 + ((size_t)b * SEQ + t) * NP0 + col + 8 * c); }
#pragma unroll
        for (int j = 0; j < 9; ++j) { const int it = tid + 512 * j, row = it >> 3, c = it & 7;
            if (it < 528 * 8) *(LAS v4u*)(WIN + row * 128 + (((c + (row >> 4)) & 7) << 4)) = x[j]; }
    }
    const int ht = w & 3, kh = w >> 2;
    const bf16x8* bfr = (const bf16x8*)W1F + ((size_t)(which * 4 + ht) * 128 + 64 * kh) * 64 + lane;
    bf16x8 B0[8], B1[8];
#define C3_LD(B, kb) { _Pragma("unroll") for (int j = 0; j < 8; ++j) B[j] = bfr[(size_t)(8 * (kb) + j) * 64]; }
#define C3_MM(B, kb) { _Pragma("unroll") for (int j = 0; j < 8; ++j) { const int ks = 64 * kh + 8 * (kb) + j, p = ks >> 2, c = 2 * (ks & 3) + hh; \
        const bf16x8 a = *(const LAS bf16x8*)(WIN + (16 * r + p) * 128 + (((c + r + (p >> 4)) & 7) << 4)); acc = MFMA32(a, B[j], acc); } }
    C3_LD(B0, 0);
    f32x16 acc;
#pragma unroll
    for (int i = 0; i < 16; ++i) acc[i] = 0.f;
    __syncthreads();
#pragma unroll 1
    for (int kb = 0; kb < 8; kb += 2) {
        C3_LD(B1, kb + 1); C3_MM(B0, kb);
        if (kb + 2 < 8) C3_LD(B0, kb + 2);
        C3_MM(B1, kb + 1);
    }
#undef C3_LD
#undef C3_MM
    if (kh == 1) {
#pragma unroll
        for (int i = 0; i < 16; ++i) RED[((i & 3) + 8 * (i >> 2) + 4 * hh) * 132 + 32 * ht + r] = acc[i];
    }
    __syncthreads();
    if (kh == 0) { const float bias = BIAS1[which * 128 + 32 * ht + r];
#pragma unroll
        for (int i = 0; i < 16; ++i) { const int nn = (i & 3) + 8 * (i >> 2) + 4 * hh; H1[nn * GM_P + 32 * ht + r] = (bf16)(pkbf(gelu_tanh(acc[i] + RED[nn * 132 + 32 * ht + r] + bias), 0.f) & 0xffffu); }
    }
    __syncthreads();
    if (w < 2) {
        const int dt = w; const bf16* w2t = W2T + (size_t)which * 64 * 128; bf16* O = which ? VC : KC;
        f32x16 a2;
#pragma unroll
        for (int i = 0; i < 16; ++i) a2[i] = 0.f;
#pragma unroll
        for (int ks = 0; ks < 8; ++ks) { const bf16x8 a = *(const LAS bf16x8*)(H1 + r * GM_P + 16 * ks + 8 * hh); const bf16x8 bv = *(const bf16x8*)(w2t + (size_t)(32 * dt + r) * 128 + 16 * ks + 8 * hh); a2 = MFMA32(a, bv, a2); }
#pragma unroll
        for (int i = 0; i < 16; ++i) { const int n = n0 + (i & 3) + 8 * (i >> 2) + 4 * hh;
            O[((size_t)(b * 2 + g) * NCMP_PAD + n) * 64 + 32 * dt + r] = (n < NCMP) ? (bf16)(pkbf(a2[i], 0.f) & 0xffffu) : (bf16)0; }
    }
    __syncthreads();
}
__device__ __forceinline__ void tab_to_fp8(const float* src, unsigned char* dst, float* scl, int nrows, int gw, int NGW, int lane) {
    for (int rw = gw; rw < nrows; rw += NGW) {
        const f32x4* s = (const f32x4*)(src + (size_t)rw * DM + 16 * lane);
        const f32x4 a = s[0], b = s[1], c = s[2], d = s[3];
        float mx = fmaxf(fmaxf(fmaxf(fabsf(a.x), fabsf(a.y)), fmaxf(fabsf(a.z), fabsf(a.w))), fmaxf(fmaxf(fabsf(b.x), fabsf(b.y)), fmaxf(fabsf(b.z), fabsf(b.w))));
        mx = fmaxf(mx, fmaxf(fmaxf(fmaxf(fabsf(c.x), fabsf(c.y)), fmaxf(fabsf(c.z), fabsf(c.w))), fmaxf(fmaxf(fabsf(d.x), fabsf(d.y)), fmaxf(fabsf(d.z), fabsf(d.w)))));
        mx = fmaxf(wave_max(mx), 1e-30f);
        const float inv = 440.0f / mx;
        v4u o; int p;
        p = __builtin_amdgcn_cvt_pk_fp8_f32(a.x * inv, a.y * inv, 0, false); p = __builtin_amdgcn_cvt_pk_fp8_f32(a.z * inv, a.w * inv, p, true); o.x = (unsigned)p;
        p = __builtin_amdgcn_cvt_pk_fp8_f32(b.x * inv, b.y * inv, 0, false); p = __builtin_amdgcn_cvt_pk_fp8_f32(b.z * inv, b.w * inv, p, true); o.y = (unsigned)p;
        p = __builtin_amdgcn_cvt_pk_fp8_f32(c.x * inv, c.y * inv, 0, false); p = __builtin_amdgcn_cvt_pk_fp8_f32(c.z * inv, c.w * inv, p, true); o.z = (unsigned)p;
        p = __builtin_amdgcn_cvt_pk_fp8_f32(d.x * inv, d.y * inv, 0, false); p = __builtin_amdgcn_cvt_pk_fp8_f32(d.z * inv, d.w * inv, p, true); o.w = (unsigned)p;
        *((v4u*)(dst + (size_t)rw * DM) + lane) = o;
        if (lane == 0) scl[rw] = mx * (1.0f / 440.0f);
    }
}
__device__ __forceinline__ float dot16_fp8(const v4u q, const float (&x)[16]) {
    float a0 = 0.f, a1 = 0.f;
#define DT_STEP(word, hi, k0) { const f32x2 t = __builtin_amdgcn_cvt_pk_f32_fp8(word, hi); a0 = __builtin_fmaf(t.x, x[k0], a0); a1 = __builtin_fmaf(t.y, x[(k0) + 1], a1); asm("" : "+v"(a0), "+v"(a1)); }
    DT_STEP(q.x, false, 0) DT_STEP(q.x, true, 2) DT_STEP(q.y, false, 4) DT_STEP(q.y, true, 6) DT_STEP(q.z, false, 8) DT_STEP(q.z, true, 10) DT_STEP(q.w, false, 12) DT_STEP(q.w, true, 14)
#undef DT_STEP
    return a0 + a1;
}
__device__ __forceinline__ void axpy16_fp8(const v4u q, float w, float (&acc)[16]) {
#define AX_STEP(word, hi, k0) { const f32x2 t = __builtin_amdgcn_cvt_pk_f32_fp8(word, hi); acc[k0] = __builtin_fmaf(t.x, w, acc[k0]); acc[(k0) + 1] = __builtin_fmaf(t.y, w, acc[(k0) + 1]); asm("" : "+v"(acc[k0]), "+v"(acc[(k0) + 1])); }
    AX_STEP(q.x, false, 0) AX_STEP(q.x, true, 2) AX_STEP(q.y, false, 4) AX_STEP(q.y, true, 6) AX_STEP(q.z, false, 8) AX_STEP(q.z, true, 10) AX_STEP(q.w, false, 12) AX_STEP(q.w, true, 14)
#undef AX_STEP
}
#ifndef PE_RED_MODE
#define PE_RED_MODE 3
#endif
__device__ __forceinline__ float pe_reduce8(const float (&p)[8], int lane) {
#if PE_RED_MODE == 0
    const bool b5 = lane & 32, b4 = lane & 16, b3 = lane & 8; float q[4], r[2];
#pragma unroll
    for (int i = 0; i < 4; ++i) { const float send = b5 ? p[i] : p[i + 4], keep = b5 ? p[i + 4] : p[i]; q[i] = keep + __shfl_xor(send, 32); }
#pragma unroll
    for (int i = 0; i < 2; ++i) { const float send = b4 ? q[i] : q[i + 2], keep = b4 ? q[i + 2] : q[i]; r[i] = keep + __shfl_xor(send, 16); }
    float s; { const float send = b3 ? r[0] : r[1], keep = b3 ? r[1] : r[0]; s = keep + __shfl_xor(send, 8); }
    s += __shfl_xor(s, 4); s += __shfl_xor(s, 2); s += __shfl_xor(s, 1);
    return s;
#else
    const bool b4 = lane & 16, b3 = lane & 8; float q4[4], q2[2];
#pragma unroll
    for (int i = 0; i < 4; ++i) { auto sw = __builtin_amdgcn_permlane32_swap(__builtin_bit_cast(unsigned, p[i]), __builtin_bit_cast(unsigned, p[i + 4]), false, false); const unsigned s0_ = sw[0], s1_ = sw[1]; q4[i] = __builtin_bit_cast(float, s0_) + __builtin_bit_cast(float, s1_); }
#if PE_RED_MODE == 1
#pragma unroll
    for (int i = 0; i < 2; ++i) { const float send = b4 ? q4[i] : q4[i + 2], keep = b4 ? q4[i + 2] : q4[i]; q2[i] = keep + __shfl_xor(send, 16); }
    float s; { const float send = b3 ? q2[0] : q2[1], keep = b3 ? q2[1] : q2[0]; s = keep + __shfl_xor(send, 8); }
    s += __shfl_xor(s, 4); s += __shfl_xor(s, 2); s += __shfl_xor(s, 1);
    return s;
#else
#pragma unroll
    for (int i = 0; i < 2; ++i) { auto sw = __builtin_amdgcn_permlane16_swap(__builtin_bit_cast(unsigned, q4[i]), __builtin_bit_cast(unsigned, q4[i + 2]), false, false); const unsigned s0_ = sw[0], s1_ = sw[1]; q2[i] = __builtin_bit_cast(float, s0_) + __builtin_bit_cast(float, s1_); }
#if PE_RED_MODE == 2
    float s; { const float send = b3 ? q2[0] : q2[1], keep = b3 ? q2[1] : q2[0]; s = keep + __shfl_xor(send, 8); }
    s += __shfl_xor(s, 4); s += __shfl_xor(s, 2); s += __shfl_xor(s, 1);
    return s;
#else
    float s; { const float send = b3 ? q2[0] : q2[1], keep = b3 ? q2[1] : q2[0]; s = keep + __builtin_bit_cast(float, __builtin_amdgcn_update_dpp(0, __builtin_bit_cast(int, send), 0x140, 0xf, 0xf, false)); }
    s += __builtin_bit_cast(float, __builtin_amdgcn_update_dpp(0, __builtin_bit_cast(int, s), 0x141, 0xf, 0xf, false));
    s += __builtin_bit_cast(float, __builtin_amdgcn_update_dpp(0, __builtin_bit_cast(int, s), 0xB1, 0xf, 0xf, false));
    s += __builtin_bit_cast(float, __builtin_amdgcn_update_dpp(0, __builtin_bit_cast(int, s), 0x4E, 0xf, 0xf, false));
    return s;
#endif
#endif
#endif
}
__device__ __forceinline__ float dot16_fp8_bf(const v4u q, const unsigned (&xp)[8]) {
    float a0 = 0.f, a1 = 0.f;
#define DB_STEP(word, hi, k0) { a0 = __builtin_amdgcn_fdot2_f32_bf16(__builtin_amdgcn_cvt_scalef32_pk_bf16_fp8(word, 1.0f, hi), __builtin_bit_cast(bf16x2_t, xp[k0]), a0, false); }
#define DB_STEP1(word, hi, k0) { a1 = __builtin_amdgcn_fdot2_f32_bf16(__builtin_amdgcn_cvt_scalef32_pk_bf16_fp8(word, 1.0f, hi), __builtin_bit_cast(bf16x2_t, xp[k0]), a1, false); }
    DB_STEP(q.x, false, 0) DB_STEP1(q.x, true, 1) DB_STEP(q.y, false, 2) DB_STEP1(q.y, true, 3) DB_STEP(q.z, false, 4) DB_STEP1(q.z, true, 5) DB_STEP(q.w, false, 6) DB_STEP1(q.w, true, 7)
#undef DB_STEP
#undef DB_STEP1
    return a0 + a1;
}
__device__ __forceinline__ void peer_eval_wave(int tok, const bf16* XN, bf16* XNO, const unsigned char* TU, const unsigned char* TV, const float* SU, const float* SV, const int* EXPI, const float* GATEI,
                                               const float* xres, float* xout, const float* nw_bf, const float* nw_f, LAS float* WL, int lane, int exmask = 0x3FFF) {
    float x[16];
    {   const v4u* xr = (const v4u*)(XN + (size_t)tok * DM + 16 * lane); const v4u x0 = xr[0], x1 = xr[1];
        x[0] = bflo(x0.x); x[1] = bfhi(x0.x); x[2] = bflo(x0.y); x[3] = bfhi(x0.y); x[4] = bflo(x0.z); x[5] = bfhi(x0.z); x[6] = bflo(x0.w); x[7] = bfhi(x0.w);
        x[8] = bflo(x1.x); x[9] = bfhi(x1.x); x[10] = bflo(x1.y); x[11] = bfhi(x1.y); x[12] = bflo(x1.z); x[13] = bfhi(x1.z); x[14] = bflo(x1.w); x[15] = bfhi(x1.w); }
    int exA = EXPI[(size_t)tok * 128 + lane] & exmask, exB = EXPI[(size_t)tok * 128 + 64 + lane] & exmask;
    float gA = GATEI[(size_t)tok * 128 + lane] * SV[exA], gB = GATEI[(size_t)tok * 128 + 64 + lane] * SV[exB];
    float suA = SU[exA], suB = SU[exB];
#if PEER_SORT
    {
        const int kA = exA * 128 + lane, kB = exB * 128 + 64 + lane; int rA = 0, rB = 0;
#pragma unroll 4
        for (int j = 0; j < 64; ++j) { const int a = __builtin_amdgcn_readlane(kA, j), b = __builtin_amdgcn_readlane(kB, j); rA += (a < kA) + (b < kA); rB += (a < kB) + (b < kB); }
        LAS int* SI = (LAS int*)(WL + 128); LAS float* SG = WL + 256; LAS float* SS = WL + 384;
        SI[rA] = exA; SI[rB] = exB; SG[rA] = gA; SG[rB] = gB; SS[rA] = suA; SS[rB] = suB;
        LDS_WAIT();
        exA = SI[lane]; exB = SI[64 + lane]; gA = SG[lane]; gB = SG[64 + lane]; suA = SS[lane]; suB = SS[64 + lane];
    }
#endif
#define PE_LOAD(buf, T, gi_) do { const int exv_ = (gi_) < 8 ? exA : exB; _Pragma("unroll") for (int j = 0; j < 8; ++j) { const int ex_ = __builtin_amdgcn_readlane(exv_, (((gi_) * 8 + j) & 63)); buf[j] = *((const v4u*)((T) + (size_t)ex_ * DM) + lane); } } while (0)
#define PE_DPPADD(v, ctrl) ((v) + __builtin_bit_cast(float, __builtin_amdgcn_update_dpp(0, __builtin_bit_cast(int, (v)), (ctrl), 0xf, 0xf, false)))
#define PE_DOTS(buf, gi_) do { float p[8]; _Pragma("unroll") for (int j = 0; j < 8; ++j) p[j] = dot16_fp8(buf[j], x); \
        float s_ = pe_reduce8(p, lane); \
        const int el_ = (((gi_) * 8) & 63) + (lane >> 3); \
        const float su_ = __shfl((gi_) < 8 ? suA : suB, el_), gt_ = __shfl((gi_) < 8 ? gA : gB, el_); \
        if ((lane & 7) == 0) WL[(gi_) * 8 + (lane >> 3)] = gt_ * gelu_tanh(s_ * su_); } while (0)
    {
        v4u ua[8], ub[8];
        PE_LOAD(ua, TU, 0);
#pragma unroll 1
        for (int gi = 0; gi < 16; gi += 2) {
            PE_LOAD(ub, TU, gi + 1);
            PE_DOTS(ua, gi);
            if (gi + 2 < 16) PE_LOAD(ua, TU, gi + 2);
            PE_DOTS(ub, gi + 1);
        }
    }
    LDS_WAIT();
    float acc[16];
#pragma unroll
    for (int i = 0; i < 16; ++i) acc[i] = 0.f;
#define PE_AXPY(buf, gi_) do { _Pragma("unroll") for (int j = 0; j < 8; ++j) axpy16_fp8(buf[j], WL[(gi_) * 8 + j], acc); } while (0)
    {
        v4u va[8], vb[8];
        PE_LOAD(va, TV, 0);
#pragma unroll 1
        for (int gi = 0; gi < 16; gi += 2) {
            PE_LOAD(vb, TV, gi + 1);
            PE_AXPY(va, gi);
            if (gi + 2 < 16) PE_LOAD(va, TV, gi + 2);
            PE_AXPY(vb, gi + 1);
        }
    }
#undef PE_LOAD
#undef PE_DOTS
#undef PE_AXPY
#undef PE_DPPADD
    const float* xrow = xres + (size_t)tok * DM + 16 * lane; float* orow = xout + (size_t)tok * DM + 16 * lane; f32x4 y[4]; float ss = 0.f;
#pragma unroll
    for (int c = 0; c < 4; ++c) { f32x4 rr = *(const f32x4*)(xrow + 4 * c); rr.x += acc[4 * c]; rr.y += acc[4 * c + 1]; rr.z += acc[4 * c + 2]; rr.w += acc[4 * c + 3]; y[c] = rr; ss += (rr.x * rr.x + rr.y * rr.y) + (rr.z * rr.z + rr.w * rr.w); }
    const float rn = 1.0f / sqrtf(wave_sum(ss) * (1.0f / DM) + EPS);
    if (nw_f) {
#pragma unroll
        for (int c = 0; c < 4; ++c) { const f32x4 wv = *(const f32x4*)(nw_f + 16 * lane + 4 * c); *(f32x4*)(orow + 4 * c) = y[c] * rn * wv; }
    } else {
#pragma unroll
        for (int c = 0; c < 4; ++c) *(f32x4*)(orow + 4 * c) = y[c];
    }
    if (nw_bf) {
        f32x4 z[4];
#pragma unroll
        for (int c = 0; c < 4; ++c) { const f32x4 wv = *(const f32x4*)(nw_bf + 16 * lane + 4 * c); z[c] = y[c] * rn * wv; }
        v4u o0, o1; o0.x = pkbf(z[0].x, z[0].y); o0.y = pkbf(z[0].z, z[0].w); o0.z = pkbf(z[1].x, z[1].y); o0.w = pkbf(z[1].z, z[1].w);
        o1.x = pkbf(z[2].x, z[2].y); o1.y = pkbf(z[2].z, z[2].w); o1.z = pkbf(z[3].x, z[3].y); o1.w = pkbf(z[3].z, z[3].w);
        v4u* xo = (v4u*)(XNO + (size_t)tok * DM + 16 * lane); xo[0] = o0; xo[1] = o1;
    }
    LDS_WAIT();
}
#ifndef PEER_PT
#define PEER_PT 4
#endif
#ifndef PEER_BUCKET
#define PEER_BUCKET 1
#endif
constexpr int PT = PEER_PT;
constexpr int PE4_LDS = PT * 512 * 4;
__device__ __forceinline__ void peer_eval4m_wave(int tok0, const bf16* XN, bf16* XNO, const unsigned char* TU, const unsigned char* TV, const float* SU, const float* SV, const int* EXPI, const float* GATEI,
                                                 const float* xres, float* xout, const float* nw_bf, const float* nw_f, LAS float* W4, int lane, const float* rsx = nullptr, const float* nwx = nullptr) {
#pragma unroll 1
    for (int tl = 0; tl < PT; ++tl) {
        const size_t eb = (size_t)(tok0 + tl) * 128;
        const int a = EXPI[eb + lane], b = EXPI[eb + 64 + lane];
        const float ga = GATEI[eb + lane] * SV[a], gb = GATEI[eb + 64 + lane] * SV[b], sa = SU[a], sb = SU[b];
        LAS float* WLt = W4 + tl * 512; LAS int* SI = (LAS int*)(WLt + 128); LAS float* SG = WLt + 256; LAS float* SS = WLt + 384;
#if PEER_BUCKET
        LAS int* HI = (LAS int*)WLt;
        HI[lane] = 0;
        const int ra_ = __hip_atomic_fetch_add(HI + (a >> 8), 1, __ATOMIC_RELAXED, __HIP_MEMORY_SCOPE_WORKGROUP), rb_ = __hip_atomic_fetch_add(HI + (b >> 8), 1, __ATOMIC_RELAXED, __HIP_MEMORY_SCOPE_WORKGROUP);
        const int c_ = HI[lane]; int incl = c_;
#pragma unroll
        for (int o = 1; o < 64; o <<= 1) { const int t_ = __shfl_up(incl, o); if (lane >= o) incl += t_; }
        HI[64 + lane] = incl - c_;
        const int rA = HI[64 + (a >> 8)] + ra_, rB = HI[64 + (b >> 8)] + rb_;
#else
        const int kA = a * 128 + lane, kB = b * 128 + 64 + lane; int rA = 0, rB = 0;
#pragma unroll 4
        for (int j = 0; j < 64; ++j) { const int p_ = __builtin_amdgcn_readlane(kA, j), q_ = __builtin_amdgcn_readlane(kB, j); rA += (p_ < kA) + (q_ < kA); rB += (p_ < kB) + (q_ < kB); }
#endif
        SI[rA] = a; SI[rB] = b; SG[rA] = ga; SG[rB] = gb; SS[rA] = sa; SS[rB] = sb;
    }
    LDS_WAIT();
#define PE_LOAD(buf, T, tl_, gi_) do { const LAS int* si_ = (const LAS int*)(W4 + (tl_) * 512 + 128) + (gi_) * 8; _Pragma("unroll") for (int j = 0; j < 8; ++j) { const int ex_ = __builtin_amdgcn_readfirstlane(si_[j]); buf[j] = *((const v4u*)((T) + (size_t)ex_ * DM) + lane); } } while (0)
    {
        unsigned x[PT][8];
#pragma unroll
        for (int tl = 0; tl < PT; ++tl) { const v4u* xr = (const v4u*)(XN + (size_t)(tok0 + tl) * DM + 16 * lane); const v4u x0 = xr[0], x1 = xr[1];
            x[tl][0] = x0.x; x[tl][1] = x0.y; x[tl][2] = x0.z; x[tl][3] = x0.w; x[tl][4] = x1.x; x[tl][5] = x1.y; x[tl][6] = x1.z; x[tl][7] = x1.w; }
        if (rsx) {
            float wn[16];
#pragma unroll
            for (int c = 0; c < 4; ++c) { const f32x4 wv = *(const f32x4*)(nwx + 16 * lane + 4 * c); wn[4 * c] = wv.x; wn[4 * c + 1] = wv.y; wn[4 * c + 2] = wv.z; wn[4 * c + 3] = wv.w; }
#pragma unroll
            for (int tl = 0; tl < PT; ++tl) { const f32x4* rp = (const f32x4*)(rsx + (size_t)(tok0 + tl) * 16); const f32x4 t0 = rp[0], t1 = rp[1], t2 = rp[2], t3 = rp[3];
                const float tot = (((t0[0] + t0[1]) + (t0[2] + t0[3])) + ((t1[0] + t1[1]) + (t1[2] + t1[3]))) + (((t2[0] + t2[1]) + (t2[2] + t2[3])) + ((t3[0] + t3[1]) + (t3[2] + t3[3])));
                const float rr = 1.0f / sqrtf(tot * (1.0f / DM) + EPS);
#pragma unroll
                for (int k = 0; k < 8; ++k) x[tl][k] = pkbf(bflo(x[tl][k]) * rr * wn[2 * k], bfhi(x[tl][k]) * rr * wn[2 * k + 1]); }
        }
#define PE_DOTS(buf, tl_, gi_) do { float p[8]; _Pragma("unroll") for (int j = 0; j < 8; ++j) { p[j] = dot16_fp8_bf(buf[j], x[tl_]); if (j & 1) __builtin_amdgcn_sched_barrier(0); } \
        const float s_ = pe_reduce8(p, lane); const int el_ = (gi_) * 8 + (lane >> 3); \
        const float su_ = W4[(tl_) * 512 + 384 + el_], gt_ = W4[(tl_) * 512 + 256 + el_]; \
        if ((lane & 7) == 0) W4[(tl_) * 512 + el_] = gt_ * gelu_tanh(s_ * su_); } while (0)
        v4u ua[8], ub[8];
        PE_LOAD(ua, TU, 0, 0);
#pragma unroll 1
        for (int gi = 0; gi < 16; ++gi) {
            PE_LOAD(ub, TU, 1, gi);
            PE_DOTS(ua, 0, gi);
            if (PT == 4) { PE_LOAD(ua, TU, 2, gi); PE_DOTS(ub, 1, gi); PE_LOAD(ub, TU, 3, gi); PE_DOTS(ua, 2, gi); }
            if (gi + 1 < 16) PE_LOAD(ua, TU, 0, gi + 1);
            PE_DOTS(ub, PT - 1, gi);
        }
#undef PE_DOTS
    }
    LDS_WAIT();
    float acc[PT][16];
#pragma unroll
    for (int tl = 0; tl < PT; ++tl)
#pragma unroll
        for (int k = 0; k < 16; ++k) acc[tl][k] = 0.f;
#define PE_AXPY(buf, tl_, gi_) do { _Pragma("unroll") for (int j = 0; j < 8; ++j) { axpy16_fp8(buf[j], W4[(tl_) * 512 + (gi_) * 8 + j], acc[tl_]); if (j & 1) __builtin_amdgcn_sched_barrier(0); } } while (0)
    {
        v4u va[8], vb[8];
        PE_LOAD(va, TV, 0, 0);
#pragma unroll 1
        for (int gi = 0; gi < 16; ++gi) {
            PE_LOAD(vb, TV, 1, gi);
            PE_AXPY(va, 0, gi);
            if (PT == 4) { PE_LOAD(va, TV, 2, gi); PE_AXPY(vb, 1, gi); PE_LOAD(vb, TV, 3, gi); PE_AXPY(va, 2, gi); }
            if (gi + 1 < 16) PE_LOAD(va, TV, 0, gi + 1);
            PE_AXPY(vb, PT - 1, gi);
        }
    }
#undef PE_AXPY
#undef PE_LOAD
#pragma unroll
    for (int tl = 0; tl < PT; ++tl) {
        asm volatile("" ::: "memory"); __builtin_amdgcn_sched_barrier(0);
        const float* xrow = xres + (size_t)(tok0 + tl) * DM + 16 * lane; float* orow = xout + (size_t)(tok0 + tl) * DM + 16 * lane; f32x4 y[4]; float ss = 0.f;
#if RESID_BF16
        {
            const v4u* xb = (const v4u*)((const bf16*)xres + (size_t)(tok0 + tl) * DM + 16 * lane); const v4u b0 = xb[0], b1 = xb[1];
            y[0] = (f32x4){bflo(b0.x), bfhi(b0.x), bflo(b0.y), bfhi(b0.y)}; y[1] = (f32x4){bflo(b0.z), bfhi(b0.z), bflo(b0.w), bfhi(b0.w)};
            y[2] = (f32x4){bflo(b1.x), bfhi(b1.x), bflo(b1.y), bfhi(b1.y)}; y[3] = (f32x4){bflo(b1.z), bfhi(b1.z), bflo(b1.w), bfhi(b1.w)};
#pragma unroll
            for (int c = 0; c < 4; ++c) { f32x4 rr = y[c]; rr.x += acc[tl][4 * c]; rr.y += acc[tl][4 * c + 1]; rr.z += acc[tl][4 * c + 2]; rr.w += acc[tl][4 * c + 3]; y[c] = rr; ss += (rr.x * rr.x + rr.y * rr.y) + (rr.z * rr.z + rr.w * rr.w); }
        }
#else
#pragma unroll
        for (int c = 0; c < 4; ++c) { f32x4 rr = *(const f32x4*)(xrow + 4 * c); rr.x += acc[tl][4 * c]; rr.y += acc[tl][4 * c + 1]; rr.z += acc[tl][4 * c + 2]; rr.w += acc[tl][4 * c + 3]; y[c] = rr; ss += (rr.x * rr.x + rr.y * rr.y) + (rr.z * rr.z + rr.w * rr.w); }
#endif
        const float rn = 1.0f / sqrtf(wave_sum(ss) * (1.0f / DM) + EPS);
        if (nw_f) {
#pragma unroll
            for (int c = 0; c < 4; ++c) { const f32x4 wv = *(const f32x4*)(nw_f + 16 * lane + 4 * c); *(f32x4*)(orow + 4 * c) = y[c] * rn * wv; }
        } else {
#if RESID_BF16
            v4u r0, r1; r0.x = pkbf(y[0].x, y[0].y); r0.y = pkbf(y[0].z, y[0].w); r0.z = pkbf(y[1].x, y[1].y); r0.w = pkbf(y[1].z, y[1].w);
            r1.x = pkbf(y[2].x, y[2].y); r1.y = pkbf(y[2].z, y[2].w); r1.z = pkbf(y[3].x, y[3].y); r1.w = pkbf(y[3].z, y[3].w);
            v4u* xo_ = (v4u*)((bf16*)xout + (size_t)(tok0 + tl) * DM + 16 * lane); xo_[0] = r0; xo_[1] = r1;
#else
#pragma unroll
            for (int c = 0; c < 4; ++c) *(f32x4*)(orow + 4 * c) = y[c];
#endif
        }
        if (nw_bf) {
            f32x4 z[4];
#pragma unroll
            for (int c = 0; c < 4; ++c) { const f32x4 wv = *(const f32x4*)(nw_bf + 16 * lane + 4 * c); z[c] = y[c] * rn * wv; }
            v4u o0, o1; o0.x = pkbf(z[0].x, z[0].y); o0.y = pkbf(z[0].z, z[0].w); o0.z = pkbf(z[1].x, z[1].y); o0.w = pkbf(z[1].z, z[1].w);
            o1.x = pkbf(z[2].x, z[2].y); o1.y = pkbf(z[2].z, z[2].w); o1.z = pkbf(z[3].x, z[3].y); o1.w = pkbf(z[3].z, z[3].w);
            v4u* xo = (v4u*)(XNO + (size_t)(tok0 + tl) * DM + 16 * lane); xo[0] = o0; xo[1] = o1;
        }
    }
    LDS_WAIT();
}
constexpr int PE4C_LDS = (4 * 512 + 80 + 192) * 4;
__device__ __forceinline__ void peer_eval4c_wave(int tok0, const bf16* XN, bf16* XNO, const unsigned char* TU, const unsigned char* TV, const float* SU, const float* SV, const int* EXPI, const float* GATEI,
                                                 const float* xres, float* xout, const float* nw_bf, const float* nw_f, LAS float* W4, int lane) {
    LAS int* CS = (LAS int*)(W4 + 2048); LAS int* BL = CS + 80;
#pragma unroll 1
    for (int tl = 0; tl < 4; ++tl) {
        const size_t eb = (size_t)(tok0 + tl) * 128;
        const int a = EXPI[eb + lane], b = EXPI[eb + 64 + lane];
        const float ga = GATEI[eb + lane] * SV[a], gb = GATEI[eb + 64 + lane] * SV[b], sa = SU[a], sb = SU[b];
        const int kA = a * 128 + lane, kB = b * 128 + 64 + lane; int rA = 0, rB = 0, cnt = 0;
#pragma unroll 4
        for (int j = 0; j < 64; ++j) { const int p_ = __builtin_amdgcn_readlane(kA, j), q_ = __builtin_amdgcn_readlane(kB, j); rA += (p_ < kA) + (q_ < kA); rB += (p_ < kB) + (q_ < kB);
            cnt += ((p_ >> 7) < 1024 * lane) + ((q_ >> 7) < 1024 * lane); }
        LAS float* WLt = W4 + tl * 512; LAS int* SI = (LAS int*)(WLt + 128); LAS float* SG = WLt + 256; LAS float* SS = WLt + 384;
        SI[rA] = a; SI[rB] = b; SG[rA] = ga; SG[rB] = gb; SS[rA] = sa; SS[rB] = sb;
        if (lane <= 16) CS[tl * 20 + lane] = cnt;
    }
    LDS_WAIT();
    int nb;
    {   const int c = lane >> 2, tl = lane & 3, lo = CS[tl * 20 + c], hi = CS[tl * 20 + c + 1], n = hi - lo, nbt = (n + 7) >> 3;
        int incl = nbt;
#pragma unroll
        for (int o = 1; o < 64; o <<= 1) { const int t = __shfl_up(incl, o); if (lane >= o) incl += t; }
        const int base = incl - nbt;
        for (int q = 0; q < nbt; ++q) BL[base + q] = tl | ((lo + 8 * q) << 2) | (min(8, n - 8 * q) << 9);
        nb = __builtin_amdgcn_readlane(incl, 63);
    }
    LDS_WAIT();
#define PC_LOAD(buf, be, T, k_) do { be = __builtin_amdgcn_readfirstlane(BL[(k_)]); const int tl_ = be & 3, st_ = (be >> 2) & 127, n_ = be >> 9; const LAS int* si_ = (const LAS int*)(W4 + tl_ * 512 + 128) + st_; \
        _Pragma("unroll") for (int j = 0; j < 8; ++j) { const int ex_ = __builtin_amdgcn_readfirstlane(si_[j < n_ ? j : n_ - 1]); buf[j] = *((const v4u*)((T) + (size_t)ex_ * DM) + lane); } } while (0)
    {
        float x[4][16];
#pragma unroll
        for (int tl = 0; tl < 4; ++tl) { const v4u* xr = (const v4u*)(XN + (size_t)(tok0 + tl) * DM + 16 * lane); const v4u x0 = xr[0], x1 = xr[1];
            x[tl][0] = bflo(x0.x); x[tl][1] = bfhi(x0.x); x[tl][2] = bflo(x0.y); x[tl][3] = bfhi(x0.y); x[tl][4] = bflo(x0.z); x[tl][5] = bfhi(x0.z); x[tl][6] = bflo(x0.w); x[tl][7] = bfhi(x0.w);
            x[tl][8] = bflo(x1.x); x[tl][9] = bfhi(x1.x); x[tl][10] = bflo(x1.y); x[tl][11] = bfhi(x1.y); x[tl][12] = bflo(x1.z); x[tl][13] = bfhi(x1.z); x[tl][14] = bflo(x1.w); x[tl][15] = bfhi(x1.w); }
#define PC_DOT8(buf, n_, xx) do { asm volatile("" ::: "memory"); _Pragma("unroll") for (int j = 0; j < 8; ++j) { if (j < n_) p[j] = dot16_fp8(buf[j], xx); } } while (0)
#define PC_DOTS(buf, be) do { float p[8]; _Pragma("unroll") for (int j = 0; j < 8; ++j) p[j] = 0.f; const int tl_ = be & 3, st_ = (be >> 2) & 127, n_ = be >> 9; \
        if (tl_ == 0) PC_DOT8(buf, n_, x[0]); else if (tl_ == 1) PC_DOT8(buf, n_, x[1]); else if (tl_ == 2) PC_DOT8(buf, n_, x[2]); else PC_DOT8(buf, n_, x[3]); \
        const float s_ = pe_reduce8(p, lane); const int e_ = (lane >> 3); LAS float* wl_ = W4 + tl_ * 512; \
        if ((lane & 7) == 0 && e_ < n_) wl_[st_ + e_] = wl_[256 + st_ + e_] * gelu_tanh(s_ * wl_[384 + st_ + e_]); } while (0)
        v4u ua[8], ub[8]; int ea, ebb;
        PC_LOAD(ua, ea, TU, 0);
#pragma unroll 1
        for (int k = 0; k < nb; k += 2) {
            if (k + 1 < nb) PC_LOAD(ub, ebb, TU, k + 1);
            PC_DOTS(ua, ea);
            if (k + 2 < nb) PC_LOAD(ua, ea, TU, k + 2);
            if (k + 1 < nb) PC_DOTS(ub, ebb);
        }
#undef PC_DOTS
#undef PC_DOT8
    }
    LDS_WAIT();
    float acc[4][16];
#pragma unroll
    for (int tl = 0; tl < 4; ++tl)
#pragma unroll
        for (int k = 0; k < 16; ++k) acc[tl][k] = 0.f;
#define PC_AX8(buf, n_, wl_, aa) do { asm volatile("" ::: "memory"); _Pragma("unroll") for (int j = 0; j < 8; ++j) { if (j < n_) axpy16_fp8(buf[j], wl_[j], aa); } } while (0)
#define PC_AXPY(buf, be) do { const int tl_ = be & 3, st_ = (be >> 2) & 127, n_ = be >> 9; const LAS float* wl_ = W4 + tl_ * 512 + st_; \
        if (tl_ == 0) PC_AX8(buf, n_, wl_, acc[0]); else if (tl_ == 1) PC_AX8(buf, n_, wl_, acc[1]); else if (tl_ == 2) PC_AX8(buf, n_, wl_, acc[2]); else PC_AX8(buf, n_, wl_, acc[3]); } while (0)
    {
        v4u va[8], vb[8]; int ea, ebb;
        PC_LOAD(va, ea, TV, 0);
#pragma unroll 1
        for (int k = 0; k < nb; k += 2) {
            if (k + 1 < nb) PC_LOAD(vb, ebb, TV, k + 1);
            PC_AXPY(va, ea);
            if (k + 2 < nb) PC_LOAD(va, ea, TV, k + 2);
            if (k + 1 < nb) PC_AXPY(vb, ebb);
        }
    }
#undef PC_AXPY
#undef PC_AX8
#undef PC_LOAD
#pragma unroll
    for (int tl = 0; tl < 4; ++tl) {
        asm volatile("" ::: "memory"); __builtin_amdgcn_sched_barrier(0);
        const float* xrow = xres + (size_t)(tok0 + tl) * DM + 16 * lane; float* orow = xout + (size_t)(tok0 + tl) * DM + 16 * lane; f32x4 y[4]; float ss = 0.f;
#pragma unroll
        for (int c = 0; c < 4; ++c) { f32x4 rr = *(const f32x4*)(xrow + 4 * c); rr.x += acc[tl][4 * c]; rr.y += acc[tl][4 * c + 1]; rr.z += acc[tl][4 * c + 2]; rr.w += acc[tl][4 * c + 3]; y[c] = rr; ss += (rr.x * rr.x + rr.y * rr.y) + (rr.z * rr.z + rr.w * rr.w); }
        const float rn = 1.0f / sqrtf(wave_sum(ss) * (1.0f / DM) + EPS);
        if (nw_f) {
#pragma unroll
            for (int c = 0; c < 4; ++c) { const f32x4 wv = *(const f32x4*)(nw_f + 16 * lane + 4 * c); *(f32x4*)(orow + 4 * c) = y[c] * rn * wv; }
        } else {
#pragma unroll
            for (int c = 0; c < 4; ++c) *(f32x4*)(orow + 4 * c) = y[c];
        }
        if (nw_bf) {
            f32x4 z[4];
#pragma unroll
            for (int c = 0; c < 4; ++c) { const f32x4 wv = *(const f32x4*)(nw_bf + 16 * lane + 4 * c); z[c] = y[c] * rn * wv; }
            v4u o0, o1; o0.x = pkbf(z[0].x, z[0].y); o0.y = pkbf(z[0].z, z[0].w); o0.z = pkbf(z[1].x, z[1].y); o0.w = pkbf(z[1].z, z[1].w);
            o1.x = pkbf(z[2].x, z[2].y); o1.y = pkbf(z[2].z, z[2].w); o1.z = pkbf(z[3].x, z[3].y); o1.w = pkbf(z[3].z, z[3].w);
            v4u* xo = (v4u*)(XNO + (size_t)(tok0 + tl) * DM + 16 * lane); xo[0] = o0; xo[1] = o1;
        }
    }
    LDS_WAIT();
}
template <int N> __device__ __forceinline__ void sortnet_desc(unsigned (&a)[N]) {
#pragma unroll
    for (int k = 2; k <= N; k <<= 1)
#pragma unroll
        for (int j = k >> 1; j > 0; j >>= 1)
#pragma unroll
            for (int i = 0; i < N; ++i) { const int l = i ^ j; if (l > i) { const bool desc = ((i & k) == 0); const unsigned x = a[i], y = a[l]; const unsigned mx = __builtin_elementwise_max(x, y), mn = __builtin_elementwise_min(x, y); a[i] = desc ? mx : mn; a[l] = desc ? mn : mx; } }
}
template <int N> __device__ __forceinline__ void bitonic_merge_desc(unsigned (&a)[N]) {
#pragma unroll
    for (int j = N >> 1; j > 0; j >>= 1)
#pragma unroll
        for (int i = 0; i < N; ++i) { const int l = i ^ j; if (l > i) { const unsigned x = a[i], y = a[l]; a[i] = __builtin_elementwise_max(x, y); a[l] = __builtin_elementwise_min(x, y); } }
}
__device__ __forceinline__ void sort16_desc(unsigned (&a)[16]) {
#define SN_CE(i, j) { const unsigned x_ = a[i], y_ = a[j]; a[i] = __builtin_elementwise_max(x_, y_); a[j] = __builtin_elementwise_min(x_, y_); }
    SN_CE(0,1) SN_CE(2,3) SN_CE(0,2) SN_CE(1,3) SN_CE(1,2) SN_CE(4,5) SN_CE(6,7) SN_CE(4,6) SN_CE(5,7) SN_CE(5,6) SN_CE(0,4) SN_CE(2,6) SN_CE(2,4) SN_CE(1,5) SN_CE(3,7) SN_CE(3,5) SN_CE(1,2) SN_CE(3,4) SN_CE(5,6) SN_CE(8,9) SN_CE(10,11) SN_CE(8,10) SN_CE(9,11) SN_CE(9,10) SN_CE(12,13) SN_CE(14,15) SN_CE(12,14) SN_CE(13,15) SN_CE(13,14) SN_CE(8,12) SN_CE(10,14) SN_CE(10,12) SN_CE(9,13) SN_CE(11,15) SN_CE(11,13) SN_CE(9,10) SN_CE(11,12) SN_CE(13,14) SN_CE(0,8) SN_CE(4,12) SN_CE(4,8) SN_CE(2,10) SN_CE(6,14) SN_CE(6,10) SN_CE(2,4) SN_CE(6,8) SN_CE(10,12) SN_CE(1,9) SN_CE(5,13) SN_CE(5,9) SN_CE(3,11) SN_CE(7,15) SN_CE(7,11) SN_CE(3,5) SN_CE(7,9) SN_CE(11,13) SN_CE(1,2) SN_CE(3,4) SN_CE(5,6) SN_CE(7,8) SN_CE(9,10) SN_CE(11,12) SN_CE(13,14)
#undef SN_CE
}
__device__ __forceinline__ void top16_merge(unsigned (&a)[16], const unsigned (&b)[16]) {
#pragma unroll
    for (int i = 0; i < 16; ++i) { const unsigned y = b[15 - i]; a[i] = __builtin_elementwise_max(a[i], y); }
    bitonic_merge_desc<16>(a);
}
__device__ __forceinline__ void top16_xchg32(unsigned (&a)[16], bool upper) {
    unsigned o[16];
#pragma unroll
    for (int i = 0; i < 16; ++i) { auto sw = __builtin_amdgcn_permlane32_swap(a[i], a[i], false, false); const unsigned lo_ = sw[0], hi_ = sw[1]; o[i] = upper ? lo_ : hi_; }
    top16_merge(a, o);
}
constexpr int PS_KP = 136;
__device__ __forceinline__ void peer_select_unit(int unit, const bf16* QP, const LAS bf16* KLDS, int* EXPO, float* GATEO, LAS unsigned* KL, int wave, int lane) {
    const int h = unit & 7, tile = unit >> 3, r = lane & 31, hh = lane >> 5, tok = tile * 256 + wave * 32 + r;
    LAS unsigned* kl = KL + lane;
    f32x16 f0, f1;
    bf16x8 qf[8];
#pragma unroll
    for (int s = 0; s < 8; ++s) qf[s] = *(const bf16x8*)(QP + (size_t)tok * NQP + h * 256 + 8 * hh + 16 * s);
#pragma unroll
    for (int p = 0; p < 2; ++p) {
        f32x16 acc[4];
#pragma unroll
        for (int nt = 0; nt < 4; ++nt)
#pragma unroll
            for (int i = 0; i < 16; ++i) acc[nt][i] = 0.f;
        const LAS bf16* krow = KLDS + (p * 128 + r) * PS_KP + 8 * hh;
        bf16x8 ka[2][4];
#pragma unroll
        for (int nt = 0; nt < 4; ++nt) ka[0][nt] = *(const LAS bf16x8*)(krow + nt * 32 * PS_KP);
#pragma unroll
        for (int s = 0; s < 8; ++s) {
            if (s + 1 < 8) {
#pragma unroll
                for (int nt = 0; nt < 4; ++nt) ka[(s + 1) & 1][nt] = *(const LAS bf16x8*)(krow + nt * 32 * PS_KP + 16 * (s + 1)); }
            __builtin_amdgcn_sched_barrier(0);
            const bf16x8 b = qf[s];
#pragma unroll
            for (int nt = 0; nt < 4; ++nt) acc[nt] = MFMA32(ka[s & 1][nt], b, acc[nt]);
            __builtin_amdgcn_sched_barrier(0);
        }
        if (p == 0) {
#pragma unroll
            for (int s = 0; s < 8; ++s) qf[s] = *(const bf16x8*)(QP + (size_t)tok * NQP + h * 256 + 128 + 8 * hh + 16 * s); }
        unsigned top[16];
#pragma unroll
        for (int nt = 0; nt < 4; ++nt) {
            unsigned c[16];
#pragma unroll
            for (int i = 0; i < 16; ++i) { const int n = nt * 32 + (i & 3) + 8 * (i >> 2) + 4 * hh; c[i] = (ord_key(acc[nt][i]) & ~0x7Fu) | (unsigned)(127 - n); }
            sort16_desc(c);
            if (nt == 0) {
#pragma unroll
                for (int i = 0; i < 16; ++i) top[i] = c[i];
            } else top16_merge(top, c);
        }
        top16_xchg32(top, hh != 0);
#pragma unroll
        for (int i = 0; i < 16; ++i) { kl[(p * 16 + i) * 64] = top[i]; const float f = ord_dec(top[i] & ~0x7Fu); if (p == 0) f0[i] = f; else f1[i] = f; }
    }
    unsigned cd[32];
#define PSEL_C(idx, a0, b0, a1, b1) { const float sm = (hh ? f0[a1] : f0[a0]) + (hh ? f1[b1] : f1[b0]); const int fl = hh ? ((a1) * 16 + (b1)) : ((a0) * 16 + (b0)); cd[idx] = (ord_key(sm) & ~0xFFu) | (unsigned)(255 - fl); }
#define PSEL_C0(idx, a0, b0) { const float sm = f0[a0] + f1[b0]; cd[idx] = hh ? 0u : ((ord_key(sm) & ~0xFFu) | (unsigned)(255 - ((a0) * 16 + (b0)))); }
#define PSEL_C1(idx, a1, b1) { const float sm = f0[a1] + f1[b1]; cd[idx] = hh ? ((ord_key(sm) & ~0xFFu) | (unsigned)(255 - ((a1) * 16 + (b1)))) : 0u; }
    PSEL_C(0, 0, 0, 1, 0) PSEL_C(1, 0, 1, 1, 1) PSEL_C(2, 0, 2, 1, 2) PSEL_C(3, 0, 3, 1, 3) PSEL_C(4, 0, 4, 1, 4) PSEL_C(5, 0, 5, 1, 5) PSEL_C(6, 0, 6, 1, 6) PSEL_C(7, 0, 7, 1, 7)
    PSEL_C(8, 0, 8, 3, 0) PSEL_C(9, 0, 9, 3, 1) PSEL_C(10, 0, 10, 3, 2) PSEL_C(11, 0, 11, 3, 3) PSEL_C(12, 0, 12, 5, 0) PSEL_C(13, 0, 13, 5, 1) PSEL_C(14, 0, 14, 6, 0) PSEL_C(15, 0, 15, 6, 1)
    PSEL_C(16, 2, 0, 7, 0) PSEL_C(17, 2, 1, 7, 1) PSEL_C(18, 2, 2, 8, 0) PSEL_C(19, 2, 3, 9, 0) PSEL_C(20, 2, 4, 10, 0) PSEL_C(21, 4, 0, 11, 0) PSEL_C(22, 4, 1, 12, 0) PSEL_C(23, 4, 2, 13, 0)
    PSEL_C1(24, 14, 0) PSEL_C1(25, 15, 0)
#pragma unroll
    for (int i = 26; i < 32; ++i) cd[i] = 0u;
#undef PSEL_C
#undef PSEL_C0
#undef PSEL_C1
    unsigned ca[16], cb[16];
#pragma unroll
    for (int i = 0; i < 16; ++i) { ca[i] = cd[i]; cb[i] = cd[16 + i]; }
    sort16_desc(ca); sort16_desc(cb); top16_merge(ca, cb); top16_xchg32(ca, hh != 0);
    typedef unsigned u32x16 __attribute__((ext_vector_type(16)));
    u32x16 cav; f32x16 e;
#pragma unroll
    for (int i = 0; i < 16; ++i) cav[i] = ca[i];
    const float bmax = ord_dec(ca[0] & ~0xFFu); float sum = 0.f;
#pragma unroll
    for (int i = 0; i < 16; ++i) { e[i] = __expf(ord_dec(ca[i] & ~0xFFu) - bmax); sum += e[i]; }
    const float inv = 1.0f / sum;
    LDS_WAIT();
    int* eo = EXPO + (size_t)tok * 128 + h * 16 + 8 * hh; float* go = GATEO + (size_t)tok * 128 + h * 16 + 8 * hh;
    int ex8[8]; float g8[8];
#pragma unroll
    for (int i = 0; i < 8; ++i) {
        const unsigned key = hh ? cav[8 + i] : cav[i]; const float ev = hh ? e[8 + i] : e[i];
        const int fl = 255 - (int)(key & 0xFFu), a = fl >> 4, b = fl & 15;
        const unsigned ka = kl[a * 64], kb = kl[(16 + b) * 64];
        ex8[i] = (127 - (int)(ka & 0x7Fu)) * 128 + (127 - (int)(kb & 0x7Fu)); g8[i] = ev * inv;
    }
    { v4u w0, w1; w0.x = (unsigned)ex8[0]; w0.y = (unsigned)ex8[1]; w0.z = (unsigned)ex8[2]; w0.w = (unsigned)ex8[3]; w1.x = (unsigned)ex8[4]; w1.y = (unsigned)ex8[5]; w1.z = (unsigned)ex8[6]; w1.w = (unsigned)ex8[7];
      ((v4u*)eo)[0] = w0; ((v4u*)eo)[1] = w1;
      ((f32x4*)go)[0] = (f32x4){g8[0], g8[1], g8[2], g8[3]}; ((f32x4*)go)[1] = (f32x4){g8[4], g8[5], g8[6], g8[7]}; }
    LDS_WAIT();
}
__device__ __forceinline__ void psel_stage_keys(const bf16* K, LAS bf16* KLDS, int tid) {
    __syncthreads();
#pragma unroll
    for (int i = 0; i < 8; ++i) { const int c = tid + NTHR * i, row = c >> 4, ch = c & 15;
        *(LAS v4u*)(KLDS + row * PS_KP + 8 * ch) = *(const v4u*)(K + (size_t)row * 128 + 8 * ch); }
    __syncthreads();
}
struct Args { const float* in[22]; float* out; unsigned char* ws; int ph_lo, ph_hi, li, pad; };
enum { I_X = 0, I_NMIX, I_NFFN, I_FNORM, I_EWIN, I_LNW, I_WS, I_BS, I_POS, I_CKW1, I_CKW2, I_CVW1, I_CVW2, I_EWOUT, I_OWIN, I_LB, I_HNW, I_OWOUT, I_PWQ, I_PKEYS, I_PU, I_PV };

#define WSP_EARLY ((unsigned char*)args.ws)
__global__ void __launch_bounds__(NTHR, 2) fwd_kernel(Args args) {
    extern __shared__ __attribute__((aligned(16))) unsigned char lds_raw[];
    LAS unsigned char* lds = (LAS unsigned char*)lds_raw;
    volatile LAS unsigned* MISC = (volatile LAS unsigned*)(lds + MISC_OFF);
    const int tid = threadIdx.x, lane = tid & 63, wave = __builtin_amdgcn_readfirstlane(tid >> 6);
    const int G = gridDim.x, bx = blockIdx.x;
    const int gw = bx * NWAVES + wave, NGW = G * NWAVES, gtid = bx * NTHR + tid, gthreads = G * NTHR;
    typedef __attribute__((address_space(4))) const volatile Args CArgs;
    CArgs* kargs = (CArgs*)__builtin_amdgcn_kernarg_segment_ptr();
    gu32* ctl = (gu32*)(WSP_EARLY + WS_CTL);
    for (int u = tid; u < (LDS_BYTES - LDSCTL_OFF) / 4; u += NTHR) ((LAS unsigned*)(lds + LDSCTL_OFF))[u] = 0u;
    __syncthreads();
    XcdBarrier bar; bar.bar = (unsigned*)(ctl + CW_BAR); bar.x = 0; bar.st = nullptr;
    if (MK_N_LAUNCHES == 1) bar = xcd_barrier_post((unsigned*)(ctl + CW_BAR), MISC + 8);
    const int lo = args.ph_lo, hi = args.ph_hi;
#define IN(k) (lo <= (k) && (k) < hi)
#ifndef PROBE_REPEAT
#define PROBE_REPEAT -1
#endif
#ifndef PROBE_BAR2
#define PROBE_BAR2 0
#endif
#ifndef PROBE_EXMASK
#define PROBE_EXMASK 0x3FFF
#endif
#define NREP(k) ((k) == PROBE_REPEAT ? 2 : 1)
#define DRY(k) ((k) == PROBE_REPEAT && rep_ == 0)
#define PH_IDS int tid_o_ = threadIdx.x; asm volatile("" : "+v"(tid_o_)); const int tid = tid_o_, lane = tid & 63, wave = __builtin_amdgcn_readfirstlane(tid >> 6), gw = bx * NWAVES + wave, gtid = bx * NTHR + tid; (void)lane; (void)wave; (void)gw; (void)gtid
#define SEAM(k) do { if (IN(k) && IN((k) + 1)) { xcd_barrier(bar); if (PROBE_BAR2) xcd_barrier(bar); } } while (0)

#define AIN(i) ((const float*)kargs->in[i])
#define WSP ((unsigned char*)kargs->ws)
#define Win0t ((bf16*)(WSP + WS_WIN0))
#define Wout0t ((bf16*)(WSP + WS_WOUT0))
#define Win1t ((bf16*)(WSP + WS_WIN1))
#define Wout1t ((bf16*)(WSP + WS_WOUT1))
#define Wqt ((bf16*)(WSP + WS_WQ))
#define KEYS ((bf16*)(WSP + WS_KEYS))
#define WSTRIL ((bf16*)(WSP + WS_WSTRIL))
#define LBV ((float*)(WSP + WS_LB))
#define KCMP ((bf16*)(WSP + WS_KCMP))
#define VCMP ((bf16*)(WSP + WS_VCMP))
#define XN ((bf16*)(WSP + WS_XN))
#define MIX ((bf16*)(WSP + WS_MIX))
#define TAB8U(l) ((unsigned char*)(WSP + WS_TAB8 + (size_t)(l) * 32 * MiB))
#define TAB8V(l) ((unsigned char*)(WSP + WS_TAB8 + (size_t)(l) * 32 * MiB + 16 * MiB))
#define SCLU(l) ((float*)(WSP + WS_SCL + (size_t)(l) * 131072))
#define SCLV(l) ((float*)(WSP + WS_SCL + (size_t)(l) * 131072 + 65536))
#define EXPB ((int*)(WSP + WS_EXP))
#define GATEB ((float*)(WSP + WS_GATE))
#define PB ((bf16*)(WSP + WS_P))
#define xres ((float*)kargs->out)
#define XRB ((bf16*)kargs->out)
#define X3B ((bf16*)(WSP + WS_P + 128 * MiB))
#define RSB(l) ((float*)(WSP + WS_P + 192 * MiB))
    for (int rep_ = 0; rep_ < NREP(0); ++rep_) if (IN(0)) { PH_IDS;
        LAS float* scr = (LAS float*)(lds + wave * 16384);
        {
            const int n0 = (DM / 64) * (NP0 / 32), n1 = (DM / 64) * (DM / 32), n2 = (DM / 64) * (NP1 / 32), n3 = n1, n4 = (DM / 64) * (NQP / 32), n5 = n4;
            const int tot = n0 + n1 + n2 + n3 + n4 + n5;
            for (int it = gw; it < tot; it += NGW) { int r = it;
                if (r < n0) { tr_item(AIN(I_EWIN), DM, NP0_REAL, Win0t, scr, r, NP0 / 32, lane); continue; } r -= n0;
                if (r < n1) { tr_item(AIN(I_EWOUT), DM, DM, Wout0t, scr, r, DM / 32, lane); continue; } r -= n1;
                if (r < n2) { tr_item(AIN(I_OWIN), DM, NP1, Win1t, scr, r, NP1 / 32, lane); continue; } r -= n2;
                if (r < n3) { tr_item(AIN(I_OWOUT), DM, DM, Wout1t, scr, r, DM / 32, lane); continue; } r -= n3;
                if (r < n4) { tr_item(AIN(I_PWQ), DM, NQP, Wqt, scr, r, NQP / 32, lane, FUSE_NORM ? AIN(I_NFFN) : nullptr); continue; } r -= n4;
                tr_item(AIN(I_PWQ) + (size_t)DM * NQP, DM, NQP, Wqt + (size_t)NQP * DM, scr, r, NQP / 32, lane, FUSE_NORM ? AIN(I_NFFN) + DM : nullptr); }
        }
        {
            bf16* W1T = (bf16*)(WSP + WS_CW1); bf16* W2T = (bf16*)(WSP + WS_CW2); float* B1 = (float*)(WSP + WS_BIAS1);
            for (int it = gw; it < 2 * 128 + 2 * 4; it += NGW) { int r = it;
#if P2_C32
                if (r < 256) continue;
                r -= 256;
#else
                if (r < 128) { tr_item(AIN(I_CKW1), 2048, 128, W1T, scr, r, 4, lane); continue; } r -= 128;
                if (r < 128) { tr_item(AIN(I_CVW1), 2048, 128, W1T + (size_t)128 * 2048, scr, r, 4, lane); continue; } r -= 128;
#endif
                if (r < 4) { tr_item(AIN(I_CKW2), 128, 64, W2T, scr, r, 2, lane); continue; } r -= 4;
                tr_item(AIN(I_CVW2), 128, 64, W2T + 64 * 128, scr, r, 2, lane); }
#if P2_C32
            for (int it = gw; it < 1024; it += NGW) {
                const int ks = it & 127, ht = (it >> 7) & 3; const float* w1 = (it >> 9) ? AIN(I_CVW1) : AIN(I_CKW1);
                const float* s0 = w1 + (size_t)(16 * ks + 8 * (lane >> 5)) * 128 + 32 * ht + (lane & 31);
                v4u o; o.x = pk2(s0[0], s0[128]); o.y = pk2(s0[256], s0[384]); o.z = pk2(s0[512], s0[640]); o.w = pk2(s0[768], s0[896]);
                *((v4u*)W1T + (size_t)it * 64 + lane) = o; }
#endif
            for (int o = gw; o < 256; o += NGW) { const float* w1 = (o < 128) ? AIN(I_CKW1) : AIN(I_CVW1); const int hid = o & 127; float a = 0.f;
                for (int jj = lane; jj < 2048; jj += 64) a += AIN(I_POS)[jj] * w1[(size_t)jj * 128 + hid];
                a = wave_sum(a); if (lane == 0) B1[o] = a; }
        }
        cvt_items(AIN(I_PKEYS), KEYS, (size_t)2 * 8 * 2 * 128 * 128, gw, NGW, lane);
        for (int l = 0; l < (TAB1_IN_P7 ? 1 : 2); ++l) { tab_to_fp8(AIN(I_PU) + (size_t)l * NEXP * DM, TAB8U(l), SCLU(l), NEXP, gw, NGW, lane); tab_to_fp8(AIN(I_PV) + (size_t)l * NEXP * DM, TAB8V(l), SCLV(l), NEXP, gw, NGW, lane); }
        for (int i = gtid; i < 4 * 128 * 128; i += gthreads) { const int t = (i >> 7) & 127, s = i & 127; WSTRIL[i] = (s <= t) ? f2bf(AIN(I_WS)[i]) : (bf16)0; }
        for (int i = gtid; i < DM; i += gthreads) LBV[i] = sigmoidf_(AIN(I_LB)[DM + i] - AIN(I_LB)[i]);
        rms_rows(AIN(I_X), AIN(I_NMIX), XN, nullptr, gw, NGW, lane);
    }
    SEAM(0);
    for (int rep_ = 0; rep_ < NREP(1); ++rep_) if (IN(1)) { PH_IDS;
#if FAST_GEMM
        pg8::Gemm g{XN, Win0t, MTOK, NP0, DM}; pg8::StaticOrder S; S.init(MTOK, NP0, G, bx);
        pg8::EpiAct<0> E{PB, NP0, nullptr};
        pg8::gemm_phase<pg8::EpiAct<0>, pg8::StaticOrder, GEMM_ALIGN_ACT, true>(lds + RING_OFF, g, S, E);
#else
        naive_gemm(XN, Win0t, MTOK, NP0, DM, NEpiAct{PB, NP0, 0, nullptr}, gtid, gthreads);
#endif
    }
    SEAM(1);
    for (int rep_ = 0; rep_ < NREP(2); ++rep_) if (IN(2)) { PH_IDS;
#if FAST_P2
        if (G == 256) {
#if P2_C32
#ifdef P2_CMP_REP
            compress_unit32(bx, PB, (const bf16*)(WSP + WS_CW1), (const bf16*)(WSP + WS_CW2), (const float*)(WSP + WS_BIAS1), KCMP, VCMP, lds, tid);
#endif
            compress_unit32(bx, PB, (const bf16*)(WSP + WS_CW1), (const bf16*)(WSP + WS_CW2), (const float*)(WSP + WS_BIAS1), KCMP, VCMP, lds, tid);
            gmlp_run(bx, 4, 256, PB, AIN(I_LNW), WSTRIL, AIN(I_BS), MIX, lds, tid);
#elif P2_PIPE
#ifdef P2_CMP_REP
            if (bx < 128) compress_unit(bx, PB, (const bf16*)(WSP + WS_CW1), (const bf16*)(WSP + WS_CW2), (const float*)(WSP + WS_BIAS1), KCMP, VCMP, lds, tid);
#endif
            if (bx < 128) { compress_unit(bx, PB, (const bf16*)(WSP + WS_CW1), (const bf16*)(WSP + WS_CW2), (const float*)(WSP + WS_BIAS1), KCMP, VCMP, lds, tid);
                gmlp_run(bx, P2_NC, 128, PB, AIN(I_LNW), WSTRIL, AIN(I_BS), MIX, lds, tid); }
            else gmlp_run(128 * P2_NC + (bx - 128), (1024 - 128 * P2_NC) / 128, 128, PB, AIN(I_LNW), WSTRIL, AIN(I_BS), MIX, lds, tid);
#else
            if (bx < 128) { compress_unit(bx, PB, (const bf16*)(WSP + WS_CW1), (const bf16*)(WSP + WS_CW2), (const float*)(WSP + WS_BIAS1), KCMP, VCMP, lds, tid);
                for (int k = 0; k < 3; ++k) gmlp_unit(bx + 128 * k, PB, AIN(I_LNW), WSTRIL, AIN(I_BS), MIX, lds, tid); }
            else { for (int k = 0; k < 5; ++k) gmlp_unit(384 + (bx - 128) + 128 * k, PB, AIN(I_LNW), WSTRIL, AIN(I_BS), MIX, lds, tid); }
#endif
        } else
        for (int u = bx; u < 128 + 1024; u += G) {
            if (u < 128) compress_unit(u, PB, (const bf16*)(WSP + WS_CW1), (const bf16*)(WSP + WS_CW2), (const float*)(WSP + WS_BIAS1), KCMP, VCMP, lds, tid);
            else gmlp_unit(u - 128, PB, AIN(I_LNW), WSTRIL, AIN(I_BS), MIX, lds, tid);
        }
#else
        for (int u = bx; u < 1024; u += G) naive_gmlp_unit(u, PB, AIN(I_LNW), AIN(I_WS), AIN(I_BS), MIX, lds, tid);
        for (int cu = bx; cu < 2 * NCMP * 8; cu += G) naive_compress_unit(cu, PB, AIN(I_POS), AIN(I_CKW1), AIN(I_CKW2), AIN(I_CVW1), AIN(I_CVW2), KCMP, VCMP, lds, tid);
#endif
    }
    SEAM(2);
    for (int rep_ = 0; rep_ < NREP(3); ++rep_) if (IN(3)) { PH_IDS;
#if FAST_NSA
        for (int u = bx; u < 1024; u += G) {
            int u2 = u;
            if (G == 256 && ((u >> 8) & 1)) u2 = (u & ~(31 << 3)) | ((31 - ((u >> 3) & 31)) << 3);
            nsa_unit(u2, PB, KCMP, VCMP, MIX, lds, tid); }
#else
        for (int wu = gw; wu < BATCH * 2 * SEQ; wu += NGW) naive_nsa_wave(wu, PB, KCMP, VCMP, MIX, lds + wave * NSA_WAVE_LDS, lane);
#endif
    }
    SEAM(3);
    for (int rep_ = 0; rep_ < NREP(4); ++rep_) if (IN(4)) { PH_IDS;
#if FAST_GEMM
        pg8::Gemm g{MIX, Wout0t, MTOK, DM, DM}; pg8::StaticOrder S; S.init(MTOK, DM, G, bx);
#if FUSE_NORM
        pg8::EpiResidNorm E{AIN(I_X), xres, XN, RSB(0), DM};
        pg8::gemm_phase<pg8::EpiResidNorm, pg8::StaticOrder, true, true>(lds + RING_OFF, g, S, E);
#elif RESID_BF16
        pg8::EpiResidBf<false> E{AIN(I_X), XRB, DM};
        pg8::gemm_phase<pg8::EpiResidBf<false>, pg8::StaticOrder, GEMM_ALIGN_RES, true>(lds + RING_OFF, g, S, E);
#else
        pg8::EpiResid E{AIN(I_X), xres, DM};
        pg8::gemm_phase<pg8::EpiResid, pg8::StaticOrder, true, true>(lds + RING_OFF, g, S, E);
#endif
#else
        naive_gemm(MIX, Wout0t, MTOK, DM, DM, NEpiResid{AIN(I_X), xres, DM}, gtid, gthreads);
#endif
    }
    SEAM(4);
#if !FUSE_NORM
    for (int rep_ = 0; rep_ < NREP(5); ++rep_) if (IN(5)) { PH_IDS; if (RESID_BF16) rms_rows_bf(XRB, AIN(I_NFFN), XN, gw, NGW, lane); else rms_rows(xres, AIN(I_NFFN), XN, nullptr, gw, NGW, lane); }
    SEAM(5);
#endif
    for (int rep_ = 0; rep_ < NREP(6); ++rep_) if (IN(6)) { PH_IDS;
#if FAST_GEMM
        pg8::Gemm g{XN, Wqt, MTOK, NQP, DM}; pg8::StaticOrder S; S.init(MTOK, NQP, G, bx);
#if FUSE_NORM
        pg8::EpiRowScale E{PB, NQP, RSB(0), 1.0f / DM, EPS};
        pg8::gemm_phase<pg8::EpiRowScale, pg8::StaticOrder, true, true>(lds + RING_OFF, g, S, E);
#else
        pg8::EpiAct<2> E{PB, NQP, nullptr};
        pg8::gemm_phase<pg8::EpiAct<2>, pg8::StaticOrder, true, true>(lds + RING_OFF, g, S, E);
#endif
#else
        naive_gemm(XN, Wqt, MTOK, NQP, DM, NEpiAct{PB, NQP, 2, nullptr}, gtid, gthreads);
#endif
    }
    SEAM(6);
#if FAST_PSEL
    for (int rep_ = 0; rep_ < NREP(7); ++rep_) if (IN(7)) { PH_IDS; int curh = -1; for (int u = bx; u < 1024; u += G) { if ((u & 7) != curh) { curh = u & 7; psel_stage_keys(KEYS + (size_t)curh * 2 * 128 * 128, (LAS bf16*)(lds + 65536), tid); } peer_select_unit(u, PB, (const LAS bf16*)(lds + 65536), EXPB, GATEB, (LAS unsigned*)(lds + wave * 8192), wave, lane);
            if (TAB1_IN_P7) {
                const int nsl = (1024 + G - 1) / G * G;
                for (int rw = u * 32 + wave * 4; rw < u * 32 + wave * 4 + 4; ++rw) { (void)nsl;
                    if (rw < NEXP) tab_to_fp8(AIN(I_PU) + (size_t)NEXP * DM + (size_t)rw * DM, TAB8U(1) + (size_t)rw * DM, SCLU(1) + rw, 1, 0, 1, lane);
                    else tab_to_fp8(AIN(I_PV) + (size_t)NEXP * DM + (size_t)(rw - NEXP) * DM, TAB8V(1) + (size_t)(rw - NEXP) * DM, SCLV(1) + (rw - NEXP), 1, 0, 1, lane); } } } }
#else
    if (IN(7)) { PH_IDS; for (int wu = gw; wu < MTOK * 8; wu += NGW) naive_peer_select_wave(wu, PB, KEYS, EXPB, GATEB, lds + wave * 2048, lane); }
#endif
    SEAM(7);
#if FAST_PEVAL
#if PEER_CHUNK
    for (int rep_ = 0; rep_ < NREP(8); ++rep_) if (IN(8)) { PH_IDS; for (int t4 = gw; t4 < MTOK / 4; t4 += NGW) peer_eval4c_wave(4 * t4, XN, DRY(8) ? MIX : XN, TAB8U(0), TAB8V(0), SCLU(0), SCLV(0), EXPB, GATEB, xres, DRY(8) ? (float*)PB : xres, AIN(I_NMIX) + DM, nullptr, (LAS float*)(lds + wave * PE4C_LDS), lane); }
#elif PEER_EVAL4
    for (int rep_ = 0; rep_ < NREP(8); ++rep_) if (IN(8)) { PH_IDS; for (int t4 = gw; t4 < MTOK / PT; t4 += NGW) peer_eval4m_wave(PT * t4, XN, DRY(8) ? MIX : XN, TAB8U(0), TAB8V(0), SCLU(0), SCLV(0), EXPB, GATEB, RESID_BF16 ? (const float*)XRB : xres, DRY(8) ? (float*)PB : (RESID_BF16 ? (float*)XRB : xres), AIN(I_NMIX) + DM, nullptr, (LAS float*)(lds + wave * PE4_LDS), lane, FUSE_NORM ? RSB(0) : nullptr, AIN(I_NFFN) + 0 * DM); }
#else
    for (int rep_ = 0; rep_ < NREP(8); ++rep_) if (IN(8)) { PH_IDS; for (int tok = gw; tok < MTOK; tok += NGW) peer_eval_wave(tok, XN, DRY(8) ? MIX : XN, TAB8U(0), TAB8V(0), SCLU(0), SCLV(0), EXPB, GATEB, xres, DRY(8) ? (float*)PB : xres, AIN(I_NMIX) + DM, nullptr, (LAS float*)(lds + wave * 2048), lane, DRY(8) ? PROBE_EXMASK : 0x3FFF); }
#endif
    SEAM(8);
#else
    if (IN(8)) { PH_IDS; for (int tok = gw; tok < MTOK; tok += NGW) naive_peer_eval_wave(tok, XN, (const bf16*)TAB8U(0), (const bf16*)TAB8V(0), EXPB, GATEB, xres, nullptr, nullptr, lane); }
    SEAM(8);
    if (IN(9)) { PH_IDS; rms_rows(xres, AIN(I_NMIX) + DM, XN, nullptr, gw, NGW, lane); }
    SEAM(9);
#endif
    for (int rep_ = 0; rep_ < NREP(10); ++rep_) if (IN(10)) { PH_IDS;
#if FAST_GEMM
        pg8::Gemm g{XN, Win1t, MTOK, NP1, DM}; pg8::StaticOrder S; S.init(MTOK, NP1, G, bx);
        pg8::EpiAct<1> E{PB, NP1, LBV};
        pg8::gemm_phase<pg8::EpiAct<1>, pg8::StaticOrder, GEMM_ALIGN_ACT, true>(lds + RING_OFF, g, S, E);
#else
        naive_gemm(XN, Win1t, MTOK, NP1, DM, NEpiAct{PB, NP1, 1, LBV}, gtid, gthreads);
#endif
    }
    SEAM(10);
#if FAST_HGRN
    for (int rep_ = 0; rep_ < NREP(11); ++rep_) if (IN(11)) { PH_IDS; for (int u = bx; u < 256; u += G) hgrn_pass_a(u, PB, (float*)(WSP + WS_EXP), (float*)(WSP + WS_GATE), lds, tid); }
#endif
    SEAM(11);
#if FAST_HGRN
    for (int rep_ = 0; rep_ < NREP(12); ++rep_) if (IN(12)) { PH_IDS; for (int u = bx; u < 256; u += G) hgrn_pass_c(u, PB, (const float*)(WSP + WS_EXP), (const float*)(WSP + WS_GATE), AIN(I_HNW), MIX, lds, tid); }
#else
    if (IN(12)) { PH_IDS; for (int blk = bx; blk < 8; blk += G) naive_hgrn_block(blk, PB, AIN(I_HNW), MIX, lds, tid); }
#endif
    SEAM(12);
    for (int rep_ = 0; rep_ < NREP(13); ++rep_) if (IN(13)) { PH_IDS;
#if FAST_GEMM
        pg8::Gemm g{MIX, Wout1t, MTOK, DM, DM}; pg8::StaticOrder S; S.init(MTOK, DM, G, bx);
#if FUSE_NORM
        pg8::EpiResidNorm E{xres, DRY(13) ? (float*)PB : xres, XN, RSB(1), DM};
        pg8::gemm_phase<pg8::EpiResidNorm, pg8::StaticOrder, true, true>(lds + RING_OFF, g, S, E);
#elif RESID_BF16
        pg8::EpiResidBf<true> E{XRB, DRY(13) ? PB : X3B, DM};
        pg8::gemm_phase<pg8::EpiResidBf<true>, pg8::StaticOrder, GEMM_ALIGN_RES, true>(lds + RING_OFF, g, S, E);
#else
        pg8::EpiResid E{xres, DRY(13) ? (float*)PB : xres, DM};
        pg8::gemm_phase<pg8::EpiResid, pg8::StaticOrder, true, true>(lds + RING_OFF, g, S, E);
#endif
#else
        naive_gemm(MIX, Wout1t, MTOK, DM, DM, NEpiResid{xres, xres, DM}, gtid, gthreads);
#endif
    }
    SEAM(13);
#if !FUSE_NORM
    for (int rep_ = 0; rep_ < NREP(14); ++rep_) if (IN(14)) { PH_IDS; if (RESID_BF16) rms_rows_bf(X3B, AIN(I_NFFN) + DM, XN, gw, NGW, lane); else rms_rows(xres, AIN(I_NFFN) + DM, XN, nullptr, gw, NGW, lane); }
    SEAM(14);
#endif
    for (int rep_ = 0; rep_ < NREP(15); ++rep_) if (IN(15)) { PH_IDS;
#if FAST_GEMM
        pg8::Gemm g{XN, Wqt + (size_t)NQP * DM, MTOK, NQP, DM}; pg8::StaticOrder S; S.init(MTOK, NQP, G, bx);
#if FUSE_NORM
        pg8::EpiRowScale E{PB, NQP, RSB(1), 1.0f / DM, EPS};
        pg8::gemm_phase<pg8::EpiRowScale, pg8::StaticOrder, true, true>(lds + RING_OFF, g, S, E);
#else
        pg8::EpiAct<2> E{PB, NQP, nullptr};
        pg8::gemm_phase<pg8::EpiAct<2>, pg8::StaticOrder, true, true>(lds + RING_OFF, g, S, E);
#endif
#else
        naive_gemm(XN, Wqt + (size_t)NQP * DM, MTOK, NQP, DM, NEpiAct{PB, NQP, 2, nullptr}, gtid, gthreads);
#endif
    }
    SEAM(15);
#if FAST_PSEL
    for (int rep_ = 0; rep_ < NREP(16); ++rep_) if (IN(16)) { PH_IDS; int curh = -1; for (int u = bx; u < 1024; u += G) { if ((u & 7) != curh) { curh = u & 7; psel_stage_keys(KEYS + (size_t)(8 + curh) * 2 * 128 * 128, (LAS bf16*)(lds + 65536), tid); } peer_select_unit(u, PB, (const LAS bf16*)(lds + 65536), EXPB, GATEB, (LAS unsigned*)(lds + wave * 8192), wave, lane); } }
#else
    if (IN(16)) { PH_IDS; for (int wu = gw; wu < MTOK * 8; wu += NGW) naive_peer_select_wave(wu, PB, KEYS + (size_t)8 * 2 * 128 * 128, EXPB, GATEB, lds + wave * 2048, lane); }
#endif
    SEAM(16);
#if FAST_PEVAL
#if PEER_CHUNK
    for (int rep_ = 0; rep_ < NREP(17); ++rep_) if (IN(17)) { PH_IDS; for (int t4 = gw; t4 < MTOK / 4; t4 += NGW) peer_eval4c_wave(4 * t4, XN, XN, TAB8U(1), TAB8V(1), SCLU(1), SCLV(1), EXPB, GATEB, xres, DRY(17) ? (float*)PB : xres, nullptr, AIN(I_FNORM), (LAS float*)(lds + wave * PE4C_LDS), lane); }
#elif PEER_EVAL4
    for (int rep_ = 0; rep_ < NREP(17); ++rep_) if (IN(17)) { PH_IDS; for (int t4 = gw; t4 < MTOK / PT; t4 += NGW) peer_eval4m_wave(PT * t4, XN, XN, TAB8U(1), TAB8V(1), SCLU(1), SCLV(1), EXPB, GATEB, RESID_BF16 ? (const float*)X3B : xres, DRY(17) ? (float*)PB : xres, nullptr, AIN(I_FNORM), (LAS float*)(lds + wave * PE4_LDS), lane, FUSE_NORM ? RSB(1) : nullptr, AIN(I_NFFN) + 1 * DM); }
#else
    for (int rep_ = 0; rep_ < NREP(17); ++rep_) if (IN(17)) { PH_IDS; for (int tok = gw; tok < MTOK; tok += NGW) peer_eval_wave(tok, XN, XN, TAB8U(1), TAB8V(1), SCLU(1), SCLV(1), EXPB, GATEB, xres, DRY(17) ? (float*)PB : xres, nullptr, AIN(I_FNORM), (LAS float*)(lds + wave * 2048), lane); }
#endif
#else
    if (IN(17)) { PH_IDS; for (int tok = gw; tok < MTOK; tok += NGW) naive_peer_eval_wave(tok, XN, (const bf16*)TAB8U(0), (const bf16*)TAB8V(0), EXPB, GATEB, xres, nullptr, AIN(I_FNORM), lane); }
#endif
#undef IN
#undef SEAM
}

extern "C" void kernel_launch(void* const* d_in, const int* in_sizes, int n_in, void* d_out, int out_size, void* d_ws, size_t ws_size, hipStream_t stream) {
    static int grid = 0;
    if (grid == 0) {
        if (n_in != 22 || in_sizes[0] != MTOK * DM || out_size != MTOK * DM || ws_size < WS_END) { fprintf(stderr, "kernel_launch: unexpected shapes / workspace (n_in %d, ws %zu); nothing launched\n", n_in, ws_size); grid = -1; return; }
        int dev = 0, cus = 0, per_cu = 0;
        if (hipGetDevice(&dev) != hipSuccess || hipDeviceGetAttribute(&cus, hipDeviceAttributeMultiprocessorCount, dev) != hipSuccess) { grid = -1; return; }
        if (hipFuncSetAttribute((const void*)fwd_kernel, hipFuncAttributeMaxDynamicSharedMemorySize, LDS_BYTES) != hipSuccess) { fprintf(stderr, "kernel_launch: hipFuncSetAttribute failed\n"); grid = -1; return; }
        if (hipOccupancyMaxActiveBlocksPerMultiprocessor(&per_cu, (const void*)fwd_kernel, NTHR, LDS_BYTES) != hipSuccess || per_cu < 1) { fprintf(stderr, "kernel_launch: occupancy query reports %d workgroups per CU; nothing launched\n", per_cu); (void)hipGetLastError(); grid = -1; return; }
        grid = cus;
    }
    if (grid < 0) return;
    (void)hipMemsetAsync((char*)d_ws + WS_CTL, 0, CTL_ZERO_BYTES, stream);
    Args a{};
    for (int i = 0; i < 22; ++i) a.in[i] = (const float*)d_in[i];
    a.out = (float*)d_out; a.ws = (unsigned char*)d_ws;
    for (int li = 0; li < MK_N_LAUNCHES; ++li) {
        if (MK_N_LAUNCHES == 1) { a.ph_lo = 0; a.ph_hi = N_PHASES; } else { a.ph_lo = li; a.ph_hi = li + 1; }
        a.li = li;
        hipLaunchKernelGGL(fwd_kernel, dim3(grid), dim3(NTHR), LDS_BYTES, stream, a);
    }
}
```

```cpp
#include <hip/hip_runtime.h>
#include <cstdio>
#include <cstdint>
#ifndef GEMM_XCD2D
#define GEMM_XCD2D 0
#endif
namespace pg8 {
#define PG8_LAS __attribute__((address_space(3)))
typedef unsigned short bf16_t;
typedef short bf16x8 __attribute__((ext_vector_type(8)));
typedef float f32x4 __attribute__((ext_vector_type(4)));
typedef unsigned u32x4 __attribute__((ext_vector_type(4)));
constexpr int BM = 256, BK = 64, HALF = 128, HTB = HALF * BK * 2  , STAGE_BYTES = 8 * HTB, NXCD = 8, WGM = 1;

__host__ __device__ __forceinline__ int lds_byte(int r, int c) { const int st = (r >> 4) * 2 + (c >> 5), rr = r & 15, cc = c & 31, ob = rr * 64 + cc * 2; return st * 1024 + (ob ^ (((ob >> 9) & 1) << 5)); }
__host__ __device__ __forceinline__ void stage_rc(int b, int& R, int& C) { const int st = b / 1024, sb = b % 1024, swz = sb ^ (((sb >> 9) & 1) << 5); R = (st >> 1) * 16 + swz / 64; C = (st & 1) * 32 + (swz % 64) / 2; }
__host__ __device__ __forceinline__ int perm32(int rho) { const int n = rho >> 4, i = rho & 15; return 8 * (i >> 2) + 4 * n + (i & 3); }

struct Unit { int pm, pn; };
struct Gemm { const bf16_t* A; const bf16_t* Bt; int M, N, K; };

struct StaticOrder {
    int nM, nN, nwg, G, c; int rot = 0;
    __host__ __device__ void init(int M, int N, int G_, int c_) { nM = M / BM; nN = N / BM; nwg = nM * nN; G = G_; c = c_; }
    __host__ __device__ bool next(int i, Unit& u) const {
        const long L = (long)i * G + c; if (L >= nwg) return false;
#if GEMM_XCD2D
        {
            const int CPX = (nN % 5 == 0) ? 5 : 4, ncg = nN / CPX;
            if (nN % CPX == 0 && ncg >= 1 && ncg <= NXCD && NXCD % ncg == 0 && nM % (NXCD / ncg) == 0 && nwg % NXCD == 0) {
                const int nrg = NXCD / ncg, xcd = (int)(L % NXCD), off = (int)(L / NXCD), cg = xcd % ncg, rg = xcd / ncg;
                u.pm = rg * (nM / nrg) + off / CPX; u.pn = cg * CPX + off % CPX; return true;
            }
        }
#endif
        int wgid = (int)L; { const int q = nwg / NXCD, r = nwg % NXCD, xcd = wgid % NXCD, off = wgid / NXCD; wgid = (xcd < r ? xcd * (q + 1) : r * (q + 1) + (xcd - r) * q) + off; }
        const int nig = WGM * nN, gid = wgid / nig, fm = gid * WGM, gsz = (nM - fm) < WGM ? (nM - fm) : WGM;
        u.pm = fm + ((wgid % nig) % gsz); u.pn = ((wgid % nig) / gsz + rot * i) % nN; return true;
    }
    __device__ __forceinline__ void a_ready(const Unit&) const {}
    __device__ __forceinline__ void done(const Unit&) const {}
};
__device__ __forceinline__ unsigned cvt_pk_bf16(float lo, float hi) { unsigned r; asm volatile("v_cvt_pk_bf16_f32 %0, %1, %2" : "=v"(r) : "v"(lo), "v"(hi)); return r; }
typedef float f32x2 __attribute__((ext_vector_type(2)));
__device__ __forceinline__ f32x2 gelu_pk(f32x2 v) {
    const f32x2 av = __builtin_elementwise_abs(v), d = av * 0.2316418882f + 1.0f;
    f32x2 t; t.x = __builtin_amdgcn_rcpf(d.x); t.y = __builtin_amdgcn_rcpf(d.y);
    f32x2 q = t * 0.5307027145f + (-0.7265760135f); q = q * t + 0.7107068705f; q = q * t + (-0.142248368f); q = q * t + 0.127414796f; q = q * t;
    const f32x2 s = (v * v) * (-0.72134752044f);
    f32x2 e; e.x = __builtin_amdgcn_exp2f(s.x); e.y = __builtin_amdgcn_exp2f(s.y);
    const f32x2 m = v * (q * e), r = v - m;
    f32x2 o; o.x = v.x < 0.f ? m.x : r.x; o.y = v.y < 0.f ? m.y : r.y; return o;
}

__device__ __forceinline__ float sigmoidf_(float x) { return __builtin_amdgcn_rcpf(1.0f + __builtin_amdgcn_exp2f(-1.4426950408889634f * x)); }
__device__ __forceinline__ float siluf_(float x) { return x * __builtin_amdgcn_rcpf(1.0f + __builtin_amdgcn_exp2f(-1.4426950408889634f * x)); }
__device__ __forceinline__ float gelu_tanh(float x) {
    const float x2 = x * x;
    const float t = x * __builtin_fmaf(x2, -2.0f * 1.4426950408889634f * 0.7978845608028654f * 0.044715f, -2.0f * 1.4426950408889634f * 0.7978845608028654f);
    return x * __builtin_amdgcn_rcpf(1.0f + __builtin_amdgcn_exp2f(t));
}
__device__ __forceinline__ unsigned short f2h_bits(float x) { _Float16 h = (_Float16)x; return __builtin_bit_cast(unsigned short, h); }
__device__ __forceinline__ float h2f_bits(unsigned short b) { _Float16 h = __builtin_bit_cast(_Float16, b); return (float)h; }
__device__ __forceinline__ unsigned short f2bf_rne(float f) { unsigned u = __builtin_bit_cast(unsigned, f); return (unsigned short)((u + 0x7fffu + ((u >> 16) & 1u)) >> 16); }
enum { AK_ID = 0, AK_GELU = 1, AK_SCALE8 = 2, AK_SIGMOID = 3, AK_SILU = 4, AK_KK = 5 };
__device__ __forceinline__ int kind_p0(int col) { return col < 1024 ? AK_GELU : col < 1536 ? AK_SCALE8 : col < 2304 ? AK_ID : AK_SIGMOID; }
__device__ __forceinline__ int kind_p1(int col) { return col < 1024 ? AK_SILU : col < 2048 ? AK_KK : col < 3072 ? AK_ID : AK_SILU; }
__device__ __forceinline__ float act_val(int kind, float v, float lbv) {
    switch (kind) {
        case AK_GELU: return gelu_tanh(v);
        case AK_SCALE8: return v * (0.125f * 1.4426950408889634f);
        case AK_SIGMOID: return sigmoidf_(v);
        case AK_SILU: return siluf_(v);
        case AK_KK: return (1.0f - lbv) * sigmoidf_(-v);
        default: return v;
    }
}
typedef __bf16 ebf16x2 __attribute__((ext_vector_type(2)));
typedef _Float16 ef16x2 __attribute__((ext_vector_type(2)));
__device__ __forceinline__ unsigned act_pack2(int kind, float a, float b, float lba, float lbb) {
    const float x = act_val(kind, a, lba), y = act_val(kind, b, lbb);
    if (kind == AK_KK) { ef16x2 h; h[0] = (_Float16)x; h[1] = (_Float16)y; return __builtin_bit_cast(unsigned, h); }
    ebf16x2 r; r[0] = (__bf16)x; r[1] = (__bf16)y; return __builtin_bit_cast(unsigned, r);
}
__device__ __forceinline__ unsigned short act_store(int kind, float v, float lbv) { return (unsigned short)(act_pack2(kind, v, v, lbv, lbv) & 0xffffu); }
#ifndef GEMM_WT_STORES
#define GEMM_WT_STORES 0
#endif
#ifndef PEER_BUFLD
#define PEER_BUFLD 1
#endif
#ifndef EPI_RESID_PRELOAD
#define EPI_RESID_PRELOAD 0
#endif
__device__ __forceinline__ void store16_wt(void* ptr, u32x4 v) {
#if GEMM_WT_STORES == 2
    asm volatile("global_store_dwordx4 %0, %1, off nt\n\ts_nop 1" :: "v"(ptr), "v"(v) : "memory");
#elif GEMM_WT_STORES
    asm volatile("global_store_dwordx4 %0, %1, off sc1\n\ts_nop 1" :: "v"(ptr), "v"(v) : "memory");
#else
    *(u32x4*)ptr = v;
#endif
}
template <int WHICH> struct EpiAct {
    static constexpr bool PERM = true, AFTER_DRAIN = false;
    bf16_t* O; int ldc; const float* lb; const float* rsd = nullptr;
    __device__ __forceinline__ void operator()(const f32x4 (&acc)[2][2][4][2], const Unit& u, int wr, int wc, int fr, int fq) const {
        const int row0 = u.pm * BM + wr * 64 + fr; const int colt = u.pn * BM;
        const int kind = WHICH == 0 ? kind_p0(colt) : WHICH == 1 ? kind_p1(colt) : AK_ID;
        const int col0 = colt + wc * 32 + 8 * fq;
#pragma unroll
        for (int bj = 0; bj < 2; ++bj) {
            float lbv[8];
#pragma unroll
            for (int e = 0; e < 8; ++e) lbv[e] = (WHICH == 1 && kind == AK_KK) ? lb[col0 + bj * HALF + e - 1024] : 0.f;
#pragma unroll
            for (int ai = 0; ai < 2; ++ai)
#pragma unroll
                for (int m = 0; m < 4; ++m) {
                    f32x4 v0 = acc[ai][bj][m][0], v1 = acc[ai][bj][m][1];
                    if (WHICH == 0 && rsd) { const float r_ = rsd[row0 + ai * HALF + m * 16]; v0 = v0 * r_; v1 = v1 * r_; }
                    u32x4 w;
                    w.x = act_pack2(kind, v0[0], v0[1], lbv[0], lbv[1]);
                    w.y = act_pack2(kind, v0[2], v0[3], lbv[2], lbv[3]);
                    w.z = act_pack2(kind, v1[0], v1[1], lbv[4], lbv[5]);
                    w.w = act_pack2(kind, v1[2], v1[3], lbv[6], lbv[7]);
                    store16_wt(O + (size_t)(row0 + ai * HALF + m * 16) * ldc + col0 + bj * HALF, w);
                }
        }
    }
};
struct EpiResid {
    static constexpr bool PERM = false, AFTER_DRAIN = false;
    const float* base; float* out; int ldc;
    __device__ __forceinline__ void operator()(const f32x4 (&acc)[2][2][4][2], const Unit& u, int wr, int wc, int fr, int fq) const {
        const int row0 = u.pm * BM + wr * 64 + fr; const int col0 = u.pn * BM + wc * 32 + 4 * fq;
#pragma unroll
        for (int ai = 0; ai < 2; ++ai)
#pragma unroll
            for (int m = 0; m < 4; ++m) { const size_t off = (size_t)(row0 + ai * HALF + m * 16) * ldc + col0;
#pragma unroll
                for (int bj = 0; bj < 2; ++bj)
#pragma unroll
                    for (int n = 0; n < 2; ++n) { const f32x4 b = *(const f32x4*)(base + off + bj * HALF + n * 16); *(f32x4*)(out + off + bj * HALF + n * 16) = b + acc[ai][bj][m][n]; } }
    }
};
struct EpiResidNorm {
    static constexpr bool PERM = false, AFTER_DRAIN = false;
    const float* base; float* out; bf16_t* xb; float* rs; int ldc;
    __device__ __forceinline__ void operator()(const f32x4 (&acc)[2][2][4][2], const Unit& u, int wr, int wc, int fr, int fq) const {
        const int row0 = u.pm * BM + wr * 64 + fr; const int col0 = u.pn * BM + wc * 32 + 4 * fq;
#pragma unroll
        for (int ai = 0; ai < 2; ++ai)
#pragma unroll
            for (int m = 0; m < 4; ++m) { const int row = row0 + ai * HALF + m * 16; const size_t off = (size_t)row * ldc + col0; float ss = 0.f;
#pragma unroll
                for (int bj = 0; bj < 2; ++bj)
#pragma unroll
                    for (int n = 0; n < 2; ++n) { const f32x4 b = *(const f32x4*)(base + off + bj * HALF + n * 16); const f32x4 o = b + acc[ai][bj][m][n]; *(f32x4*)(out + off + bj * HALF + n * 16) = o;
                        ss += (o[0] * o[0] + o[1] * o[1]) + (o[2] * o[2] + o[3] * o[3]);
                        ebf16x2 p0, p1; p0[0] = (__bf16)o[0]; p0[1] = (__bf16)o[1]; p1[0] = (__bf16)o[2]; p1[1] = (__bf16)o[3];
                        typedef unsigned eu32x2 __attribute__((ext_vector_type(2))); eu32x2 w; w.x = __builtin_bit_cast(unsigned, p0); w.y = __builtin_bit_cast(unsigned, p1);
                        *(eu32x2*)(xb + off + bj * HALF + n * 16) = w; }
                { auto s1 = __builtin_amdgcn_permlane16_swap(__builtin_bit_cast(unsigned, ss), __builtin_bit_cast(unsigned, ss), false, false); const unsigned a_ = s1[0], b_ = s1[1]; ss = __builtin_bit_cast(float, a_) + __builtin_bit_cast(float, b_); }
                { auto s2 = __builtin_amdgcn_permlane32_swap(__builtin_bit_cast(unsigned, ss), __builtin_bit_cast(unsigned, ss), false, false); const unsigned a_ = s2[0], b_ = s2[1]; ss = __builtin_bit_cast(float, a_) + __builtin_bit_cast(float, b_); }
                if (fq == 0) rs[(size_t)row * 16 + u.pn * 4 + wc] = ss; }
    }
};
struct EpiRowScale {
    static constexpr bool PERM = true, AFTER_DRAIN = false;
    bf16_t* O; int ldc; const float* rs; float inv_n, eps;
    __device__ __forceinline__ void operator()(const f32x4 (&acc)[2][2][4][2], const Unit& u, int wr, int wc, int fr, int fq) const {
        const int row0 = u.pm * BM + wr * 64 + fr; const int col0 = u.pn * BM + wc * 32 + 8 * fq;
#pragma unroll
        for (int ai = 0; ai < 2; ++ai)
#pragma unroll
            for (int m = 0; m < 4; ++m) { const int row = row0 + ai * HALF + m * 16; const f32x4* rp = (const f32x4*)(rs + (size_t)row * 16); const f32x4 t0 = rp[0], t1 = rp[1], t2 = rp[2], t3 = rp[3];
                const float tot = (((t0[0] + t0[1]) + (t0[2] + t0[3])) + ((t1[0] + t1[1]) + (t1[2] + t1[3]))) + (((t2[0] + t2[1]) + (t2[2] + t2[3])) + ((t3[0] + t3[1]) + (t3[2] + t3[3])));
                const float r = 1.0f / __builtin_sqrtf(tot * inv_n + eps);
#pragma unroll
                for (int bj = 0; bj < 2; ++bj) { const f32x4 v0 = acc[ai][bj][m][0] * r, v1 = acc[ai][bj][m][1] * r; u32x4 w;
                    w.x = act_pack2(AK_ID, v0[0], v0[1], 0.f, 0.f); w.y = act_pack2(AK_ID, v0[2], v0[3], 0.f, 0.f); w.z = act_pack2(AK_ID, v1[0], v1[1], 0.f, 0.f); w.w = act_pack2(AK_ID, v1[2], v1[3], 0.f, 0.f);
                    *(u32x4*)(O + (size_t)row * ldc + col0 + bj * HALF) = w; } }
    }
};
template <bool BASE_BF> struct EpiResidBf {
    static constexpr bool PERM = true, AFTER_DRAIN = false;
    const void* base; bf16_t* out; int ldc;
    __device__ __forceinline__ void operator()(const f32x4 (&acc)[2][2][4][2], const Unit& u, int wr, int wc, int fr, int fq) const {
        const int row0 = u.pm * BM + wr * 64 + fr; const int col0 = u.pn * BM + wc * 32 + 8 * fq;
#if EPI_RESID_PRELOAD
        if (BASE_BF) {
            u32x4 wq[2][4][2];
#pragma unroll
            for (int ai = 0; ai < 2; ++ai)
#pragma unroll
                for (int m = 0; m < 4; ++m)
#pragma unroll
                    for (int bj = 0; bj < 2; ++bj) wq[ai][m][bj] = *(const u32x4*)((const bf16_t*)base + (size_t)(row0 + ai * HALF + m * 16) * ldc + col0 + bj * HALF);
            asm volatile("" ::: "memory");
#pragma unroll
            for (int ai = 0; ai < 2; ++ai)
#pragma unroll
                for (int m = 0; m < 4; ++m) { const size_t off = (size_t)(row0 + ai * HALF + m * 16) * ldc + col0;
#pragma unroll
                    for (int bj = 0; bj < 2; ++bj) { const u32x4 w = wq[ai][m][bj]; f32x4 b0, b1;
                        b0[0] = __builtin_bit_cast(float, w.x << 16); b0[1] = __builtin_bit_cast(float, w.x & 0xffff0000u); b0[2] = __builtin_bit_cast(float, w.y << 16); b0[3] = __builtin_bit_cast(float, w.y & 0xffff0000u);
                        b1[0] = __builtin_bit_cast(float, w.z << 16); b1[1] = __builtin_bit_cast(float, w.z & 0xffff0000u); b1[2] = __builtin_bit_cast(float, w.w << 16); b1[3] = __builtin_bit_cast(float, w.w & 0xffff0000u);
                        const f32x4 o0 = b0 + acc[ai][bj][m][0], o1 = b1 + acc[ai][bj][m][1];
                        u32x4 w2; w2.x = act_pack2(AK_ID, o0[0], o0[1], 0.f, 0.f); w2.y = act_pack2(AK_ID, o0[2], o0[3], 0.f, 0.f); w2.z = act_pack2(AK_ID, o1[0], o1[1], 0.f, 0.f); w2.w = act_pack2(AK_ID, o1[2], o1[3], 0.f, 0.f);
                        store16_wt(out + off + bj * HALF, w2); } }
            return;
        }
#endif
#pragma unroll
        for (int ai = 0; ai < 2; ++ai)
#pragma unroll
            for (int m = 0; m < 4; ++m) { const size_t off = (size_t)(row0 + ai * HALF + m * 16) * ldc + col0;
#pragma unroll
                for (int bj = 0; bj < 2; ++bj) { f32x4 b0, b1;
                    if (BASE_BF) { const u32x4 w = *(const u32x4*)((const bf16_t*)base + off + bj * HALF);
                        b0[0] = __builtin_bit_cast(float, w.x << 16); b0[1] = __builtin_bit_cast(float, w.x & 0xffff0000u); b0[2] = __builtin_bit_cast(float, w.y << 16); b0[3] = __builtin_bit_cast(float, w.y & 0xffff0000u);
                        b1[0] = __builtin_bit_cast(float, w.z << 16); b1[1] = __builtin_bit_cast(float, w.z & 0xffff0000u); b1[2] = __builtin_bit_cast(float, w.w << 16); b1[3] = __builtin_bit_cast(float, w.w & 0xffff0000u); }
                    else { const f32x4* bp = (const f32x4*)((const float*)base + off + bj * HALF); b0 = bp[0]; b1 = bp[1]; }
                    const f32x4 o0 = b0 + acc[ai][bj][m][0], o1 = b1 + acc[ai][bj][m][1];
                    u32x4 w2; w2.x = act_pack2(AK_ID, o0[0], o0[1], 0.f, 0.f); w2.y = act_pack2(AK_ID, o0[2], o0[3], 0.f, 0.f); w2.z = act_pack2(AK_ID, o1[0], o1[1], 0.f, 0.f); w2.w = act_pack2(AK_ID, o1[2], o1[3], 0.f, 0.f);
                    store16_wt(out + off + bj * HALF, w2); } }
    }
};
template <class Epi, class Sched, bool ALIGN_EPI = false, bool SP2 = false>
__device__ __forceinline__ void gemm_phase(PG8_LAS unsigned char* lds, const Gemm g, const Sched& S, const Epi& E) {
    int tid_o_ = threadIdx.x; asm volatile("" : "+v"(tid_o_));
    const int tid = tid_o_, wid = __builtin_amdgcn_readfirstlane(tid >> 6), lane = tid & 63, wr = wid >> 2, wc = wid & 3, fr = lane & 15, fq = lane >> 4;
    const int K = g.K, nt = K / BK;
    unsigned voffA[2], voffB[2];
#pragma unroll
    for (int i = 0; i < 2; ++i) { int R, C; stage_rc(tid * 16 + i * 8192, R, C); const int Rb = Epi::PERM ? ((R & ~31) + perm32(R & 31)) : R;
        voffA[i] = (unsigned)(R * K + C) * 2u; voffB[i] = (unsigned)(Rb * K + C) * 2u; }
    const size_t kstep = (size_t)(BK * 2);
    const size_t hstep = (size_t)HALF * K * 2;
    const size_t tstep = 2 * hstep;
    const unsigned ldsw = (unsigned)wid * 1024u;
    const int aoff = lds_byte(wr * 64 + fr, fq * 8), boff = lds_byte(wc * 32 + fr, fq * 8);
#define PG8_SA(b, h) (((b) * 2 + (h)) * HTB)
#define PG8_SB(b, h) ((4 + (b) * 2 + (h)) * HTB)
#define PG8_STAGE(bufoff, gbase, voff) do { _Pragma("unroll") for (int _i = 0; _i < 2; ++_i) \
        __builtin_amdgcn_global_load_lds((const unsigned*)((const char*)(gbase) + (voff)[_i]), (PG8_LAS unsigned*)(lds + (bufoff) + ldsw + _i * 8192), 16, 0, 0); } while (0)
#define PG8_LDA(dst, b, h) do { _Pragma("unroll") for (int m = 0; m < 4; ++m) _Pragma("unroll") for (int k = 0; k < 2; ++k) dst[m][k] = *(const PG8_LAS bf16x8*)(lds + PG8_SA(b, h) + aoff + m * 2048 + k * 1024); } while (0)
#define PG8_LDB(dst, b, h) do { _Pragma("unroll") for (int n = 0; n < 2; ++n) _Pragma("unroll") for (int k = 0; k < 2; ++k) dst[n][k] = *(const PG8_LAS bf16x8*)(lds + PG8_SB(b, h) + boff + n * 2048 + k * 1024); } while (0)
#define PG8_MMA(ai, bj, At, Bt) do { __builtin_amdgcn_s_setprio(1); _Pragma("unroll") for (int m = 0; m < 4; ++m) _Pragma("unroll") for (int n = 0; n < 2; ++n) _Pragma("unroll") for (int k = 0; k < 2; ++k) \
        acc[ai][bj][m][n] = __builtin_amdgcn_mfma_f32_16x16x32_bf16(Bt[n][k], At[m][k], acc[ai][bj][m][n], 0, 0, 0); __builtin_amdgcn_s_setprio(0); } while (0)
#define PG8_WAIT_V(n) asm volatile("s_waitcnt vmcnt(" #n ")" ::: "memory")
#define PG8_WAIT_L(n) asm volatile("s_waitcnt lgkmcnt(" #n ")" ::: "memory")
#define PG8_BAR __builtin_amdgcn_s_barrier()
#define PG8_SCHED __builtin_amdgcn_sched_barrier(0)
    Unit cur, nxt; int ui = 0;
    if (!S.next(0, cur)) return;
    f32x4 acc[2][2][4][2];
#pragma unroll
    for (int a = 0; a < 2; ++a)
#pragma unroll
        for (int b = 0; b < 2; ++b)
#pragma unroll
            for (int m = 0; m < 4; ++m)
#pragma unroll
                for (int n = 0; n < 2; ++n) acc[a][b][m][n] = (f32x4){0.f, 0.f, 0.f, 0.f};
    bf16x8 At[4][2], B0[2][2], B1[2][2];
    const char* cA = (const char*)g.A + (size_t)cur.pm * tstep; const char* cB = (const char*)g.Bt + (size_t)cur.pn * tstep;
    S.a_ready(cur);
    if constexpr (SP2) {
        PG8_STAGE(PG8_SB(0, 0), cB, voffB); PG8_STAGE(PG8_SB(0, 1), cB + hstep, voffB); PG8_STAGE(PG8_SA(0, 0), cA, voffA); PG8_STAGE(PG8_SA(0, 1), cA + hstep, voffA);
        if (wr == 1) PG8_BAR;
        PG8_WAIT_V(2); PG8_BAR;
        PG8_STAGE(PG8_SB(1, 0), cB + kstep, voffB); PG8_STAGE(PG8_SA(1, 0), cA + kstep, voffA); PG8_STAGE(PG8_SB(1, 1), cB + hstep + kstep, voffB);
        PG8_WAIT_V(6); PG8_BAR;
    } else {
        PG8_STAGE(PG8_SB(0, 0), cB, voffB); PG8_STAGE(PG8_SA(0, 0), cA, voffA); PG8_STAGE(PG8_SB(0, 1), cB + hstep, voffB); PG8_STAGE(PG8_SA(0, 1), cA + hstep, voffA);
        if (wr == 1) PG8_BAR;
        PG8_WAIT_V(4); PG8_BAR;
        PG8_STAGE(PG8_SB(1, 0), cB + kstep, voffB); PG8_STAGE(PG8_SA(1, 0), cA + kstep, voffA); PG8_STAGE(PG8_SB(1, 1), cB + hstep + kstep, voffB);
        PG8_WAIT_V(6); PG8_BAR;
    }
    for (;;) {
        const bool has_next = S.next(ui + 1, nxt);
        const char* nA = has_next ? (const char*)g.A + (size_t)nxt.pm * tstep : cA; const char* nB = has_next ? (const char*)g.Bt + (size_t)nxt.pn * tstep : cB;
        for (int t = 0; t < nt; t += 2) {
            const bool last = (t == nt - 2);
            const char* a1 = cA + (size_t)(t + 1) * kstep;
            const char* a2 = last ? nA : cA + (size_t)(t + 2) * kstep; const char* b2 = last ? nB : cB + (size_t)(t + 2) * kstep;
            const char* a3 = a2 + kstep; const char* b3 = b2 + kstep;
            if (last && has_next) S.a_ready(nxt);
            if constexpr (SP2) {
            PG8_LDB(B0, 0, 0); PG8_LDB(B1, 0, 1); PG8_SCHED; PG8_LDA(At, 0, 0); PG8_STAGE(PG8_SA(1, 1), a1 + hstep, voffA);
            PG8_WAIT_V(8); PG8_WAIT_L(0); PG8_BAR; PG8_MMA(0, 0, At, B0); PG8_MMA(0, 1, At, B1); PG8_BAR; PG8_SCHED;
            PG8_LDA(At, 0, 1); PG8_STAGE(PG8_SB(0, 0), b2, voffB); PG8_STAGE(PG8_SB(0, 1), b2 + hstep, voffB); PG8_STAGE(PG8_SA(0, 0), a2, voffA);
            PG8_WAIT_V(8); PG8_WAIT_L(0); PG8_BAR; PG8_MMA(1, 0, At, B0); PG8_MMA(1, 1, At, B1); PG8_BAR; PG8_SCHED;
            PG8_LDB(B0, 1, 0); PG8_LDB(B1, 1, 1); PG8_SCHED; PG8_LDA(At, 1, 0); PG8_STAGE(PG8_SA(0, 1), a2 + hstep, voffA);
            PG8_WAIT_V(8); PG8_WAIT_L(0); PG8_BAR; PG8_MMA(0, 0, At, B0); PG8_MMA(0, 1, At, B1); PG8_BAR; PG8_SCHED;
            PG8_LDA(At, 1, 1); PG8_STAGE(PG8_SB(1, 0), b3, voffB); PG8_STAGE(PG8_SB(1, 1), b3 + hstep, voffB); PG8_STAGE(PG8_SA(1, 0), a3, voffA);
            PG8_WAIT_V(8); PG8_WAIT_L(0); PG8_BAR; PG8_MMA(1, 0, At, B0); PG8_MMA(1, 1, At, B1); PG8_BAR; PG8_SCHED;
            } else {
            PG8_LDB(B0, 0, 0); PG8_SCHED; PG8_LDA(At, 0, 0); PG8_STAGE(PG8_SA(1, 1), a1 + hstep, voffA);
            PG8_WAIT_L(8); PG8_BAR; PG8_WAIT_L(0); PG8_MMA(0, 0, At, B0); PG8_BAR; PG8_SCHED;
            PG8_LDB(B1, 0, 1); PG8_STAGE(PG8_SB(0, 0), b2, voffB);
            PG8_BAR; PG8_WAIT_L(0); PG8_MMA(0, 1, At, B1); PG8_BAR;
            PG8_LDA(At, 0, 1); PG8_STAGE(PG8_SA(0, 0), a2, voffA);
            PG8_BAR; PG8_WAIT_L(0); PG8_MMA(1, 0, At, B0); PG8_BAR; PG8_SCHED;
            PG8_STAGE(PG8_SB(0, 1), b2 + hstep, voffB);
            PG8_WAIT_V(6); PG8_BAR; PG8_MMA(1, 1, At, B1); PG8_BAR;
            PG8_LDB(B0, 1, 0); PG8_SCHED; PG8_LDA(At, 1, 0); PG8_STAGE(PG8_SA(0, 1), a2 + hstep, voffA);
            PG8_WAIT_L(8); PG8_BAR; PG8_WAIT_L(0); PG8_MMA(0, 0, At, B0); PG8_BAR; PG8_SCHED;
            PG8_LDB(B1, 1, 1); PG8_STAGE(PG8_SB(1, 0), b3, voffB);
            PG8_BAR; PG8_WAIT_L(0); PG8_MMA(0, 1, At, B1); PG8_BAR;
            PG8_LDA(At, 1, 1); PG8_STAGE(PG8_SA(1, 0), a3, voffA);
            PG8_BAR; PG8_WAIT_L(0); PG8_MMA(1, 0, At, B0); PG8_BAR; PG8_SCHED;
            PG8_STAGE(PG8_SB(1, 1), b3 + hstep, voffB);
            PG8_WAIT_V(6); PG8_BAR; PG8_MMA(1, 1, At, B1); PG8_BAR;
            }
        }
        if constexpr (ALIGN_EPI) { if (wr == 0) PG8_BAR; }
        if constexpr (!Epi::AFTER_DRAIN) { E(acc, cur, wr, wc, fr, fq); S.done(cur); }
        if (!has_next) break;
#pragma unroll
        for (int a = 0; a < 2; ++a)
#pragma unroll
            for (int b = 0; b < 2; ++b)
#pragma unroll
                for (int m = 0; m < 4; ++m)
#pragma unroll
                    for (int n = 0; n < 2; ++n) acc[a][b][m][n] = (f32x4){0.f, 0.f, 0.f, 0.f};
        cur = nxt; cA = nA; cB = nB; ++ui;
        if constexpr (ALIGN_EPI) { if (wr == 1) PG8_BAR; }
    }
    PG8_WAIT_V(0);
    if constexpr (!ALIGN_EPI) { if (wr == 0) PG8_BAR; }
    PG8_BAR;
    if constexpr (Epi::AFTER_DRAIN) { E.fused(acc, cur, wr, wc, fr, fq, lds, wid, lane); S.done(cur); }
#undef PG8_SA
#undef PG8_SB
#undef PG8_STAGE
#undef PG8_LDA
#undef PG8_LDB
#undef PG8_MMA
#undef PG8_WAIT_V
#undef PG8_WAIT_L
#undef PG8_BAR
#undef PG8_SCHED
}
}
constexpr int NWAVES = 8, NTHR = 512;
constexpr int BATCH = 4, SEQ = 8192, DM = 1024, MTOK = BATCH * SEQ;
constexpr int NP0 = 2560, NP0_REAL = 2328, NP1 = 4096, NQP = 2048;
constexpr int C_U = 0, C_V = 512, C_Q = 1024, C_KC = 1536, C_VC = 1664, C_KS = 1792, C_VS = 1920, C_KW = 2048, C_VW = 2176, C_GT = 2304;
constexpr int NCMP = 511, NCMP_PAD = 512;
constexpr int NEXP = 16384;
constexpr float EPS = 1e-6f;
#ifndef MK_N_LAUNCHES
#define MK_N_LAUNCHES 1
#endif
#ifndef FAST_GEMM
#define FAST_GEMM 1
#endif
#ifndef FAST_PEVAL
#define FAST_PEVAL 1
#endif
#ifndef PEER_SORT
#define PEER_SORT 1
#endif
#ifndef NSA_FENCES
#define NSA_FENCES 1
#endif
#ifndef NSA_DEFER
#define NSA_DEFER 1
#endif
#ifndef PEER_XPF
#define PEER_XPF 1
#endif
#ifndef HGRN_GATEPF
#define HGRN_GATEPF 1
#endif
#ifndef HGRN_BATCH
#define HGRN_BATCH 1
#endif
#ifndef NSA_QUEUE
#define NSA_QUEUE 0
#endif
#ifndef FUSE_QSEL
#define FUSE_QSEL 0
#endif
#ifndef HGRN_SSPF
#define HGRN_SSPF 1
#endif
#ifndef NSA_TOPK_BALLOT
#define NSA_TOPK_BALLOT 1
#endif
#ifndef NSA_CMPBIAS
#define NSA_CMPBIAS 1
#endif
#ifndef NSA_VTR
#define NSA_VTR 0
#endif
#ifndef FUSE_NORM0
#define FUSE_NORM0 1
#endif
#ifndef GEMM3_STAGGER
#define GEMM3_STAGGER 0
#endif
#ifndef PEER_ALIGN_XCD
#define PEER_ALIGN_XCD 0
#endif
#ifndef PEER_ALIGN_XIN
#define PEER_ALIGN_XIN 0
#endif
#ifndef PEER_ALIGN_IN
#define PEER_ALIGN_IN 4
#endif
#ifndef PEER_ALIGN
#define PEER_ALIGN 1
#endif
#ifndef PEER_RING4
#define PEER_RING4 0
#endif
#ifndef PEER_I8
#define PEER_I8 1
#endif
#ifndef PEER_PKFMA
#define PEER_PKFMA 1
#endif
#ifndef NSA_DMA
#define NSA_DMA 0
#endif
#ifndef NSA_DMA_WIN
#define NSA_DMA_WIN 1
#endif
#ifndef NSA_DMA_SLC
#define NSA_DMA_SLC 0
#endif
#ifndef NSA_PIPE_SLC
#define NSA_PIPE_SLC 1
#endif
#ifndef NSA_PIPE_WIN
#define NSA_PIPE_WIN 1
#endif
#ifndef NSA_PIPE
#define NSA_PIPE 1
#endif
#ifndef P2_C32
#define P2_C32 1
#endif
#ifndef P2_PIPE
#define P2_PIPE 1
#endif
#ifndef P2_NC
#define P2_NC 2
#endif
#ifndef TAB1_IN_P7
#define TAB1_IN_P7 0
#endif
#ifndef GEMM_ALIGN_RES
#define GEMM_ALIGN_RES true
#endif
#ifndef GEMM_ALIGN_ACT
#define GEMM_ALIGN_ACT true
#endif
#ifndef PEER_CHUNK
#define PEER_CHUNK 0
#endif
#ifndef PEER_EVAL4
#define PEER_EVAL4 1
#endif
#ifndef FAST_PSEL
#define FAST_PSEL 1
#endif
#ifndef FAST_P2
#define FAST_P2 1
#endif
#ifndef FAST_NSA
#define FAST_NSA 1
#endif
#ifndef FAST_HGRN
#define FAST_HGRN 1
#endif
constexpr int N_PHASES = 18;
#ifndef RESID_BF16
#define RESID_BF16 1
#endif
#ifndef FUSE_NORM
#define FUSE_NORM 0
#endif
constexpr size_t MiB = 1u << 20;
constexpr size_t WS_CTL = 0, CTL_ZERO_BYTES = 64 * 1024;
constexpr size_t WS_WIN0 = 1 * MiB, WS_WOUT0 = 6 * MiB, WS_WIN1 = 8 * MiB, WS_WOUT1 = 16 * MiB, WS_WQ = 18 * MiB  , WS_KEYS = 26 * MiB  ;
constexpr size_t WS_CW1 = 27 * MiB  ;
constexpr size_t WS_CW2 = 28 * MiB  , WS_WSTRIL = 28 * MiB + 64 * 1024  ;
constexpr size_t WS_BIAS1 = 28 * MiB + 256 * 1024  , WS_LB = 28 * MiB + 260 * 1024  ;
constexpr size_t WS_KCMP = 29 * MiB, WS_VCMP = 29 * MiB + 512 * 1024;
constexpr size_t WS_XN = 32 * MiB;
constexpr size_t WS_MIX = 96 * MiB;
constexpr size_t WS_TAB8 = 160 * MiB;
constexpr size_t WS_RS = 30 * MiB + 512 * 1024;
constexpr size_t WS_SCL = 30 * MiB;
constexpr size_t WS_EXP = 224 * MiB, WS_GATE = 240 * MiB;
constexpr size_t WS_P = 256 * MiB;
constexpr size_t WS_END = 512 * MiB;
constexpr int CW_BAR = 1024;
constexpr int RING_OFF = 0, RING_BYTES = 131072;
constexpr int LDSCTL_OFF = 143360, MISC_OFF = LDSCTL_OFF + 320;
constexpr int LDS_BYTES = 147456;
#define GAS __attribute__((address_space(1)))
#define LAS __attribute__((address_space(3)))
typedef unsigned short bf16;
typedef unsigned v4u __attribute__((ext_vector_type(4)));
typedef float f32x4 __attribute__((ext_vector_type(4)));
typedef short bf16x8 __attribute__((ext_vector_type(8)));
typedef GAS unsigned gu32;
typedef GAS unsigned long long gu64;
#define RLX_AGENT __ATOMIC_RELAXED, __HIP_MEMORY_SCOPE_AGENT
#define LDS_WAIT() asm volatile("s_waitcnt lgkmcnt(0)" ::: "memory")
#define VM_WAIT() asm volatile("s_waitcnt vmcnt(0)" ::: "memory")
__device__ __forceinline__ unsigned long long rt() { return __builtin_amdgcn_s_memrealtime(); }
__device__ __forceinline__ unsigned f2bf(float f) { unsigned u = __builtin_bit_cast(unsigned, f); return (u + 0x7fffu + ((u >> 16) & 1u)) >> 16; }
__device__ __forceinline__ unsigned pk2(float lo, float hi) { return f2bf(lo) | (f2bf(hi) << 16); }
#define XB_TMO      128
#define XB_XCNT(j)  (256  + 64 * (j))
#define XB_XSUB(j)  (1280 + 64 * (j))
#define XB_XGEN(j)  (2304 + 64 * (j))
#define XB_TOP      3328
#define XB_TOPGEN   3392
#define XCD_BAR_WORDS 3456
#define XB_SPIN_CAP (1u << 22)

__device__ __forceinline__ unsigned xb_ld(unsigned* p)              { return __hip_atomic_load(p, __ATOMIC_RELAXED, __HIP_MEMORY_SCOPE_AGENT); }
__device__ __forceinline__ unsigned xb_add(unsigned* p, unsigned v) { return __hip_atomic_fetch_add(p, v, __ATOMIC_RELAXED, __HIP_MEMORY_SCOPE_AGENT); }
__device__ __forceinline__ unsigned xb_xcc_id() { return (unsigned)__builtin_amdgcn_s_getreg((3 << 11) | 20) & 0xFu; }
#define XB_SPIN(cond, bar) do { unsigned _sp = 0; while (cond) { __builtin_amdgcn_s_sleep(1); \
    if ((++_sp & 255u) == 0u) { if (xb_ld(&(bar)[XB_TMO])) break; if (_sp > XB_SPIN_CAP) { atomicAdd(&(bar)[XB_TMO], 1u); break; } } } } while (0)

struct XcdBarrier {
    unsigned* bar; unsigned x;
    volatile LAS unsigned* st;
};

__device__ __forceinline__ XcdBarrier xcd_barrier_post(unsigned* bar, volatile LAS unsigned* st) {
    XcdBarrier b; b.bar = bar; b.x = xb_xcc_id(); b.st = st;
    if (threadIdx.x == 0) (void)xb_add(&bar[XB_XCNT(b.x)], 1u);
    return b;
}
__device__ __forceinline__ void xcd_barrier_complete(unsigned* bar, unsigned x, unsigned& nloc, unsigned& nx) {
    const unsigned G = gridDim.x * gridDim.y * gridDim.z;
    unsigned sum, cnt, mine, sp = 0u;
    for (;;) {
        sum = 0u; cnt = 0u; mine = 0u;
#pragma unroll
        for (unsigned j = 0; j < 16; ++j) { const unsigned c = xb_ld(&bar[XB_XCNT(j)]); sum += c; cnt += (c > 0u) ? 1u : 0u; mine = (j == x) ? c : mine; }
        if (sum == G) break;
        __builtin_amdgcn_s_sleep(1);
        if ((++sp & 255u) == 0u) { if (xb_ld(&bar[XB_TMO])) break; if (sp > XB_SPIN_CAP) { atomicAdd(&bar[XB_TMO], 1u); break; } }
    }
    nloc = mine > 0u ? mine : 1u; nx = cnt > 0u ? cnt : 1u;
}

__device__ __forceinline__ void xcd_barrier(const XcdBarrier& b) {
    asm volatile("s_waitcnt vmcnt(0)" ::: "memory");
    __syncthreads();
    if (threadIdx.x == 0) {
        unsigned* bar = b.bar;
        __builtin_amdgcn_s_waitcnt(0);
        unsigned nloc = b.st[0], nx = b.st[1];
        if (nloc == 0u) { xcd_barrier_complete(bar, b.x, nloc, nx); b.st[0] = nloc; b.st[1] = nx; }
        const unsigned old = xb_add(&bar[XB_XSUB(b.x)], 1u);
        const unsigned gen = old / nloc;
        if (old + 1u == (gen + 1u) * nloc) {
            __builtin_amdgcn_fence(__ATOMIC_RELEASE, "agent");
            asm volatile("s_waitcnt vmcnt(0)" ::: "memory");
            const unsigned og = xb_add(&bar[XB_TOP], 1u);
            const unsigned tg = og / nx;
            if (og + 1u == (tg + 1u) * nx) xb_add(&bar[XB_TOPGEN], 1u);
            else XB_SPIN(xb_ld(&bar[XB_TOPGEN]) == tg, bar);
            __builtin_amdgcn_fence(__ATOMIC_ACQUIRE, "agent");
            xb_add(&bar[XB_XGEN(b.x)], 1u);
            asm volatile("s_waitcnt vmcnt(0)" ::: "memory");
        } else {
            XB_SPIN(xb_ld(&bar[XB_XGEN(b.x)]) == gen, bar);
            __builtin_amdgcn_fence(__ATOMIC_ACQUIRE, "agent");
            asm volatile("s_waitcnt vmcnt(0)" ::: "memory");
        }
    }
    __syncthreads();
}

#define XB_ALN_CNT(j) (3520 + 64 * (j))
#define XB_ALN_GEN(j) (4544 + 64 * (j))
__device__ __forceinline__ void xcd_align(const XcdBarrier& b) {
    __syncthreads();
    if (threadIdx.x == 0 && b.st) {
        const unsigned nloc = b.st[0], agen = b.st[2];
        if (nloc > 1u) {
            const unsigned old = xb_add(&b.bar[XB_ALN_CNT(b.x)], 1u);
            if (old + 1u == (agen + 1u) * nloc) xb_add(&b.bar[XB_ALN_GEN(b.x)], 1u);
            else XB_SPIN(xb_ld(&b.bar[XB_ALN_GEN(b.x)]) == agen, b.bar);
        }
        b.st[2] = agen + 1u;
    }
    __syncthreads();
}
typedef __bf16 bf16x2_t __attribute__((ext_vector_type(2)));
typedef float f32x2 __attribute__((ext_vector_type(2)));
typedef float f32x16 __attribute__((ext_vector_type(16)));
#define MFMA32(a, b, c) __builtin_amdgcn_mfma_f32_32x32x16_bf16((a), (b), (c), 0, 0, 0)
__device__ __forceinline__ float bf2f(bf16 v) { return __builtin_bit_cast(float, (unsigned)v << 16); }
__device__ __forceinline__ float bflo(unsigned w) { return __builtin_bit_cast(float, w << 16); }
__device__ __forceinline__ float bfhi(unsigned w) { return __builtin_bit_cast(float, w & 0xffff0000u); }
__device__ __forceinline__ float dot2bf(unsigned a, unsigned b, float acc) { return __builtin_amdgcn_fdot2_f32_bf16(__builtin_bit_cast(bf16x2_t, a), __builtin_bit_cast(bf16x2_t, b), acc, false); }
__device__ __forceinline__ unsigned ord_key(float s) { const int u = __builtin_bit_cast(int, s); return (unsigned)(u ^ ((u >> 31) | (int)0x80000000)); }
__device__ __forceinline__ float ord_dec(unsigned k) { const unsigned u = (k & 0x80000000u) ? (k & 0x7fffffffu) : ~k; return __builtin_bit_cast(float, u); }
__device__ __forceinline__ float wave_sum(float v) {
#pragma unroll
    for (int o = 1; o < 64; o <<= 1) v += __shfl_xor(v, o);
    return v;
}
__device__ __forceinline__ float wave_max(float v) {
#pragma unroll
    for (int o = 1; o < 64; o <<= 1) v = fmaxf(v, __shfl_xor(v, o));
    return v;
}
using pg8::gelu_tanh; using pg8::sigmoidf_; using pg8::siluf_; using pg8::act_store; using pg8::kind_p0; using pg8::kind_p1; using pg8::h2f_bits;

__device__ __forceinline__ void rms_rows(const float* src, const float* w, bf16* dst_bf, float* dst_f, int gw, int NGW, int lane) {
    f32x4 nv[4] = {};
    if (gw < MTOK) { const f32x4* xr = (const f32x4*)(src + (size_t)gw * DM) + lane;
#pragma unroll
        for (int j = 0; j < 4; ++j) nv[j] = xr[64 * j]; }
    for (int m = gw; m < MTOK; m += NGW) {
        f32x4 v[4]; float s = 0.f;
#pragma unroll
        for (int j = 0; j < 4; ++j) v[j] = nv[j];
        if (m + NGW < MTOK) { const f32x4* xr = (const f32x4*)(src + (size_t)(m + NGW) * DM) + lane;
#pragma unroll
            for (int j = 0; j < 4; ++j) nv[j] = xr[64 * j]; }
#pragma unroll
        for (int j = 0; j < 4; ++j) s += (v[j].x * v[j].x + v[j].y * v[j].y) + (v[j].z * v[j].z + v[j].w * v[j].w);
        const float r = 1.0f / sqrtf(wave_sum(s) * (1.0f / DM) + EPS);
#pragma unroll
        for (int j = 0; j < 4; ++j) {
            const f32x4 wv = *((const f32x4*)w + lane + 64 * j);
            const f32x4 y = v[j] * r * wv;
            if (dst_bf) { unsigned long long o = (unsigned long long)pk2(y.x, y.y) | ((unsigned long long)pk2(y.z, y.w) << 32); *((unsigned long long*)(dst_bf + (size_t)m * DM) + lane + 64 * j) = o; }
            if (dst_f) *((f32x4*)(dst_f + (size_t)m * DM) + lane + 64 * j) = y;
        }
    }
}

__device__ __forceinline__ void cvt_rows_rstd(const float* src, bf16* dst_bf, float* rstd, int gw, int NGW, int lane) {
    f32x4 nv[4] = {};
    if (gw < MTOK) { const f32x4* xr = (const f32x4*)(src + (size_t)gw * DM) + lane;
#pragma unroll
        for (int j = 0; j < 4; ++j) nv[j] = xr[64 * j]; }
    for (int m = gw; m < MTOK; m += NGW) {
        f32x4 v[4]; float s = 0.f;
#pragma unroll
        for (int j = 0; j < 4; ++j) v[j] = nv[j];
        if (m + NGW < MTOK) { const f32x4* xr = (const f32x4*)(src + (size_t)(m + NGW) * DM) + lane;
#pragma unroll
            for (int j = 0; j < 4; ++j) nv[j] = xr[64 * j]; }
#pragma unroll
        for (int j = 0; j < 4; ++j) { s += (v[j].x * v[j].x + v[j].y * v[j].y) + (v[j].z * v[j].z + v[j].w * v[j].w);
            unsigned long long o = (unsigned long long)pk2(v[j].x, v[j].y) | ((unsigned long long)pk2(v[j].z, v[j].w) << 32); *((unsigned long long*)(dst_bf + (size_t)m * DM) + lane + 64 * j) = o; }
        const float r = 1.0f / sqrtf(wave_sum(s) * (1.0f / DM) + EPS);
        if (lane == 0) rstd[m] = r;
    }
}
__device__ __forceinline__ void rms_rows_bf(const bf16* src, const float* w, bf16* dst_bf, int gw, int NGW, int lane) {
    for (int m = gw; m < MTOK; m += NGW) {
        const v4u* xb = (const v4u*)(src + (size_t)m * DM + 16 * lane); const v4u b0 = xb[0], b1 = xb[1];
        float v[16] = {bflo(b0.x), bfhi(b0.x), bflo(b0.y), bfhi(b0.y), bflo(b0.z), bfhi(b0.z), bflo(b0.w), bfhi(b0.w), bflo(b1.x), bfhi(b1.x), bflo(b1.y), bfhi(b1.y), bflo(b1.z), bfhi(b1.z), bflo(b1.w), bfhi(b1.w)};
        float s = 0.f;
#pragma unroll
        for (int i = 0; i < 16; ++i) s += v[i] * v[i];
        const float rr = 1.0f / sqrtf(wave_sum(s) * (1.0f / DM) + EPS);
        unsigned o[8];
#pragma unroll
        for (int c = 0; c < 4; ++c) { const f32x4 wv = *(const f32x4*)(w + 16 * lane + 4 * c);
            o[2 * c] = pk2(v[4 * c] * rr * wv.x, v[4 * c + 1] * rr * wv.y); o[2 * c + 1] = pk2(v[4 * c + 2] * rr * wv.z, v[4 * c + 3] * rr * wv.w); }
        v4u* d = (v4u*)(dst_bf + (size_t)m * DM + 16 * lane); d[0] = (v4u){o[0], o[1], o[2], o[3]}; d[1] = (v4u){o[4], o[5], o[6], o[7]};
    }
}
__device__ __forceinline__ void tr_item(const float* W, int K, int N, bf16* WT, LAS float* scr, int item, int nblk, int lane, const float* kscale = nullptr) {
    const int kb = item / nblk, nb = item % nblk, k0 = 64 * kb, n0 = 32 * nb;
    const int nn = n0 + (lane & 31);
#pragma unroll 8
    for (int i = 0; i < 32; ++i) { const int kk = 2 * i + (lane >> 5); scr[kk * 33 + (lane & 31)] = (nn < N) ? W[(size_t)(k0 + kk) * N + nn] * (kscale ? kscale[k0 + kk] : 1.0f) : 0.f; }
    LDS_WAIT(); asm volatile("" ::: "memory");
    const int c = lane & 7;
#pragma unroll
    for (int j = 0; j < 4; ++j) { const int n = (lane >> 3) + 8 * j; const LAS float* s = scr + (8 * c) * 33 + n;
        v4u o; o.x = pk2(s[0 * 33], s[1 * 33]); o.y = pk2(s[2 * 33], s[3 * 33]); o.z = pk2(s[4 * 33], s[5 * 33]); o.w = pk2(s[6 * 33], s[7 * 33]);
        *(v4u*)(WT + (size_t)(n0 + n) * K + k0 + 8 * c) = o; }
    LDS_WAIT(); asm volatile("" ::: "memory");
}
__device__ __forceinline__ void cvt_items(const float* src, bf16* dst, size_t n, int gw, int NGW, int lane) {
    const size_t nit = n / 512;
    for (size_t it = gw; it < nit; it += NGW) {
        const f32x4* s = (const f32x4*)(src + it * 512) + 2 * lane; const f32x4 a = s[0], b = s[1];
        v4u o; o.x = pk2(a.x, a.y); o.y = pk2(a.z, a.w); o.z = pk2(b.x, b.y); o.w = pk2(b.z, b.w);
        *((v4u*)(dst + it * 512) + lane) = o;
    }
}
template <class Epi>
__device__ __forceinline__ void naive_gemm(const bf16* A, const bf16* Wt, int M, int N, int K, const Epi& epi, int gtid, int gthreads) {
    const long total = (long)M * N;
    for (long idx = gtid; idx < total; idx += gthreads) {
        const int m = (int)(idx / N), n = (int)(idx % N);
        const v4u* a = (const v4u*)(A + (size_t)m * K); const v4u* w = (const v4u*)(Wt + (size_t)n * K);
        float a0 = 0.f, a1 = 0.f, a2 = 0.f, a3 = 0.f;
        for (int k = 0; k < K / 8; ++k) { const v4u av = a[k], wv = w[k]; a0 = dot2bf(av.x, wv.x, a0); a1 = dot2bf(av.y, wv.y, a1); a2 = dot2bf(av.z, wv.z, a2); a3 = dot2bf(av.w, wv.w, a3); }
        epi(m, n, (a0 + a1) + (a2 + a3));
    }
}
struct NEpiAct { bf16* O; int ldc; int which; const float* lb;
    __device__ __forceinline__ void operator()(int m, int n, float v) const {
        const int kind = which == 0 ? kind_p0(n) : which == 1 ? kind_p1(n) : pg8::AK_ID;
        const float lbv = (which == 1 && kind == pg8::AK_KK) ? lb[n - 1024] : 0.f;
        O[(size_t)m * ldc + n] = act_store(kind, v, lbv); } };
struct NEpiResid { const float* base; float* out; int ldc;
    __device__ __forceinline__ void operator()(int m, int n, float v) const { out[(size_t)m * ldc + n] = base[(size_t)m * ldc + n] + v; } };

__device__ __forceinline__ void naive_gmlp_unit(int u, const bf16* P0, const float* lnw, const float* Ws, const float* bs, bf16* MIX, LAS unsigned char* lds, int tid) {
    LAS float* Vn = (LAS float*)lds;
    const int g = u & 3, row0 = (u >> 2) * 128;
    {   const int r = tid >> 2, q = tid & 3;
        const bf16* src = P0 + (size_t)(row0 + r) * NP0 + C_V + g * 128 + q * 32;
        float v[32]; float s = 0.f;
#pragma unroll
        for (int i = 0; i < 32; ++i) { v[i] = bf2f(src[i]); s += v[i]; }
        s += __shfl_xor(s, 1); s += __shfl_xor(s, 2);
        const float mean = s * (1.0f / 128.0f); float q2 = 0.f;
#pragma unroll
        for (int i = 0; i < 32; ++i) { const float d = v[i] - mean; q2 += d * d; }
        q2 += __shfl_xor(q2, 1); q2 += __shfl_xor(q2, 2);
        const float rstd = 1.0f / sqrtf(q2 * (1.0f / 128.0f) + EPS);
#pragma unroll
        for (int i = 0; i < 32; ++i) Vn[r * 128 + q * 32 + i] = (v[i] - mean) * rstd * lnw[g * 128 + q * 32 + i];
    }
    __syncthreads();
    {   const int d = tid & 127, tq = tid >> 7;
        for (int t = tq * 32; t < tq * 32 + 32; ++t) {
            const float* wrow = Ws + ((size_t)g * 128 + t) * 128; float acc = 0.f;
            for (int s = 0; s <= t; ++s) acc += wrow[s] * Vn[s * 128 + d];
            const float mixed = acc + bs[g * 128 + t];
            const float uu = bf2f(P0[(size_t)(row0 + t) * NP0 + C_U + g * 128 + d]);
            MIX[(size_t)(row0 + t) * DM + g * 128 + d] = f2bf(uu * mixed);
        }
    }
    __syncthreads();
}
__device__ __forceinline__ void naive_compress_unit(int cu, const bf16* P0, const float* pos, const float* w1k, const float* w2k, const float* w1v, const float* w2v, bf16* KC, bf16* VC, LAS unsigned char* lds, int tid) {
    LAS float* blk = (LAS float*)lds; LAS float* h1p = blk + 2048; LAS float* h1 = h1p + 512;
    const int which = cu & 1, rest = cu >> 1, n = rest % NCMP, bg = rest / NCMP, g = bg & 1, b = bg >> 1;
    const float* w1 = which ? w1v : w1k; const float* w2 = which ? w2v : w2k; bf16* O = which ? VC : KC;
    const int col = (which ? C_VC : C_KC) + g * 64;
    for (int j = tid; j < 2048; j += NTHR) { const int l = j >> 6, d = j & 63; blk[j] = bf2f(P0[(size_t)(b * SEQ + 16 * n + l) * NP0 + col + d]) + pos[l * 64 + d]; }
    __syncthreads();
    {   const int hid = tid & 127, part = tid >> 7; float acc = 0.f;
        for (int j = part * 512; j < part * 512 + 512; ++j) acc += blk[j] * w1[(size_t)j * 128 + hid];
        h1p[part * 128 + hid] = acc; }
    __syncthreads();
    if (tid < 128) h1[tid] = gelu_tanh((h1p[tid] + h1p[128 + tid]) + (h1p[256 + tid] + h1p[384 + tid]));
    __syncthreads();
    if (tid < 64) { float acc = 0.f; for (int hh = 0; hh < 128; ++hh) acc += h1[hh] * w2[hh * 64 + tid]; O[((size_t)(b * 2 + g) * NCMP_PAD + n) * 64 + tid] = f2bf(acc); }
    __syncthreads();
}

constexpr int NSA_WAVE_LDS = 16384 + 1024 + 64;
__device__ __forceinline__ void nsa_dot4(const bf16* krow, const LAS float* Q, float (&s)[4]) {
    s[0] = s[1] = s[2] = s[3] = 0.f;
#pragma unroll 1
    for (int c = 0; c < 8; ++c) {
        const v4u kv = *((const v4u*)krow + c);
        const float k0 = bflo(kv.x), k1 = bfhi(kv.x), k2 = bflo(kv.y), k3 = bfhi(kv.y), k4 = bflo(kv.z), k5 = bfhi(kv.z), k6 = bflo(kv.w), k7 = bfhi(kv.w);
#pragma unroll
        for (int h = 0; h < 4; ++h) { const LAS f32x4* q = (const LAS f32x4*)(Q + h * 64 + c * 8); const f32x4 qa = q[0], qb = q[1];
            s[h] += (k0 * qa.x + k1 * qa.y) + (k2 * qa.z + k3 * qa.w) + (k4 * qb.x + k5 * qb.y) + (k6 * qb.z + k7 * qb.w); }
    }
}
__device__ __forceinline__ void naive_nsa_wave(int wu, const bf16* P0, const bf16* KC, const bf16* VC, bf16* MIX, LAS unsigned char* wlds, int lane) {
    LAS float* SC = (LAS float*)wlds; LAS float* Q = SC + 4096; LAS int* SEL = (LAS int*)(Q + 256);
    const int t = wu % SEQ, bg = wu / SEQ, g = bg & 1, b = bg >> 1;
    const size_t row = (size_t)b * SEQ + t;
    float slope[4];
#pragma unroll
    for (int h = 0; h < 4; ++h) slope[h] = exp2f(-(float)(g * 4 + h + 1));
#pragma unroll
    for (int h = 0; h < 4; ++h) Q[h * 64 + lane] = bf2f(P0[row * NP0 + C_Q + (g * 4 + h) * 64 + lane]);
    LDS_WAIT();
    const int nv = (t >= 31) ? min(NCMP, (t - 31) / 16 + 1) : 0;
    float o_cmp[4] = {0.f, 0.f, 0.f, 0.f};
    {
        float mx[4] = {-3e38f, -3e38f, -3e38f, -3e38f};
#pragma unroll 1
        for (int i = 0; i < 8; ++i) { const int n = lane + 64 * i; float s[4] = {-1e30f, -1e30f, -1e30f, -1e30f};
            if (n < nv) { nsa_dot4(KC + ((size_t)(b * 2 + g) * NCMP_PAD + n) * 64, Q, s);
#pragma unroll
                for (int h = 0; h < 4; ++h) { s[h] -= slope[h] * (float)(t - (16 * n + 31)); mx[h] = fmaxf(mx[h], s[h]); } }
#pragma unroll
            for (int h = 0; h < 4; ++h) SC[h * 1024 + n] = s[h]; }
        LDS_WAIT();
#pragma unroll
        for (int h = 0; h < 4; ++h) { const float m = wave_max(mx[h]); float sum = 0.f;
#pragma unroll 1
            for (int i = 0; i < 8; ++i) { const float s = SC[h * 1024 + lane + 64 * i]; const float e = (s > -1e29f) ? __expf(s - m) : 0.f; SC[h * 1024 + lane + 64 * i] = e; sum += e; }
            sum = wave_sum(sum); const float inv = 1.0f / fmaxf(sum, 1e-30f);
#pragma unroll 1
            for (int i = 0; i < 8; ++i) SC[h * 1024 + lane + 64 * i] *= inv; }
        LDS_WAIT();
#pragma unroll 2
        for (int n = 0; n < nv; ++n) { const float v = bf2f(VC[((size_t)(b * 2 + g) * NCMP_PAD + n) * 64 + lane]);
#pragma unroll
            for (int h = 0; h < 4; ++h) o_cmp[h] += SC[h * 1024 + n] * v; }
    }
    const int jcur = t >> 6;
    float c0, c1;
    {   float im[2];
#pragma unroll
        for (int k = 0; k < 2; ++k) { const int j = lane + 64 * k; float a = 0.f;
            for (int n = 4 * j - 1; n <= 4 * j + 3; ++n) if (n >= 0 && n < NCMP_PAD) a += (SC[n] + SC[1024 + n]) + (SC[2048 + n] + SC[3072 + n]);
            const bool forced = (j == 0) || (j == jcur) || (j == jcur - 1);
            im[k] = forced ? 1e9f : ((64 * j <= t) ? a : -1e30f); }
        c0 = im[0]; c1 = im[1]; }
    for (int it = 0; it < 16; ++it) {
        const float m = wave_max(fmaxf(c0, c1));
        const unsigned long long b0 = __ballot(c0 == m); int idx;
        if (b0) idx = __builtin_ctzll(b0); else idx = 64 + __builtin_ctzll(__ballot(c1 == m));
        if (lane == 0) SEL[it] = idx;
        if (lane == (idx & 63)) { if (idx < 64) c0 = -3e38f; else c1 = -3e38f; }
    }
    LDS_WAIT();
    float o_slc[4] = {0.f, 0.f, 0.f, 0.f}, inv_s[4];
    {   float mx[4] = {-3e38f, -3e38f, -3e38f, -3e38f};
#pragma unroll 1
        for (int it = 0; it < 16; ++it) { const int j = SEL[it]; const int kpos = 64 * j + lane; float s[4] = {-1e30f, -1e30f, -1e30f, -1e30f};
            if (kpos <= t) { nsa_dot4(P0 + ((size_t)b * SEQ + kpos) * NP0 + C_KS + g * 64, Q, s);
#pragma unroll
                for (int h = 0; h < 4; ++h) { s[h] -= slope[h] * (float)(t - kpos); mx[h] = fmaxf(mx[h], s[h]); } }
#pragma unroll
            for (int h = 0; h < 4; ++h) SC[h * 1024 + it * 64 + lane] = s[h]; }
        LDS_WAIT();
#pragma unroll
        for (int h = 0; h < 4; ++h) { const float m = wave_max(mx[h]); float sum = 0.f;
#pragma unroll 1
            for (int i = 0; i < 16; ++i) { const float s = SC[h * 1024 + i * 64 + lane]; const float e = (s > -1e29f) ? __expf(s - m) : 0.f; SC[h * 1024 + i * 64 + lane] = e; sum += e; }
            sum = wave_sum(sum); inv_s[h] = 1.0f / fmaxf(sum, 1e-30f); }
        LDS_WAIT();
#pragma unroll 1
        for (int it = 0; it < 16; ++it) { const int j = SEL[it]; if (j > jcur) continue;
#pragma unroll 2
            for (int kk = 0; kk < 64; ++kk) { const int kpos = 64 * j + kk; if (kpos > t) break;
                const float v = bf2f(P0[((size_t)b * SEQ + kpos) * NP0 + C_VS + g * 64 + lane]);
#pragma unroll
                for (int h = 0; h < 4; ++h) o_slc[h] += SC[h * 1024 + it * 64 + kk] * v; } }
    }
    float o_win[4] = {0.f, 0.f, 0.f, 0.f}, inv_w[4];
    {   float mx[4] = {-3e38f, -3e38f, -3e38f, -3e38f};
#pragma unroll 1
        for (int i = 0; i < 8; ++i) { const int kpos = t - 511 + 64 * i + lane; float s[4] = {-1e30f, -1e30f, -1e30f, -1e30f};
            if (kpos >= 0) { nsa_dot4(P0 + ((size_t)b * SEQ + kpos) * NP0 + C_KW + g * 64, Q, s);
#pragma unroll
                for (int h = 0; h < 4; ++h) { s[h] -= slope[h] * (float)(t - kpos); mx[h] = fmaxf(mx[h], s[h]); } }
#pragma unroll
            for (int h = 0; h < 4; ++h) SC[h * 1024 + i * 64 + lane] = s[h]; }
        LDS_WAIT();
#pragma unroll
        for (int h = 0; h < 4; ++h) { const float m = wave_max(mx[h]); float sum = 0.f;
#pragma unroll 1
            for (int i = 0; i < 8; ++i) { const float s = SC[h * 1024 + i * 64 + lane]; const float e = (s > -1e29f) ? __expf(s - m) : 0.f; SC[h * 1024 + i * 64 + lane] = e; sum += e; }
            sum = wave_sum(sum); inv_w[h] = 1.0f / fmaxf(sum, 1e-30f); }
        LDS_WAIT();
#pragma unroll 2
        for (int kk = 0; kk < 512; ++kk) { const int kpos = t - 511 + kk; if (kpos < 0) continue;
            const float v = bf2f(P0[((size_t)b * SEQ + kpos) * NP0 + C_VW + g * 64 + lane]);
#pragma unroll
            for (int h = 0; h < 4; ++h) o_win[h] += SC[h * 1024 + kk] * v; }
    }
#pragma unroll
    for (int h = 0; h < 4; ++h) { const bf16* gp = P0 + row * NP0 + C_GT + (g * 4 + h) * 3;
        const float o = bf2f(gp[0]) * o_cmp[h] + bf2f(gp[1]) * o_slc[h] * inv_s[h] + bf2f(gp[2]) * o_win[h] * inv_w[h];
        MIX[row * DM + 512 + (g * 4 + h) * 64 + lane] = f2bf(o); }
    LDS_WAIT();
}

__device__ __forceinline__ void naive_peer_select_wave(int wu, const bf16* QP, const bf16* KEYS, int* EXPO, float* GATEO, LAS unsigned char* wlds, int lane) {
    LAS float* Q = (LAS float*)wlds; LAS float* ST = Q + 256; LAS int* IT = (LAS int*)(ST + 32);
    const int tok = wu >> 3, h = wu & 7;
#pragma unroll
    for (int i = 0; i < 4; ++i) Q[lane + 64 * i] = bf2f(QP[(size_t)tok * NQP + h * 256 + lane + 64 * i]);
    LDS_WAIT();
    for (int p = 0; p < 2; ++p) {
        float c[2];
#pragma unroll
        for (int k = 0; k < 2; ++k) { const int n = lane + 64 * k; const v4u* kr = (const v4u*)(KEYS + ((size_t)(h * 2 + p) * 128 + n) * 128); float a = 0.f;
#pragma unroll 2
            for (int cc = 0; cc < 16; ++cc) { const v4u kv = kr[cc]; const LAS float* q = Q + p * 128 + cc * 8;
                a += (bflo(kv.x) * q[0] + bfhi(kv.x) * q[1]) + (bflo(kv.y) * q[2] + bfhi(kv.y) * q[3]) + (bflo(kv.z) * q[4] + bfhi(kv.z) * q[5]) + (bflo(kv.w) * q[6] + bfhi(kv.w) * q[7]); }
            c[k] = a; }
        float c0 = c[0], c1 = c[1];
        for (int it = 0; it < 16; ++it) {
            const float m = wave_max(fmaxf(c0, c1));
            const unsigned long long b0 = __ballot(c0 == m); int idx;
            if (b0) idx = __builtin_ctzll(b0); else idx = 64 + __builtin_ctzll(__ballot(c1 == m));
            if (lane == 0) { ST[p * 16 + it] = m; IT[p * 16 + it] = idx; }
            if (lane == (idx & 63)) { if (idx < 64) c0 = -3e38f; else c1 = -3e38f; }
        }
    }
    LDS_WAIT();
    float cd[4];
#pragma unroll
    for (int i = 0; i < 4; ++i) { const int f = lane + 64 * i; cd[i] = ST[f >> 4] + ST[16 + (f & 15)]; }
    float best = 0.f; int pos = 0;
    for (int it = 0; it < 16; ++it) {
        const float m = wave_max(fmaxf(fmaxf(cd[0], cd[1]), fmaxf(cd[2], cd[3])));
        int idx = -1;
#pragma unroll
        for (int i = 0; i < 4; ++i) { if (idx < 0) { const unsigned long long bb = __ballot(cd[i] == m); if (bb) idx = 64 * i + __builtin_ctzll(bb); } }
        if (lane == it) { best = m; pos = idx; }
#pragma unroll
        for (int i = 0; i < 4; ++i) if (idx == lane + 64 * i) cd[i] = -3e38f;
    }
    const float bmax = __shfl(best, 0);
    const float e = (lane < 16) ? __expf(best - bmax) : 0.f;
    const float sum = wave_sum(e);
    if (lane < 16) { const int ex = IT[pos >> 4] * 128 + IT[16 + (pos & 15)];
        EXPO[(size_t)tok * 128 + h * 16 + lane] = ex; GATEO[(size_t)tok * 128 + h * 16 + lane] = e / sum; }
    LDS_WAIT();
}

__device__ __forceinline__ void naive_peer_eval_wave(int tok, bf16* XN, const bf16* TU, const bf16* TV, const int* EXPI, const float* GATEI, float* xres, const float* nw_bf, const float* nw_f, int lane) {
    float x[16];
#pragma unroll
    for (int j = 0; j < 4; ++j) { const unsigned long long w = *((const unsigned long long*)(XN + (size_t)tok * DM) + lane + 64 * j);
        x[4 * j] = bflo((unsigned)w); x[4 * j + 1] = bfhi((unsigned)w); x[4 * j + 2] = bflo((unsigned)(w >> 32)); x[4 * j + 3] = bfhi((unsigned)(w >> 32)); }
    float acc[16];
#pragma unroll
    for (int i = 0; i < 16; ++i) acc[i] = 0.f;
    for (int e = 0; e < 128; ++e) {
        const int ex = EXPI[(size_t)tok * 128 + e]; const float gt = GATEI[(size_t)tok * 128 + e];
        const unsigned long long* ur = (const unsigned long long*)(TU + (size_t)ex * DM) + lane; float d = 0.f;
#pragma unroll
        for (int j = 0; j < 4; ++j) { const unsigned long long w = ur[64 * j];
            d += (bflo((unsigned)w) * x[4 * j] + bfhi((unsigned)w) * x[4 * j + 1]) + (bflo((unsigned)(w >> 32)) * x[4 * j + 2] + bfhi((unsigned)(w >> 32)) * x[4 * j + 3]); }
        d = wave_sum(d);
        const float wgt = gt * gelu_tanh(d);
        const unsigned long long* vr = (const unsigned long long*)(TV + (size_t)ex * DM) + lane;
#pragma unroll
        for (int j = 0; j < 4; ++j) { const unsigned long long w = vr[64 * j];
            acc[4 * j] += wgt * bflo((unsigned)w); acc[4 * j + 1] += wgt * bfhi((unsigned)w); acc[4 * j + 2] += wgt * bflo((unsigned)(w >> 32)); acc[4 * j + 3] += wgt * bfhi((unsigned)(w >> 32)); }
    }
    f32x4* xr = (f32x4*)(xres + (size_t)tok * DM) + lane; float ss = 0.f; f32x4 y[4];
#pragma unroll
    for (int j = 0; j < 4; ++j) { f32x4 r = xr[64 * j]; r.x += acc[4 * j]; r.y += acc[4 * j + 1]; r.z += acc[4 * j + 2]; r.w += acc[4 * j + 3]; y[j] = r; ss += (r.x * r.x + r.y * r.y) + (r.z * r.z + r.w * r.w); }
    const float rr = 1.0f / sqrtf(wave_sum(ss) * (1.0f / DM) + EPS);
#pragma unroll
    for (int j = 0; j < 4; ++j) {
        if (nw_f) { const f32x4 wv = *((const f32x4*)nw_f + lane + 64 * j); xr[64 * j] = y[j] * rr * wv; }
        else xr[64 * j] = y[j];
        if (nw_bf) { const f32x4 wv = *((const f32x4*)nw_bf + lane + 64 * j); const f32x4 z = y[j] * rr * wv;
            *((unsigned long long*)(XN + (size_t)tok * DM) + lane + 64 * j) = (unsigned long long)pk2(z.x, z.y) | ((unsigned long long)pk2(z.z, z.w) << 32); }
    }
}

__device__ __forceinline__ void naive_hgrn_block(int blk, const bf16* P1, const float* nw, bf16* OG, LAS unsigned char* lds, int tid) {
    constexpr int TB = 16;
    const int sq = tid >> 7, v = tid & 127, seq = blk * 4 + sq, b = seq >> 3, h = seq & 7;
    LAS float* QS = (LAS float*)lds + sq * (4 * TB * 128);
    LAS float* KS = QS + TB * 128; LAS float* FS = KS + TB * 128; LAS float* OS = FS + TB * 128;
    float st[128];
#pragma unroll
    for (int k = 0; k < 128; ++k) st[k] = 0.f;
    const float nwv = nw[h * 128 + v];
    for (int t0 = 0; t0 < SEQ; t0 += TB) {
        __syncthreads();
        for (int i = 0; i < TB; ++i) { const bf16* r = P1 + ((size_t)b * SEQ + t0 + i) * NP1 + h * 128 + v;
            QS[i * 128 + v] = bf2f(r[0]); const float kk = h2f_bits(r[1024]); KS[i * 128 + v] = kk; FS[i * 128 + v] = 1.0f - kk; }
        __syncthreads();
        for (int i = 0; i < TB; ++i) {
            const float vi = bf2f(P1[((size_t)b * SEQ + t0 + i) * NP1 + 2048 + h * 128 + v]); float o = 0.f;
#pragma unroll
            for (int k = 0; k < 128; ++k) { st[k] = FS[i * 128 + k] * st[k] + KS[i * 128 + k] * vi; o += QS[i * 128 + k] * st[k]; if ((k & 15) == 15) asm volatile("" ::: "memory"); }
            OS[i * 128 + v] = o;
        }
        __syncthreads();
        for (int i = 0; i < TB; ++i) { float ss = 0.f;
            for (int k = 0; k < 128; ++k) { const float o = OS[i * 128 + k]; ss += o * o; }
            const float rr = 1.0f / sqrtf(ss * (1.0f / 128.0f) + EPS);
            const float gate = bf2f(P1[((size_t)b * SEQ + t0 + i) * NP1 + 3072 + h * 128 + v]);
            OG[((size_t)b * SEQ + t0 + i) * DM + h * 128 + v] = f2bf(OS[i * 128 + v] * rr * nwv * gate); }
    }
    __syncthreads();
}
constexpr int HG_PQ = 136, HG_PK = 72;
constexpr int HG_QB = 0, HG_QT = 17408, HG_KT = 34816, HG_KH = 52224, HG_VT = 70656, HG_EB = 89088, HG_QP = 89600, HG_SS = 93696, HG_OT = 94720;
constexpr int HG_NSC = 8, HG_NCH = 16;
__device__ __forceinline__ unsigned pkbf(float lo, float hi) { bf16x2_t v; v[0] = (__bf16)lo; v[1] = (__bf16)hi; return __builtin_bit_cast(unsigned, v); }
__device__ __forceinline__ bf16x8 pack8(const f32x16& x, int sp) {
    v4u p; p.x = pkbf(x[8 * sp], x[8 * sp + 1]); p.y = pkbf(x[8 * sp + 2], x[8 * sp + 3]); p.z = pkbf(x[8 * sp + 4], x[8 * sp + 5]); p.w = pkbf(x[8 * sp + 6], x[8 * sp + 7]);
    return __builtin_bit_cast(bf16x8, p);
}
typedef unsigned u32x2 __attribute__((ext_vector_type(2)));
__device__ __forceinline__ bf16x8 ld2x8(const LAS bf16* p) {
    const u32x2 lo = *(const LAS u32x2*)p, hi = *(const LAS u32x2*)(p + 8); v4u v; v.x = lo.x; v.y = lo.y; v.z = hi.x; v.w = hi.y; return __builtin_bit_cast(bf16x8, v);
}
struct HgRaw { unsigned kkw[8], vvw[8], qw[8]; };
template <bool FULL>
__device__ __forceinline__ void hgrn_load(const bf16* P1, size_t row0, int h, int tid, HgRaw& R) {
    const int kp = tid & 63, sg = tid >> 6, k0 = 2 * kp;
    const bf16* base = P1 + (row0 + 8 * sg) * NP1 + h * 128 + k0;
#pragma unroll
    for (int i = 0; i < 8; ++i) { R.kkw[i] = *(const unsigned*)(base + (size_t)i * NP1 + 1024); R.vvw[i] = *(const unsigned*)(base + (size_t)i * NP1 + 2048); if (FULL) R.qw[i] = *(const unsigned*)(base + (size_t)i * NP1); }
}
template <bool FULL>
__device__ __forceinline__ void hgrn_prep(const HgRaw& R, LAS unsigned char* lds, int tid, float& gsum) {
    const int kp = tid & 63, sg = tid >> 6, k0 = 2 * kp;
    LAS float* QP = (LAS float*)(lds + HG_QP);
    const unsigned (&kkw)[8] = R.kkw; const unsigned (&vvw)[8] = R.vvw; const unsigned (&qw)[8] = R.qw;
    float ka[8], kb[8], ca[8], cb[8]; float ra = 0.f, rb = 0.f;
#pragma unroll
    for (int i = 0; i < 8; ++i) { ka[i] = h2f_bits((unsigned short)(kkw[i] & 0xffffu)); kb[i] = h2f_bits((unsigned short)(kkw[i] >> 16)); ra += __builtin_amdgcn_logf(1.0f - ka[i]); rb += __builtin_amdgcn_logf(1.0f - kb[i]); ca[i] = ra; cb[i] = rb; }
    *(LAS f32x2*)(QP + sg * 128 + k0) = (f32x2){ra, rb};
    __syncthreads();
    float offa = 0.f, offb = 0.f, brefa = 0.f, brefb = 0.f, bla = 0.f, blb = 0.f;
#pragma unroll
    for (int gq = 0; gq < 8; ++gq) { const f32x2 t = *(const LAS f32x2*)(QP + gq * 128 + k0); if (gq < sg) { offa += t.x; offb += t.y; } if (gq < 4) { brefa += t.x; brefb += t.y; } bla += t.x; blb += t.y; }
    if (sg == 0) { *(LAS f32x2*)((LAS float*)(lds + HG_EB) + k0) = (f32x2){__builtin_amdgcn_exp2f(bla), __builtin_amdgcn_exp2f(blb)}; gsum += bla; }
    if (sg == 1) gsum += blb;
    LAS bf16* QB = (LAS bf16*)(lds + HG_QB); LAS bf16* QT = (LAS bf16*)(lds + HG_QT); LAS bf16* KT = (LAS bf16*)(lds + HG_KT);
    unsigned kha[4], khb[4], vta[4], vtb[4];
    const float Fa = __builtin_amdgcn_exp2f(brefa), Fb = __builtin_amdgcn_exp2f(brefb), Ea = __builtin_amdgcn_exp2f(bla - brefa), Eb = __builtin_amdgcn_exp2f(blb - brefb);
#pragma unroll
    for (int i = 0; i < 8; i += 2) {
        const float a0 = offa + ca[i] - brefa, a1 = offa + ca[i + 1] - brefa, b0 = offb + cb[i] - brefb, b1 = offb + cb[i + 1] - brefb;
        const float pa0 = __builtin_amdgcn_exp2f(a0), pa1 = __builtin_amdgcn_exp2f(a1), pb0 = __builtin_amdgcn_exp2f(b0), pb1 = __builtin_amdgcn_exp2f(b1);
        const float na0 = __builtin_amdgcn_exp2f(-a0), na1 = __builtin_amdgcn_exp2f(-a1), nb0 = __builtin_amdgcn_exp2f(-b0), nb1 = __builtin_amdgcn_exp2f(-b1);
        const float kta0 = ka[i] * na0, kta1 = ka[i + 1] * na1, ktb0 = kb[i] * nb0, ktb1 = kb[i + 1] * nb1;
        kha[i >> 1] = pkbf(kta0 * Ea, kta1 * Ea);
        khb[i >> 1] = pkbf(ktb0 * Eb, ktb1 * Eb);
        vta[i >> 1] = (vvw[i] & 0xffffu) | (vvw[i + 1] << 16);
        vtb[i >> 1] = (vvw[i] >> 16) | (vvw[i + 1] & 0xffff0000u);
        if (FULL) {
            const int s0 = 8 * sg + i;
            const float qa0 = bflo(qw[i]) * pa0, qb0 = bfhi(qw[i]) * pb0, qa1 = bflo(qw[i + 1]) * pa1, qb1 = bfhi(qw[i + 1]) * pb1;
            *(LAS unsigned*)(QT + s0 * HG_PQ + k0) = pkbf(qa0, qb0); *(LAS unsigned*)(QT + (s0 + 1) * HG_PQ + k0) = pkbf(qa1, qb1);
            *(LAS unsigned*)(QB + s0 * HG_PQ + k0) = pkbf(qa0 * Fa, qb0 * Fb); *(LAS unsigned*)(QB + (s0 + 1) * HG_PQ + k0) = pkbf(qa1 * Fa, qb1 * Fb);
            *(LAS unsigned*)(KT + s0 * HG_PQ + k0) = pkbf(kta0, ktb0); *(LAS unsigned*)(KT + (s0 + 1) * HG_PQ + k0) = pkbf(kta1, ktb1);
        }
    }
    { v4u a; a.x = kha[0]; a.y = kha[1]; a.z = kha[2]; a.w = kha[3]; *(LAS v4u*)(lds + HG_KH + (k0 * HG_PK + 8 * sg) * 2) = a; a.x = khb[0]; a.y = khb[1]; a.z = khb[2]; a.w = khb[3]; *(LAS v4u*)(lds + HG_KH + ((k0 + 1) * HG_PK + 8 * sg) * 2) = a; }
    { v4u a; a.x = vta[0]; a.y = vta[1]; a.z = vta[2]; a.w = vta[3]; *(LAS v4u*)(lds + HG_VT + (k0 * HG_PK + 8 * sg) * 2) = a; a.x = vtb[0]; a.y = vtb[1]; a.z = vtb[2]; a.w = vtb[3]; *(LAS v4u*)(lds + HG_VT + ((k0 + 1) * HG_PK + 8 * sg) * 2) = a; }
    __syncthreads();
}
template <int NKT>
__device__ __forceinline__ void hgrn_state_update(f32x16 (&st)[NKT], int kt0, int vt, LAS unsigned char* lds, int r, int hh) {
    const LAS float* EB = (const LAS float*)(lds + HG_EB); const LAS bf16* KH = (const LAS bf16*)(lds + HG_KH); const LAS bf16* VT = (const LAS bf16*)(lds + HG_VT);
#pragma unroll
    for (int a = 0; a < NKT; ++a) {
#pragma unroll
        for (int g = 0; g < 4; ++g) { const f32x4 e = *(const LAS f32x4*)(EB + 32 * (kt0 + a) + 8 * g + 4 * hh); st[a][4 * g] *= e.x; st[a][4 * g + 1] *= e.y; st[a][4 * g + 2] *= e.z; st[a][4 * g + 3] *= e.w; }
    }
#if HGRN_BATCH
    bf16x8 bq[4];
#pragma unroll
    for (int ss = 0; ss < 4; ++ss) bq[ss] = *(const LAS bf16x8*)(VT + (32 * vt + r) * HG_PK + 16 * ss + 8 * hh);
    bf16x8 av[2][4];
#pragma unroll
    for (int ss = 0; ss < 4; ++ss) av[0][ss] = *(const LAS bf16x8*)(KH + (32 * kt0 + r) * HG_PK + 16 * ss + 8 * hh);
#pragma unroll
    for (int a = 0; a < NKT; ++a) {
        if (a + 1 < NKT) {
#pragma unroll
            for (int ss = 0; ss < 4; ++ss) av[(a + 1) & 1][ss] = *(const LAS bf16x8*)(KH + (32 * (kt0 + a + 1) + r) * HG_PK + 16 * ss + 8 * hh); }
        __builtin_amdgcn_sched_barrier(0);
#pragma unroll
        for (int ss = 0; ss < 4; ++ss) st[a] = MFMA32(av[a & 1][ss], bq[ss], st[a]);
        __builtin_amdgcn_sched_barrier(0);
    }
#else
#pragma unroll
    for (int ss = 0; ss < 4; ++ss) {
        const bf16x8 b = *(const LAS bf16x8*)(VT + (32 * vt + r) * HG_PK + 16 * ss + 8 * hh);
#pragma unroll
        for (int a = 0; a < NKT; ++a) { const bf16x8 av = *(const LAS bf16x8*)(KH + (32 * (kt0 + a) + r) * HG_PK + 16 * ss + 8 * hh); st[a] = MFMA32(av, b, st[a]); }
    }
#endif
}
__device__ __forceinline__ void hgrn_pass_a(int unit, const bf16* P1, float* LST, float* GST, LAS unsigned char* lds, int tid) {
    const int j = unit & 7, bh = unit >> 3, h = bh & 7, b = bh >> 3;
    const int lane = tid & 63, w = tid >> 6, r = lane & 31, hh = lane >> 5, kt = w >> 1, vt0 = 2 * (w & 1);
    f32x16 s0[1], s1[1];
#pragma unroll
    for (int i = 0; i < 16; ++i) { s0[0][i] = 0.f; s1[0][i] = 0.f; }
    float gsum = 0.f;
    HgRaw Rc, Rn;
    hgrn_load<false>(P1, (size_t)b * SEQ + j * 1024, h, tid, Rc); Rn = Rc;
    for (int c = 0; c < HG_NCH; ++c) {
        const size_t row0 = (size_t)b * SEQ + j * 1024 + c * 64;
        if (c + 1 < HG_NCH) hgrn_load<false>(P1, row0 + 64, h, tid, Rn);
        hgrn_prep<false>(Rc, lds, tid, gsum);
        Rc = Rn;
        hgrn_state_update<1>(s0, kt, vt0, lds, r, hh);
        hgrn_state_update<1>(s1, kt, vt0 + 1, lds, r, hh);
        __syncthreads();
    }
    float* L = LST + (size_t)unit * 16384;
#pragma unroll
#if HGRN_SSPF
    for (int i = 0; i < 16; ++i) { L[((vt0 * 64 + kt * 16 + i) * 64) + lane] = s0[0][i]; L[(((vt0 + 1) * 64 + kt * 16 + i) * 64) + lane] = s1[0][i]; }
#else
    for (int i = 0; i < 16; ++i) { const int k = 32 * kt + (i & 3) + 8 * (i >> 2) + 4 * hh; L[k * 128 + 32 * vt0 + r] = s0[0][i]; L[k * 128 + 32 * (vt0 + 1) + r] = s1[0][i]; }
#endif
    if (tid < 128) GST[unit * 128 + 2 * (tid & 63) + (tid >> 6)] = gsum;
}
__device__ __forceinline__ void hgrn_pass_c(int unit, const bf16* P1, const float* LST, const float* GST, const float* nw, bf16* OG, LAS unsigned char* lds, int tid) {
    const int j = unit & 7, bh = unit >> 3, h = bh & 7, b = bh >> 3;
    const int lane = tid & 63, w = tid >> 6, r = lane & 31, hh = lane >> 5, vt = w >> 1, tt = w & 1;
    f32x16 st[4];
#pragma unroll
    for (int a = 0; a < 4; ++a)
#pragma unroll
        for (int i = 0; i < 16; ++i) st[a][i] = 0.f;
#if HGRN_SSPF
#define HG_LDL(Lx, pp) { const float* L_ = LST + (size_t)(unit - j + (pp)) * 16384 + vt * 4096 + lane; _Pragma("unroll") for (int a = 0; a < 4; ++a) _Pragma("unroll") for (int i = 0; i < 16; ++i) Lx[a][i] = L_[(a * 16 + i) * 64]; }
#define HG_ACC(Lx, pp) { const float* Gp_ = GST + (unit - j + (pp)) * 128; _Pragma("unroll") for (int a = 0; a < 4; ++a) _Pragma("unroll") for (int g = 0; g < 4; ++g) { const f32x4 gv = *(const f32x4*)(Gp_ + 32 * a + 8 * g + 4 * hh); \
        st[a][4 * g] = __builtin_amdgcn_exp2f(gv.x) * st[a][4 * g] + Lx[a][4 * g]; st[a][4 * g + 1] = __builtin_amdgcn_exp2f(gv.y) * st[a][4 * g + 1] + Lx[a][4 * g + 1]; \
        st[a][4 * g + 2] = __builtin_amdgcn_exp2f(gv.z) * st[a][4 * g + 2] + Lx[a][4 * g + 2]; st[a][4 * g + 3] = __builtin_amdgcn_exp2f(gv.w) * st[a][4 * g + 3] + Lx[a][4 * g + 3]; } }
#pragma unroll 1
    for (int p = 0; p < j; ++p) {
        float LA[4][16];
        HG_LDL(LA, p);
        asm volatile("" ::: "memory");
        HG_ACC(LA, p);
    }
#undef HG_LDL
#undef HG_ACC
#else
    for (int p = 0; p < j; ++p) {
        const float* L = LST + (size_t)(unit - j + p) * 16384; const float* Gp = GST + (unit - j + p) * 128;
#pragma unroll
        for (int a = 0; a < 4; ++a) {
#pragma unroll
            for (int g = 0; g < 4; ++g) { const int k = 32 * a + 8 * g + 4 * hh; const f32x4 gv = *(const f32x4*)(Gp + k);
                st[a][4 * g] = __builtin_amdgcn_exp2f(gv.x) * st[a][4 * g] + L[k * 128 + 32 * vt + r]; st[a][4 * g + 1] = __builtin_amdgcn_exp2f(gv.y) * st[a][4 * g + 1] + L[(k + 1) * 128 + 32 * vt + r];
                st[a][4 * g + 2] = __builtin_amdgcn_exp2f(gv.z) * st[a][4 * g + 2] + L[(k + 2) * 128 + 32 * vt + r]; st[a][4 * g + 3] = __builtin_amdgcn_exp2f(gv.w) * st[a][4 * g + 3] + L[(k + 3) * 128 + 32 * vt + r]; }
            asm volatile("" ::: "memory");
        }
    }
#endif
    const LAS bf16* QB = (const LAS bf16*)(lds + HG_QB); const LAS bf16* QT = (const LAS bf16*)(lds + HG_QT); const LAS bf16* KT = (const LAS bf16*)(lds + HG_KT); const LAS bf16* VT = (const LAS bf16*)(lds + HG_VT);
    LAS float* SS = (LAS float*)(lds + HG_SS); LAS float* OT = (LAS float*)(lds + HG_OT);
    float gdummy = 0.f;
    HgRaw Rc;
    hgrn_load<true>(P1, (size_t)b * SEQ + j * 1024, h, tid, Rc);
    for (int c = 0; c < HG_NCH; ++c) {
        const size_t row0 = (size_t)b * SEQ + j * 1024 + c * 64;
        hgrn_prep<true>(Rc, lds, tid, gdummy);
        if (c + 1 < HG_NCH) hgrn_load<true>(P1, row0 + 64, h, tid, Rc);
#if HGRN_GATEPF
        v4u g0_, g1_; f32x4 nw_[4];
        {   const int t_ = tid >> 3, cc_ = tid & 7; const v4u* gp_ = (const v4u*)(P1 + (row0 + t_) * NP1 + 3072 + h * 128 + 16 * cc_); g0_ = gp_[0]; g1_ = gp_[1];
            const f32x4* np_ = (const f32x4*)(nw + h * 128 + 16 * cc_); nw_[0] = np_[0]; nw_[1] = np_[1]; nw_[2] = np_[2]; nw_[3] = np_[3]; }
#endif
        f32x16 o;
#pragma unroll
        for (int i = 0; i < 16; ++i) o[i] = 0.f;
#if HGRN_BATCH
        {
            bf16x8 fq[8], fk[8];
#pragma unroll
            for (int ks = 0; ks < 8; ++ks) { fq[ks] = *(const LAS bf16x8*)(QT + (32 * tt + r) * HG_PQ + 16 * ks + 8 * hh); fk[ks] = *(const LAS bf16x8*)(KT + r * HG_PQ + 16 * ks + 8 * hh); }
            __builtin_amdgcn_sched_barrier(0);
#pragma unroll
            for (int st_ = 0; st_ < 2; ++st_) {
                if (st_ <= tt) {
                    bf16x8 fv[2];
#pragma unroll
                    for (int sp = 0; sp < 2; ++sp) fv[sp] = ld2x8(VT + (32 * vt + r) * HG_PK + 32 * st_ + 16 * sp + 4 * hh);
                    f32x16 at;
                    { const f32x16 z16 = {}; at = MFMA32(fk[0], fq[0], z16); }
#pragma unroll
                    for (int ks = 1; ks < 8; ++ks) at = MFMA32(fk[ks], fq[ks], at);
                    if (st_ == 0 && tt == 1) {
#pragma unroll
                        for (int ks = 0; ks < 8; ++ks) fk[ks] = *(const LAS bf16x8*)(KT + (32 + r) * HG_PQ + 16 * ks + 8 * hh); }
                    __builtin_amdgcn_sched_barrier(0);
                    if (st_ == tt) {
#pragma unroll
                        for (int i = 0; i < 16; ++i) { const int s = (i & 3) + 8 * (i >> 2) + 4 * hh; if (s > r) at[i] = 0.f; }
                    }
#pragma unroll
                    for (int sp = 0; sp < 2; ++sp) { const bf16x8 bfrag = pack8(at, sp); o = MFMA32(fv[sp], bfrag, o); }
                }
            }
        }
        {
            bf16x8 fqb[2][2];
#pragma unroll
            for (int sp = 0; sp < 2; ++sp) fqb[0][sp] = ld2x8(QB + (32 * tt + r) * HG_PQ + 16 * sp + 4 * hh);
#pragma unroll
            for (int a = 0; a < 4; ++a) {
                if (a + 1 < 4) {
#pragma unroll
                    for (int sp = 0; sp < 2; ++sp) fqb[(a + 1) & 1][sp] = ld2x8(QB + (32 * tt + r) * HG_PQ + 32 * (a + 1) + 16 * sp + 4 * hh); }
                __builtin_amdgcn_sched_barrier(0);
#pragma unroll
                for (int sp = 0; sp < 2; ++sp) { const bf16x8 afrag = pack8(st[a], sp); o = MFMA32(afrag, fqb[a & 1][sp], o); }
                __builtin_amdgcn_sched_barrier(0);
            }
        }
#else
#pragma unroll
        for (int st_ = 0; st_ < 2; ++st_) {
            if (st_ <= tt) {
                f32x16 at;
#pragma unroll
                for (int i = 0; i < 16; ++i) at[i] = 0.f;
#pragma unroll
                for (int ks = 0; ks < 8; ++ks) { const bf16x8 a = *(const LAS bf16x8*)(KT + (32 * st_ + r) * HG_PQ + 16 * ks + 8 * hh); const bf16x8 bq = *(const LAS bf16x8*)(QT + (32 * tt + r) * HG_PQ + 16 * ks + 8 * hh); at = MFMA32(a, bq, at); }
                if (st_ == tt) {
#pragma unroll
                    for (int i = 0; i < 16; ++i) { const int s = (i & 3) + 8 * (i >> 2) + 4 * hh; if (s > r) at[i] = 0.f; }
                }
#pragma unroll
                for (int sp = 0; sp < 2; ++sp) { const bf16x8 bfrag = pack8(at, sp); const bf16x8 afrag = ld2x8(VT + (32 * vt + r) * HG_PK + 32 * st_ + 16 * sp + 4 * hh); o = MFMA32(afrag, bfrag, o); }
            }
        }
#pragma unroll
        for (int a = 0; a < 4; ++a)
#pragma unroll
            for (int sp = 0; sp < 2; ++sp) { const bf16x8 afrag = pack8(st[a], sp); const bf16x8 bfrag = ld2x8(QB + (32 * tt + r) * HG_PQ + 32 * a + 16 * sp + 4 * hh); o = MFMA32(afrag, bfrag, o); }
#endif
        hgrn_state_update<4>(st, 0, vt, lds, r, hh);
        float ss = 0.f;
#pragma unroll
        for (int i = 0; i < 16; ++i) ss += o[i] * o[i];
        ss += __shfl_xor(ss, 32);
        if (hh == 0) SS[vt * 64 + 32 * tt + r] = ss;
#pragma unroll
        for (int g = 0; g < 4; ++g) { f32x4 v; v.x = o[4 * g]; v.y = o[4 * g + 1]; v.z = o[4 * g + 2]; v.w = o[4 * g + 3]; *(LAS f32x4*)(OT + (32 * tt + r) * 132 + 32 * vt + 8 * g + 4 * hh) = v; }
        __syncthreads();
        {   const int t = tid >> 3, cc = tid & 7;
            const float tot = (SS[t] + SS[64 + t]) + (SS[128 + t] + SS[192 + t]);
            const float rr = 1.0f / sqrtf(tot * (1.0f / 128.0f) + EPS);
#if HGRN_GATEPF
            const v4u g0 = g0_, g1 = g1_; const f32x4* np = nw_;
#else
            const v4u* gp = (const v4u*)(P1 + (row0 + t) * NP1 + 3072 + h * 128 + 16 * cc); const v4u g0 = gp[0], g1 = gp[1];
            const f32x4* np = (const f32x4*)(nw + h * 128 + 16 * cc);
#endif
            const LAS f32x4* op = (const LAS f32x4*)(OT + t * 132 + 16 * cc);
            const f32x4 o0 = op[0] * rr * np[0], o1 = op[1] * rr * np[1], o2 = op[2] * rr * np[2], o3 = op[3] * rr * np[3];
            v4u w0, w1;
            w0.x = pkbf(o0.x * bflo(g0.x), o0.y * bfhi(g0.x)); w0.y = pkbf(o0.z * bflo(g0.y), o0.w * bfhi(g0.y)); w0.z = pkbf(o1.x * bflo(g0.z), o1.y * bfhi(g0.z)); w0.w = pkbf(o1.z * bflo(g0.w), o1.w * bfhi(g0.w));
            w1.x = pkbf(o2.x * bflo(g1.x), o2.y * bfhi(g1.x)); w1.y = pkbf(o2.z * bflo(g1.y), o2.w * bfhi(g1.y)); w1.z = pkbf(o3.x * bflo(g1.z), o3.y * bfhi(g1.z)); w1.w = pkbf(o3.z * bflo(g1.w), o3.w * bfhi(g1.w));
            v4u* dst = (v4u*)(OG + (row0 + t) * DM + h * 128 + 16 * cc); dst[0] = w0; dst[1] = w1;
        }
    }
    __syncthreads();
}
constexpr int NS_P = 72;
constexpr int NS_TILE = 64 * NS_P * 2;
constexpr int NS_IMP = 4 * NS_TILE, NS_TL = NS_IMP + 32768, NS_UN = NS_TL + 1024, NS_OT = NS_UN + 256;
constexpr float NS_LOG2E = 1.4426950408889634f;
enum { NK_CMP1 = 0, NK_CMP2 = 1, NK_SLC = 2, NK_WIN = 3 };
struct NsaSrc { const bf16* K; const bf16* V; int pitch; };
struct NsaLane {
    bf16x8 qf[4]; float slope2; f32x16 cbias;
    int tloc; int nmax; unsigned long long sel_lo, sel_hi;
};
__device__ __forceinline__ unsigned wave_max_u32(unsigned v) {
#pragma unroll
    for (int o = 1; o < 64; o <<= 1) { const unsigned t = (unsigned)__shfl_xor((int)v, o); v = v > t ? v : t; }
    return v;
}
__device__ __forceinline__ unsigned umax_(unsigned a, unsigned b) { return a > b ? a : b; }
__device__ __forceinline__ unsigned wave_max_u32_fast(unsigned v) {
    v = umax_(v, (unsigned)__builtin_amdgcn_update_dpp(0, (int)v, 0xB1, 0xf, 0xf, false));
    v = umax_(v, (unsigned)__builtin_amdgcn_update_dpp(0, (int)v, 0x4E, 0xf, 0xf, false));
    v = umax_(v, (unsigned)__builtin_amdgcn_update_dpp(0, (int)v, 0x141, 0xf, 0xf, false));
    v = umax_(v, (unsigned)__builtin_amdgcn_update_dpp(0, (int)v, 0x140, 0xf, 0xf, false));
    { auto sw = __builtin_amdgcn_permlane16_swap(v, v, false, false); const unsigned a = sw[0], b = sw[1]; v = umax_(a, b); }
    { auto sw = __builtin_amdgcn_permlane32_swap(v, v, false, false); const unsigned a = sw[0], b = sw[1]; v = umax_(a, b); }
    return v;
}
__device__ __forceinline__ void nsa_gload(const NsaSrc& S, int row0, int tid, v4u& kreg, v4u& vreg) {
    const int kr = row0 + (tid >> 3), vr = row0 + (tid & 63);
    kreg = *(const v4u*)(S.K + (size_t)(kr < 0 ? 0 : kr) * S.pitch + 8 * (tid & 7));
    vreg = *(const v4u*)(S.V + (size_t)(vr < 0 ? 0 : vr) * S.pitch + 8 * (tid >> 6));
}
__device__ __forceinline__ void nsa_lstore(LAS unsigned char* buf, int tid, const v4u& kreg, const v4u& vreg) {
    *(LAS v4u*)(buf + ((tid >> 3) * NS_P + 8 * (tid & 7)) * 2) = kreg;
    LAS bf16* vt = (LAS bf16*)(buf + NS_TILE) + (8 * (tid >> 6)) * NS_P + (tid & 63);
    vt[0 * NS_P] = (bf16)(vreg.x & 0xffffu); vt[1 * NS_P] = (bf16)(vreg.x >> 16); vt[2 * NS_P] = (bf16)(vreg.y & 0xffffu); vt[3 * NS_P] = (bf16)(vreg.y >> 16);
    vt[4 * NS_P] = (bf16)(vreg.z & 0xffffu); vt[5 * NS_P] = (bf16)(vreg.z >> 16); vt[6 * NS_P] = (bf16)(vreg.w & 0xffffu); vt[7 * NS_P] = (bf16)(vreg.w >> 16);
}
template <int KIND, int MODE>
__device__ __forceinline__ void nsa_compute_m(const LAS unsigned char* buf, int blk, int j0, const NsaLane& L, float& m, float& l, float inv_l, f32x16 (&O)[2], LAS float* impw, int r, int hh) {
    const LAS bf16* Ks = (const LAS bf16*)buf; const LAS bf16* Vt = (const LAS bf16*)(buf + NS_TILE);
    bool rowsel = true;
    if (KIND == NK_SLC) rowsel = (((blk < 64 ? L.sel_lo : L.sel_hi) >> (blk & 63)) & 1ull) != 0ull;
    f32x16 sa[2];
#pragma unroll
    for (int kt = 0; kt < 2; ++kt) {
        { const bf16x8 a = *(const LAS bf16x8*)(Ks + (32 * kt + r) * NS_P + 8 * hh); const f32x16 z16 = {};
          if (NSA_CMPBIAS && (KIND == NK_CMP1 || KIND == NK_CMP2)) sa[kt] = MFMA32(a, L.qf[0], L.cbias); else sa[kt] = MFMA32(a, L.qf[0], z16); }
#pragma unroll
        for (int s = 1; s < 4; ++s) { const bf16x8 a = *(const LAS bf16x8*)(Ks + (32 * kt + r) * NS_P + 16 * s + 8 * hh); sa[kt] = MFMA32(a, L.qf[s], sa[kt]); }
    }
    const float NEG = -__builtin_inff();
    float cb[2], mxk[2];
#pragma unroll
    for (int kt = 0; kt < 2; ++kt) {
        int lim;
        if (KIND == NK_CMP1 || KIND == NK_CMP2) { lim = L.nmax - 64 * blk - 32 * kt - 4 * hh; cb[kt] = -L.slope2 * (float)(64 * j0 + L.tloc - 31 - 16 * (64 * blk + 32 * kt + 4 * hh)); }
        else { lim = L.tloc - 32 * kt - 4 * hh; cb[kt] = -L.slope2 * (float)(64 * j0 + L.tloc - 64 * blk - 32 * kt - 4 * hh); }
        if (KIND == NK_SLC) cb[kt] = rowsel ? cb[kt] : NEG;
        float mx = NEG;
#pragma unroll
        for (int i = 0; i < 16; ++i) {
            const int kc = (i & 3) + 8 * (i >> 2);
            const float kcf = (KIND == NK_CMP1 || KIND == NK_CMP2) ? 16.0f * (float)kc : (float)kc;
            float s2 = (NSA_CMPBIAS && (KIND == NK_CMP1 || KIND == NK_CMP2)) ? sa[kt][i] : __builtin_fmaf(L.slope2, kcf, sa[kt][i]);
            if (MODE == 1) s2 = (kc <= lim) ? s2 : NEG; else if (MODE == 2) s2 = (kc > lim) ? s2 : NEG;
            sa[kt][i] = s2; mx = fmaxf(mx, s2);
        }
        mxk[kt] = mx;
    }
    if (KIND == NK_CMP2) {
#pragma unroll
        for (int kt = 0; kt < 2; ++kt) { const float off = m - cb[kt];
#pragma unroll
            for (int i = 0; i < 16; ++i) sa[kt][i] = __builtin_amdgcn_exp2f(sa[kt][i] - off) * inv_l; }
#pragma unroll
        for (int kt = 0; kt < 2; ++kt)
#pragma unroll
            for (int gq = 0; gq < 4; ++gq) {
                float a = (sa[kt][4 * gq] + sa[kt][4 * gq + 1]) + (sa[kt][4 * gq + 2] + sa[kt][4 * gq + 3]), last = sa[kt][4 * gq + 3];
                a += __builtin_bit_cast(float, __builtin_amdgcn_update_dpp(0, __builtin_bit_cast(int, a), 0xB1, 0xf, 0xf, false)); a += __builtin_bit_cast(float, __builtin_amdgcn_update_dpp(0, __builtin_bit_cast(int, a), 0x4E, 0xf, 0xf, false));
                last += __builtin_bit_cast(float, __builtin_amdgcn_update_dpp(0, __builtin_bit_cast(int, last), 0xB1, 0xf, 0xf, false)); last += __builtin_bit_cast(float, __builtin_amdgcn_update_dpp(0, __builtin_bit_cast(int, last), 0x4E, 0xf, 0xf, false));
                const int jg = 16 * blk + 8 * kt + 2 * gq + hh;
                if ((r & 3) == 0 && jg < 128) { LAS float* ip = impw + (r >> 2) * 128 + jg;
                    __hip_atomic_fetch_add(ip, a, __ATOMIC_RELAXED, __HIP_MEMORY_SCOPE_WORKGROUP);
                    if (jg + 1 < 128) __hip_atomic_fetch_add(ip + 1, last, __ATOMIC_RELAXED, __HIP_MEMORY_SCOPE_WORKGROUP); }
            }
    } else {
        float mt = fmaxf(mxk[0] + cb[0], mxk[1] + cb[1]);
        { auto sw = __builtin_amdgcn_permlane32_swap(__builtin_bit_cast(unsigned, mt), __builtin_bit_cast(unsigned, mt), false, false); const unsigned a_ = sw[0], b_ = sw[1]; mt = fmaxf(__builtin_bit_cast(float, a_), __builtin_bit_cast(float, b_)); }
        const float mn = fmaxf(m, mt), alpha = __builtin_amdgcn_exp2f(m - mn); m = mn;
        float ls = 0.f;
#pragma unroll
        for (int kt = 0; kt < 2; ++kt) { const float off = mn - cb[kt];
#pragma unroll
            for (int i = 0; i < 16; ++i) { const float p = __builtin_amdgcn_exp2f(sa[kt][i] - off); sa[kt][i] = p; ls += p; } }
        l = l * alpha + ls;
        if (KIND == NK_CMP1) return;
#pragma unroll
        for (int dt = 0; dt < 2; ++dt)
#pragma unroll
            for (int i = 0; i < 16; ++i) O[dt][i] *= alpha;
    }
#pragma unroll
    for (int kt = 0; kt < 2; ++kt)
#pragma unroll
        for (int sp = 0; sp < 2; ++sp) { const bf16x8 pb = pack8(sa[kt], sp);
#pragma unroll
            for (int dt = 0; dt < 2; ++dt) { const bf16x8 va = ld2x8(Vt + (32 * dt + r) * NS_P + 32 * kt + 16 * sp + 4 * hh); O[dt] = MFMA32(va, pb, O[dt]); } }
}
template <int KIND>
__device__ __forceinline__ void nsa_compute(const LAS unsigned char* buf, int blk, int j0, const NsaLane& L, float& m, float& l, float inv_l, f32x16 (&O)[2], LAS float* impw, int r, int hh) {
    if (KIND == NK_CMP1 || KIND == NK_CMP2) {
        const int nmin = (64 * j0 >= 31) ? ((64 * j0 - 31) >> 4) : -1;
        if (64 * blk + 63 <= nmin) nsa_compute_m<KIND, 0>(buf, blk, j0, L, m, l, inv_l, O, impw, r, hh); else nsa_compute_m<KIND, 1>(buf, blk, j0, L, m, l, inv_l, O, impw, r, hh);
        return; }
    if (blk == j0) { nsa_compute_m<KIND, 1>(buf, blk, j0, L, m, l, inv_l, O, impw, r, hh); return; }
    if (KIND == NK_WIN && blk == j0 - 8) { nsa_compute_m<KIND, 2>(buf, blk, j0, L, m, l, inv_l, O, impw, r, hh); return; }
    nsa_compute_m<KIND, 0>(buf, blk, j0, L, m, l, inv_l, O, impw, r, hh);
}
#if NSA_PIPE
#if NSA_FENCES
#define NSA_FENCE __builtin_amdgcn_sched_barrier(0)
#else
#define NSA_FENCE
#endif
#if NSA_VTR
__device__ __forceinline__ void nsa_gload2(const NsaSrc& S, int row0, int tid, v4u& kreg, v4u& vreg) {
    const int kr = row0 + (tid >> 3);
    kreg = *(const v4u*)(S.K + (size_t)(kr < 0 ? 0 : kr) * S.pitch + 8 * (tid & 7));
    vreg = *(const v4u*)(S.V + (size_t)(kr < 0 ? 0 : kr) * S.pitch + 8 * (tid & 7));
}
typedef short ns_s16x4 __attribute__((ext_vector_type(4)));
__device__ __forceinline__ bf16x8 nsa_vtr2(const LAS unsigned char* p) {
    const ns_s16x4 lo = __builtin_bit_cast(ns_s16x4, __builtin_amdgcn_ds_read_tr16_b64_v4i16((LAS ns_s16x4*)p)), hi = __builtin_bit_cast(ns_s16x4, __builtin_amdgcn_ds_read_tr16_b64_v4i16((LAS ns_s16x4*)(p + 512)));
    return (bf16x8){lo[0], lo[1], lo[2], lo[3], hi[0], hi[1], hi[2], hi[3]};
}
#endif
__device__ __forceinline__ void nsa_lstore2(LAS unsigned char* kb, LAS unsigned char* vb, int tid, const v4u& kreg, const v4u& vreg) {
#if NSA_VTR
    *(LAS v4u*)(kb + ((tid >> 3) * NS_P + 8 * (tid & 7)) * 2) = kreg;
    *(LAS v4u*)(vb + ((tid & 7) >> 2) * 4096 + (tid >> 3) * 64 + (tid & 3) * 16) = vreg;
    return;
#endif
    *(LAS v4u*)(kb + ((tid >> 3) * NS_P + 8 * (tid & 7)) * 2) = kreg;
    LAS bf16* vt = (LAS bf16*)vb + (8 * (tid >> 6)) * NS_P + (tid & 63);
    vt[0 * NS_P] = (bf16)(vreg.x & 0xffffu); vt[1 * NS_P] = (bf16)(vreg.x >> 16); vt[2 * NS_P] = (bf16)(vreg.y & 0xffffu); vt[3 * NS_P] = (bf16)(vreg.y >> 16);
    vt[4 * NS_P] = (bf16)(vreg.z & 0xffffu); vt[5 * NS_P] = (bf16)(vreg.z >> 16); vt[6 * NS_P] = (bf16)(vreg.w & 0xffffu); vt[7 * NS_P] = (bf16)(vreg.w >> 16);
}
__device__ __forceinline__ void nsa_qk(const LAS unsigned char* kn, const NsaLane& L, const f32x16& bias16, f32x16 (&sn)[2], int r, int hh) {
    const LAS bf16* Ks = (const LAS bf16*)kn;
#pragma unroll
    for (int kt = 0; kt < 2; ++kt) {
        { const bf16x8 a = *(const LAS bf16x8*)(Ks + (32 * kt + r) * NS_P + 8 * hh); sn[kt] = MFMA32(a, L.qf[0], bias16); }
#pragma unroll
        for (int s = 1; s < 4; ++s) { const bf16x8 a = *(const LAS bf16x8*)(Ks + (32 * kt + r) * NS_P + 16 * s + 8 * hh); sn[kt] = MFMA32(a, L.qf[s], sn[kt]); }
    }
}
template <int KIND, int MODE>
__device__ __forceinline__ void nsa_step_m(const LAS unsigned char* kn, const LAS unsigned char* vp, int blk, int j0, const NsaLane& L, const f32x16& bias16, float& m, float& l, f32x16 (&O)[2], f32x16 (&sa)[2], f32x16 (&sn)[2], int r, int hh) {
    const LAS bf16* Ks = (const LAS bf16*)kn; const LAS bf16* Vt = (const LAS bf16*)vp; const int lane_ = r + 32 * hh; (void)Vt; (void)lane_;
    bf16x8 kf[8];
#define NS_KF(c) (*(const LAS bf16x8*)(Ks + (32 * ((c) >> 2) + r) * NS_P + 16 * ((c) & 3) + 8 * hh))
    kf[0] = NS_KF(0); kf[1] = NS_KF(1); kf[2] = NS_KF(2);
    bool rowsel = true;
    if (KIND == NK_SLC) rowsel = (((blk < 64 ? L.sel_lo : L.sel_hi) >> (blk & 63)) & 1ull) != 0ull;
    const float NEG = -__builtin_inff();
    float cb[2], mxk[2];
#pragma unroll
    for (int kt = 0; kt < 2; ++kt) {
        const int lim = L.tloc - 32 * kt - 4 * hh; cb[kt] = -L.slope2 * (float)(64 * j0 + L.tloc - 64 * blk - 32 * kt - 4 * hh);
        if (KIND == NK_SLC) cb[kt] = rowsel ? cb[kt] : NEG;
        float mx = NEG;
#pragma unroll
        for (int q4 = 0; q4 < 4; ++q4) {
            if (4 * kt + q4 + 3 < 8) kf[4 * kt + q4 + 3] = NS_KF(4 * kt + q4 + 3);
            if (q4 == 0) sn[kt] = MFMA32(kf[4 * kt], L.qf[0], bias16); else sn[kt] = MFMA32(kf[4 * kt + q4], L.qf[q4], sn[kt]);
#pragma unroll
            for (int i = 4 * q4; i < 4 * q4 + 4; ++i) {
                const int kc = (i & 3) + 8 * (i >> 2);
                float s2 = sa[kt][i];
                if (MODE == 1) s2 = (kc <= lim) ? s2 : NEG; else if (MODE == 2) s2 = (kc > lim) ? s2 : NEG;
                sa[kt][i] = s2; mx = fmaxf(mx, s2);
            }
            NSA_FENCE;
        }
        mxk[kt] = mx;
    }
    float mt = fmaxf(mxk[0] + cb[0], mxk[1] + cb[1]);
    { auto sw = __builtin_amdgcn_permlane32_swap(__builtin_bit_cast(unsigned, mt), __builtin_bit_cast(unsigned, mt), false, false); const unsigned a_ = sw[0], b_ = sw[1]; mt = fmaxf(__builtin_bit_cast(float, a_), __builtin_bit_cast(float, b_)); }
#if NSA_DEFER
    if (__builtin_expect(__any(mt - m > 8.0f), 0)) { const float mn_ = fmaxf(m, mt), al_ = __builtin_amdgcn_exp2f(m - mn_); m = mn_; l *= al_;
#pragma unroll
        for (int dt = 0; dt < 2; ++dt)
#pragma unroll
            for (int i = 0; i < 16; ++i) O[dt][i] *= al_; }
    const float mn = m;
#else
    const float mn = fmaxf(m, mt), alpha = __builtin_amdgcn_exp2f(m - mn); m = mn;
#endif
#undef NS_KF
    bf16x8 vf[2][2][2];
#if NSA_VTR
    const LAS unsigned char* vtp = vp + ((lane_ >> 4) & 1) * 32 + (lane_ & 3) * 8 + (4 * hh + ((lane_ & 15) >> 2)) * 64;
#define NS_VF(kt, sp, dt) nsa_vtr2(vtp + (dt) * 4096 + (32 * (kt) + 16 * (sp)) * 64)
#else
#define NS_VF(kt, sp, dt) ld2x8(Vt + (32 * (dt) + r) * NS_P + 32 * (kt) + 16 * (sp) + 4 * hh)
#endif
#pragma unroll
    for (int sp = 0; sp < 2; ++sp)
#pragma unroll
        for (int dt = 0; dt < 2; ++dt) vf[0][sp][dt] = NS_VF(0, sp, dt);
#if !NSA_DEFER
#pragma unroll
    for (int dt = 0; dt < 2; ++dt)
#pragma unroll
        for (int i = 0; i < 16; ++i) O[dt][i] *= alpha;
#endif
    f32x2 ls2 = {0.f, 0.f};
    const float off0 = mn - cb[0], off1 = mn - cb[1];
#pragma unroll
    for (int i = 0; i < 16; i += 2) { const float p = __builtin_amdgcn_exp2f(sa[0][i] - off0), q = __builtin_amdgcn_exp2f(sa[0][i + 1] - off0); sa[0][i] = p; sa[0][i + 1] = q; ls2 += (f32x2){p, q}; }
    bf16x8 pb0[2]; pb0[0] = pack8(sa[0], 0); pb0[1] = pack8(sa[0], 1);
    NSA_FENCE;
#pragma unroll
    for (int j = 0; j < 4; ++j) {
        vf[1][j >> 1][j & 1] = NS_VF(1, j >> 1, j & 1);
        O[j & 1] = MFMA32(vf[0][j >> 1][j & 1], pb0[j >> 1], O[j & 1]);
#pragma unroll
        for (int i = 4 * j; i < 4 * j + 4; i += 2) { const float p = __builtin_amdgcn_exp2f(sa[1][i] - off1), q = __builtin_amdgcn_exp2f(sa[1][i + 1] - off1); sa[1][i] = p; sa[1][i + 1] = q; ls2 += (f32x2){p, q}; }
        NSA_FENCE;
    }
    const float ls = ls2.x + ls2.y;
#if NSA_DEFER
    l += ls;
#else
    l = l * alpha + ls;
#endif
#pragma unroll
    for (int sp = 0; sp < 2; ++sp) { const bf16x8 pb = pack8(sa[1], sp);
#pragma unroll
        for (int dt = 0; dt < 2; ++dt) O[dt] = MFMA32(vf[1][sp][dt], pb, O[dt]); }
#undef NS_VF
}
template <int MODE>
__device__ __forceinline__ void nsa_mask(f32x16 (&sa)[2], const NsaLane& L, int hh) {
    const float NEG = -__builtin_inff();
#pragma unroll
    for (int kt = 0; kt < 2; ++kt) { const int lim = L.tloc - 32 * kt - 4 * hh;
#pragma unroll
        for (int i = 0; i < 16; ++i) { const int kc = (i & 3) + 8 * (i >> 2); const bool keep = (MODE == 1) ? (kc <= lim) : (kc > lim); sa[kt][i] = keep ? sa[kt][i] : NEG; } }
}
template <int KIND>
__device__ __forceinline__ void nsa_step(const LAS unsigned char* kn, const LAS unsigned char* vp, int blk, int j0, const NsaLane& L, const f32x16& bias16, float& m, float& l, f32x16 (&O)[2], f32x16 (&sa)[2], f32x16 (&sn)[2], int r, int hh) {
    if (blk == j0) nsa_mask<1>(sa, L, hh);
    else if (KIND == NK_WIN && blk == j0 - 8) nsa_mask<2>(sa, L, hh);
    nsa_step_m<KIND, 0>(kn, vp, blk, j0, L, bias16, m, l, O, sa, sn, r, hh);
}
#if NSA_VTR
#define NSA_GLOAD2 nsa_gload2
#else
#define NSA_GLOAD2 nsa_gload
#endif
template <int KIND>
__device__ __forceinline__ void nsa_run_pipe(const NsaSrc& S, const LAS int* TL, int n, int j0, const NsaLane& L, float& m, float& l, f32x16 (&O)[2], LAS unsigned char* lds, unsigned long long wun_lo, unsigned long long wun_hi, int tid, int r, int hh) {
    __syncthreads();
    v4u ka_, va_;
    if (n > 0) NSA_GLOAD2(S, 64 * TL[0], tid, ka_, va_);
    f32x16 sA[2], sB[2];
    f32x16 bias16;
#pragma unroll
    for (int i = 0; i < 16; ++i) bias16[i] = L.slope2 * (float)((i & 3) + 8 * (i >> 2));
    asm volatile("" : "+v"(bias16));
    int vcur = 0, pblk = 0; bool pact = false; LAS unsigned char* pv = lds + NS_TILE;
#define NSA_STEP(i_, KB, kreg, vreg, sp_, sn_) { const int ii = (i_); const bool has = ii < n; \
        LAS unsigned char* vb = lds + (vcur == 0 ? NS_TILE : (vcur == 1 ? 3 * NS_TILE : NS_IMP)); \
        if (has) nsa_lstore2(KB, vb, tid, kreg, vreg); \
        int blk = 0; bool act = false; \
        if (has) { blk = TL[ii]; if (ii + 1 < n) NSA_GLOAD2(S, 64 * TL[ii + 1], tid, kreg, vreg); \
            act = (KIND != NK_SLC) || ((((blk < 64 ? wun_lo : wun_hi) >> (blk & 63)) & 1ull) != 0ull); } \
        __syncthreads(); \
        if (pact) nsa_step<KIND>(KB, pv, pblk, j0, L, bias16, m, l, O, sp_, sn_, r, hh); \
        else if (act) nsa_qk(KB, L, bias16, sn_, r, hh); \
        pblk = blk; pact = act; pv = vb; vcur = (vcur == 2) ? 0 : vcur + 1; }
    for (int i = 0; i <= n; i += 2) {
        NSA_STEP(i, lds, ka_, va_, sB, sA)
        if (i + 1 <= n) NSA_STEP(i + 1, lds + 2 * NS_TILE, ka_, va_, sA, sB)
    }
#undef NSA_STEP
}
#endif
#if NSA_DMA
#define ND_SBAR() __builtin_amdgcn_sched_barrier(0)
#define ND_PIN(x) asm volatile("" : "+v"(x))
#define ND_WAIT_BAR(N) asm volatile("s_waitcnt vmcnt(" #N ") lgkmcnt(0)\n\ts_barrier" ::: "memory")
#define ND_MX3(a, b, c) __builtin_fmaxf(__builtin_fmaxf((a), (b)), (c))
constexpr int ND_SLOT = 8192, ND_K = 0, ND_V = 3 * ND_SLOT;
constexpr float ND_THR = 8.0f;
typedef LAS const char* nd_lptr;
typedef short nd_s16x4 __attribute__((ext_vector_type(4)));
__device__ __forceinline__ unsigned nd_cvtpk(float lo, float hi) { unsigned r; asm("v_cvt_pk_bf16_f32 %0, %1, %2" : "=v"(r) : "v"(lo), "v"(hi)); return r; }
__device__ __forceinline__ void nd_glds16(const void* g, unsigned lds_base) {
    unsigned sv; asm volatile("s_mov_b32 %0, m0\n\ts_mov_b32 m0, %2\n\ts_nop 0\n\tglobal_load_lds_dwordx4 %1, off\n\ts_mov_b32 m0, %0" : "=&s"(sv) : "v"(g), "s"(lds_base) : "memory"); }
__device__ __forceinline__ void nd_kload2(bf16x8* kf, nd_lptr kp, int d0) { kf[2 * d0] = *(const LAS bf16x8*)(kp + d0 * 2048); kf[2 * d0 + 1] = *(const LAS bf16x8*)(kp + d0 * 2048 + 512); }
__device__ __forceinline__ nd_s16x4 nd_vtr(nd_lptr p) { return __builtin_bit_cast(nd_s16x4, __builtin_amdgcn_ds_read_tr16_b64_v4i16((LAS nd_s16x4*)p)); }
__device__ __forceinline__ float nd_max16(const f32x16& p) {
    float a = ND_MX3(p[0], p[1], p[2]), b = ND_MX3(p[3], p[4], p[5]);
    a = ND_MX3(a, p[6], p[7]); b = ND_MX3(b, p[8], p[9]); a = ND_MX3(a, p[10], p[11]); b = ND_MX3(b, p[12], p[13]); a = ND_MX3(a, p[14], p[15]);
    return __builtin_fmaxf(a, b); }
template <int MODE>
__device__ __forceinline__ void nd_mask(f32x16& p0, f32x16& p1, int tloc, int hi) {
    const float NEG = -__builtin_inff(); const int lim = tloc - 4 * hi;
#pragma unroll
    for (int i = 0; i < 16; ++i) { const int kc = (i & 3) + 8 * (i >> 2);
        if (MODE == 1) { if (kc > lim) p0[i] = NEG; if (kc + 32 > lim) p1[i] = NEG; } else { if (kc <= lim) p0[i] = NEG; if (kc + 32 <= lim) p1[i] = NEG; } }
}
template <int KIND>
__device__ __forceinline__ void nsa_run_dma(const bf16* Kg, const bf16* Vg, const LAS int* TL, int n, int j0, const NsaLane& L, float& m_out, float& l_out, f32x16 (&o)[2], LAS unsigned char* lds, int tid, int r32, int hi) {
    const int lane = tid & 63; const int wid = __builtin_amdgcn_readfirstlane(tid >> 6);
    const unsigned lds0 = (unsigned)(size_t)lds;
    const bf16* ksrc = Kg + (size_t)lane * NP0 + wid * 8;
    const bf16* vsrc = Vg + (size_t)(16 * (wid & 3) + (lane >> 2)) * NP0 + (wid >> 2) * 32 + (lane & 3) * 8;
    const unsigned kdst = lds0 + ND_K + wid * 1024, vdst = lds0 + ND_V + wid * 1024;
#define ND_TL(t) TL[(t) < n ? (t) : n - 1]
#define ND_DMA_K(t, slot) nd_glds16(ksrc + (size_t)ND_TL(t) * (64 * NP0), (unsigned)__builtin_amdgcn_readfirstlane(kdst + (slot)))
#define ND_DMA_V(t, slot) nd_glds16(vsrc + (size_t)ND_TL(t) * (64 * NP0), (unsigned)__builtin_amdgcn_readfirstlane(vdst + (slot)))
    const nd_lptr vp0 = (nd_lptr)lds + ND_V + ((lane >> 4) & 1) * 32 + (lane & 3) * 8 + (4 * hi + ((lane & 15) >> 2)) * 64;
    const nd_lptr kp0 = (nd_lptr)lds + ND_K + hi * 1024 + r32 * 16;
    __syncthreads();
    ND_DMA_K(0, 0); ND_DMA_V(0, 0); ND_DMA_K(1, ND_SLOT); ND_DMA_K(2, 2 * ND_SLOT);
    f32x16 bias16;
#pragma unroll
    for (int i = 0; i < 16; ++i) bias16[i] = L.slope2 * (float)((i & 3) + 8 * (i >> 2));
    ND_PIN(bias16);
    const float NEGI = -__builtin_inff();
    const float posq = (float)(64 * j0 + L.tloc - 4 * hi), s32 = 32.0f * L.slope2;
    float mhat = 0.f, l_reg = 0.f, fsc = 1.0f; bool resc = false;
    f32x16 pA0, pA1, pB0, pB1; bf16x8 kf[8]; nd_s16x4 vlo[8], vhi[8]; v4u pw0, pw1, pw2, pw3;
    int sl_prev = 0, sl_cur = 0, sl_next = ND_SLOT;
#define ND_ROT() do { sl_prev = sl_cur; sl_cur = sl_next; sl_next = (sl_next == 2 * ND_SLOT) ? 0 : sl_next + ND_SLOT; } while (0)
#define ND_EX(v, nm) __builtin_amdgcn_exp2f((v) + (nm))
#define ND_RESC() do { if (resc) { _Pragma("unroll") for (int d_ = 0; d_ < 2; ++d_) _Pragma("unroll") for (int i_ = 0; i_ < 16; ++i_) o[d_][i_] *= fsc; } } while (0)
    ND_WAIT_BAR(3);
#pragma unroll
    for (int d0 = 0; d0 < 4; ++d0) nd_kload2(kf, kp0, d0);
    pA0 = MFMA32(kf[0], L.qf[0], bias16); pA1 = MFMA32(kf[1], L.qf[0], bias16); pA0 = MFMA32(kf[2], L.qf[1], pA0); pA1 = MFMA32(kf[3], L.qf[1], pA1);
    pA0 = MFMA32(kf[4], L.qf[2], pA0); pA1 = MFMA32(kf[5], L.qf[2], pA1); pA0 = MFMA32(kf[6], L.qf[3], pA0); pA1 = MFMA32(kf[7], L.qf[3], pA1);
    nd_mask<1>(pA0, pA1, L.tloc, hi);
    {   const float cb0 = -L.slope2 * (posq - (float)(64 * j0)), cb1 = cb0 + s32;
        float rm = __builtin_fmaxf(nd_max16(pA0) + cb0, nd_max16(pA1) + cb1);
        { auto sw = __builtin_amdgcn_permlane32_swap(__builtin_bit_cast(unsigned, rm), __builtin_bit_cast(unsigned, rm), false, false); const unsigned a_ = sw[0], b_ = sw[1]; rm = __builtin_fmaxf(__builtin_bit_cast(float, a_), __builtin_bit_cast(float, b_)); }
        mhat = rm; const float nm0 = cb0 - mhat, nm1 = cb1 - mhat;
#pragma unroll
        for (int i = 0; i < 16; ++i) { pA0[i] = ND_EX(pA0[i], nm0); pA1[i] = ND_EX(pA1[i], nm1); } }
    ND_WAIT_BAR(0);
    ND_DMA_K(3, 0); ND_DMA_V(1, ND_SLOT); ND_ROT();
#pragma unroll
    for (int d0 = 0; d0 < 4; ++d0) nd_kload2(kf, kp0 + sl_cur, d0);
    ND_WAIT_BAR(2);
#define ND_PKW(P, i) nd_cvtpk(P[i], P[(i) + 1])
#define ND_PAF(k) __builtin_bit_cast(bf16x8, pw##k)
#define ND_VFR(i) (bf16x8){vlo[i][0], vlo[i][1], vlo[i][2], vlo[i][3], vhi[i][0], vhi[i][1], vhi[i][2], vhi[i][3]}
#define ND_VRD(i) do { vlo[i] = nd_vtr(vp_ + (((i) >> 2) * 4096 + ((i) & 3) * 1024)); vhi[i] = nd_vtr(vp_ + (((i) >> 2) * 4096 + ((i) & 3) * 1024 + 512)); } while (0)
#define ND_KRD(d0) do { nd_kload2(kf, kp0 + sl_next, d0); ND_SBAR(); } while (0)
#define ND_GAPA(MF, a0, a1, a2, a3, W0, W1, PW) do { MF; sacc += a0; sacc += a1; sacc += a2; sacc += a3; W0; W1; ND_PIN(PW); ND_PIN(sacc); ND_SBAR(); } while (0)
#define ND_GAPB(MF, X, i, nm) do { MF; X[i] = ND_EX(X[i], nm); X[(i) + 1] = ND_EX(X[(i) + 1], nm); X[(i) + 2] = ND_EX(X[(i) + 2], nm); X[(i) + 3] = ND_EX(X[(i) + 3], nm); ND_PIN(X); ND_SBAR(); } while (0)
#define ND_STEP(C0, C1, P0, P1, t) do { ND_SBAR(); \
    const nd_lptr vp_ = vp0 + sl_prev; const int blk = __builtin_amdgcn_readfirstlane(ND_TL(t)); \
    float sacc = P0[0] + P0[1]; \
                       ND_GAPA(C0 = MFMA32(kf[0], L.qf[0], bias16), P0[2], P0[3], P0[4], P0[5],     pw0[0] = ND_PKW(P0, 0),  pw0[1] = ND_PKW(P0, 2),  pw0); \
                       ND_GAPA(C1 = MFMA32(kf[1], L.qf[0], bias16), P0[6], P0[7], P0[8], P0[9],     pw0[2] = ND_PKW(P0, 4),  pw0[3] = ND_PKW(P0, 6),  pw0); \
                       ND_GAPA(C0 = MFMA32(kf[2], L.qf[1], C0),     P0[10], P0[11], P0[12], P0[13], pw1[0] = ND_PKW(P0, 8),  pw1[1] = ND_PKW(P0, 10), pw1); \
                       ND_GAPA(C1 = MFMA32(kf[3], L.qf[1], C1),     P0[14], P0[15], P1[0], P1[1],   pw1[2] = ND_PKW(P0, 12), pw1[3] = ND_PKW(P0, 14), pw1); \
    ND_VRD(0); ND_SBAR(); ND_GAPA(C0 = MFMA32(kf[4], L.qf[2], C0),     P1[2], P1[3], P1[4], P1[5],     pw2[0] = ND_PKW(P1, 0),  pw2[1] = ND_PKW(P1, 2),  pw2); \
    ND_VRD(4); ND_SBAR(); ND_GAPA(C1 = MFMA32(kf[5], L.qf[2], C1),     P1[6], P1[7], P1[8], P1[9],     pw2[2] = ND_PKW(P1, 4),  pw2[3] = ND_PKW(P1, 6),  pw2); \
    ND_VRD(1); ND_SBAR(); ND_GAPA(C0 = MFMA32(kf[6], L.qf[3], C0),     P1[10], P1[11], P1[12], P1[13], pw3[0] = ND_PKW(P1, 8),  pw3[1] = ND_PKW(P1, 10), pw3); \
    ND_VRD(5); ND_SBAR(); ND_GAPA(C1 = MFMA32(kf[7], L.qf[3], C1),     P1[14], P1[15], 0.f, 0.f,       pw3[2] = ND_PKW(P1, 12), pw3[3] = ND_PKW(P1, 14), pw3); \
    l_reg += sacc; \
    ND_DMA_K((t) + 3, sl_cur); ND_DMA_V((t) + 1, sl_next); \
    float cb0 = -L.slope2 * (posq - (float)(64 * blk)), cb1 = cb0 + s32; \
    if (KIND == NK_SLC) { const bool rowsel = (((blk < 64 ? L.sel_lo : L.sel_hi) >> (blk & 63)) & 1ull) != 0ull; cb0 = rowsel ? cb0 : NEGI; cb1 = rowsel ? cb1 : NEGI; } \
    if (KIND == NK_WIN && blk == j0 - 8) nd_mask<2>(C0, C1, L.tloc, hi); \
    {   float rm = __builtin_fmaxf(nd_max16(C0) + cb0, nd_max16(C1) + cb1); \
        { auto sw = __builtin_amdgcn_permlane32_swap(__builtin_bit_cast(unsigned, rm), __builtin_bit_cast(unsigned, rm), false, false); const unsigned a_ = sw[0], b_ = sw[1]; rm = __builtin_fmaxf(__builtin_bit_cast(float, a_), __builtin_bit_cast(float, b_)); } \
        rm -= mhat; resc = false; \
        if (__builtin_expect(__any(rm > ND_THR), 0)) { const float dl = __builtin_fmaxf(rm, 0.f); mhat += dl; fsc = __builtin_amdgcn_exp2f(-dl); l_reg *= fsc; resc = true; } } \
    const float nm0 = cb0 - mhat, nm1 = cb1 - mhat; ND_SBAR(); \
    ND_VRD(2); ND_SBAR(); ND_GAPB(o[0] = MFMA32(ND_VFR(0), ND_PAF(0), o[0]), C0, 0, nm0); \
    ND_VRD(6); ND_SBAR(); ND_GAPB(o[1] = MFMA32(ND_VFR(4), ND_PAF(0), o[1]), C0, 4, nm0); \
    ND_VRD(3); ND_SBAR(); ND_GAPB(o[0] = MFMA32(ND_VFR(1), ND_PAF(1), o[0]), C0, 8, nm0); \
    ND_VRD(7); ND_SBAR(); ND_GAPB(o[1] = MFMA32(ND_VFR(5), ND_PAF(1), o[1]), C0, 12, nm0); \
    ND_KRD(0); ND_GAPB(o[0] = MFMA32(ND_VFR(2), ND_PAF(2), o[0]), C1, 0, nm1);    ND_KRD(1); ND_GAPB(o[1] = MFMA32(ND_VFR(6), ND_PAF(2), o[1]), C1, 4, nm1); \
    ND_KRD(2); ND_GAPB(o[0] = MFMA32(ND_VFR(3), ND_PAF(3), o[0]), C1, 8, nm1);    ND_KRD(3); ND_GAPB(o[1] = MFMA32(ND_VFR(7), ND_PAF(3), o[1]), C1, 12, nm1); \
    } while (0)
#define ND_DRAIN(P0, P1) do { float sacc = P0[0] + P0[1]; \
      _Pragma("unroll") for (int i_ = 2; i_ < 16; ++i_) sacc += P0[i_]; \
      _Pragma("unroll") for (int i_ = 0; i_ < 16; ++i_) sacc += P1[i_]; \
      l_reg += sacc; \
      pw0 = (v4u){ND_PKW(P0, 0), ND_PKW(P0, 2), ND_PKW(P0, 4), ND_PKW(P0, 6)}; pw1 = (v4u){ND_PKW(P0, 8), ND_PKW(P0, 10), ND_PKW(P0, 12), ND_PKW(P0, 14)}; \
      pw2 = (v4u){ND_PKW(P1, 0), ND_PKW(P1, 2), ND_PKW(P1, 4), ND_PKW(P1, 6)}; pw3 = (v4u){ND_PKW(P1, 8), ND_PKW(P1, 10), ND_PKW(P1, 12), ND_PKW(P1, 14)}; \
      const nd_lptr vp_ = vp0 + sl_prev; _Pragma("unroll") for (int i_ = 0; i_ < 8; ++i_) ND_VRD(i_); \
      o[0] = MFMA32(ND_VFR(0), ND_PAF(0), o[0]); o[1] = MFMA32(ND_VFR(4), ND_PAF(0), o[1]); o[0] = MFMA32(ND_VFR(1), ND_PAF(1), o[0]); o[1] = MFMA32(ND_VFR(5), ND_PAF(1), o[1]); \
      o[0] = MFMA32(ND_VFR(2), ND_PAF(2), o[0]); o[1] = MFMA32(ND_VFR(6), ND_PAF(2), o[1]); o[0] = MFMA32(ND_VFR(3), ND_PAF(3), o[0]); o[1] = MFMA32(ND_VFR(7), ND_PAF(3), o[1]); } while (0)
    int t = 1;
    for (; t + 1 < n; t += 2) {
        ND_STEP(pB0, pB1, pA0, pA1, t);     ND_WAIT_BAR(2); ND_RESC(); ND_ROT();
        ND_STEP(pA0, pA1, pB0, pB1, t + 1); ND_WAIT_BAR(2); ND_RESC(); ND_ROT();
    }
    if (t < n) { ND_STEP(pB0, pB1, pA0, pA1, t); ND_WAIT_BAR(2); ND_RESC(); ND_ROT(); ND_DRAIN(pB0, pB1); }
    else ND_DRAIN(pA0, pA1);
    asm volatile("s_waitcnt vmcnt(0) lgkmcnt(0)\n\ts_barrier" ::: "memory");
    m_out = mhat; l_out = l_reg;
#undef ND_TL
#undef ND_DMA_K
#undef ND_DMA_V
#undef ND_ROT
#undef ND_EX
#undef ND_RESC
#undef ND_PKW
#undef ND_PAF
#undef ND_VFR
#undef ND_VRD
#undef ND_KRD
#undef ND_GAPA
#undef ND_GAPB
#undef ND_STEP
#undef ND_DRAIN
}
#endif
template <int KIND>
__device__ __forceinline__ void nsa_run(const NsaSrc& S, const LAS int* TL, int n, int j0, const NsaLane& L, float& m, float& l, float inv_l, f32x16 (&O)[2], LAS unsigned char* lds, LAS float* impw, unsigned long long wun_lo, unsigned long long wun_hi, int tid, int r, int hh) {
    __syncthreads();
    v4u ka_, va_, kb_, vb_;
    if (n > 0) nsa_gload(S, 64 * TL[0], tid, ka_, va_);
    if (n > 1) nsa_gload(S, 64 * TL[1], tid, kb_, vb_);
    for (int i = 0; i < n; i += 2) {
        {   LAS unsigned char* buf = lds;
            nsa_lstore(buf, tid, ka_, va_);
            __syncthreads();
            const int blk = TL[i];
            if (i + 2 < n) nsa_gload(S, 64 * TL[i + 2], tid, ka_, va_);
            bool act = true;
            if (KIND == NK_SLC) act = (((blk < 64 ? wun_lo : wun_hi) >> (blk & 63)) & 1ull) != 0ull;
            if (act) nsa_compute<KIND>(buf, blk, j0, L, m, l, inv_l, O, impw, r, hh);
        }
        if (i + 1 < n) {
            LAS unsigned char* buf = lds + 2 * NS_TILE;
            nsa_lstore(buf, tid, kb_, vb_);
            __syncthreads();
            const int blk = TL[i + 1];
            if (i + 3 < n) nsa_gload(S, 64 * TL[i + 3], tid, kb_, vb_);
            bool act = true;
            if (KIND == NK_SLC) act = (((blk < 64 ? wun_lo : wun_hi) >> (blk & 63)) & 1ull) != 0ull;
            if (act) nsa_compute<KIND>(buf, blk, j0, L, m, l, inv_l, O, impw, r, hh);
        }
    }
}
__device__ __forceinline__ void nsa_unit(int unit, const bf16* P0, const bf16* KC, const bf16* VC, bf16* MIX, LAS unsigned char* lds, int tid) {
    const int bg = unit & 7, j0 = unit >> 3, g = bg & 1, b = bg >> 1;
    const int lane = tid & 63, w = __builtin_amdgcn_readfirstlane(tid >> 6), r = lane & 31, hh = lane >> 5, hd = r & 3;
    LAS float* IMP = (LAS float*)(lds + NS_IMP); LAS float* impw = IMP + w * 1024;
    LAS int* TL = (LAS int*)(lds + NS_TL); LAS unsigned* UN = (LAS unsigned*)(lds + NS_UN);
    NsaLane L;
    L.tloc = 8 * w + (r >> 2);
    const int t = 64 * j0 + L.tloc; const size_t row = (size_t)b * SEQ + t;
    L.nmax = t >= 31 ? min(NCMP - 1, (t - 31) >> 4) : -1;
    L.slope2 = exp2f(-(float)(g * 4 + hd + 1)) * NS_LOG2E;
#pragma unroll
    for (int s = 0; s < 4; ++s) L.qf[s] = *(const bf16x8*)(P0 + row * NP0 + C_Q + (g * 4 + hd) * 64 + 16 * s + 8 * hh);
    L.sel_lo = 0ull; L.sel_hi = 0ull;
#pragma unroll
    for (int i = 0; i < 16; ++i) L.cbias[i] = L.slope2 * (float)(16 * ((i & 3) + 8 * (i >> 2)));
#pragma unroll
    for (int i = 0; i < 4; ++i) *(LAS f32x4*)(impw + 4 * lane + 256 * i) = (f32x4){0.f, 0.f, 0.f, 0.f};
    if (tid < 4) UN[tid] = 0u;
    const int ncnt = min(NCMP, 4 * j0 + 3), nct = (ncnt + 63) >> 6;
    __syncthreads();
    if (tid < 16) TL[tid] = tid;
    const NsaSrc Sc{KC + (size_t)(b * 2 + g) * NCMP_PAD * 64, VC + (size_t)(b * 2 + g) * NCMP_PAD * 64, 64};
    f32x16 O[2];
    LAS float* otl = (LAS float*)(lds + NS_OT) + w * 2048 + lane;
#pragma unroll
    for (int dt = 0; dt < 2; ++dt)
#pragma unroll
        for (int i = 0; i < 16; ++i) O[dt][i] = 0.f;
    float m = -1e30f, l = 0.f;
    nsa_run<NK_CMP1>(Sc, TL, nct, j0, L, m, l, 0.f, O, lds, impw, 0ull, 0ull, tid, r, hh);
    l += __shfl_xor(l, 32);
    const float inv_c = 1.0f / fmaxf(l, 1e-30f);
    nsa_run<NK_CMP2>(Sc, TL, nct, j0, L, m, l, inv_c, O, lds, impw, 0ull, 0ull, tid, r, hh);
    const float g0 = bf2f(P0[row * NP0 + C_GT + (g * 4 + hd) * 3]);
#pragma unroll
    for (int dt = 0; dt < 2; ++dt)
#pragma unroll
        for (int i = 0; i < 16; ++i) { otl[(dt * 16 + i) * 64] = g0 * O[dt][i]; O[dt][i] = 0.f; }
    LDS_WAIT();
    unsigned long long wun_lo = 0ull, wun_hi = 0ull;
    if (j0 < 16) { const unsigned long long all = (2ull << j0) - 1ull; L.sel_lo = all; wun_lo = all; }
    else {
        unsigned ka[8], kb[8];
#pragma unroll
        for (int tk = 0; tk < 8; ++tk) {
#pragma unroll
            for (int q = 0; q < 2; ++q) { const int j = lane + 64 * q; const float v = impw[tk * 128 + j];
                const bool forced = (j == 0) || (j == j0) || (j == j0 - 1);
                const float val = forced ? 1e9f : (j <= j0 ? v : -1e30f);
                const unsigned key = (ord_key(val) & ~0x7Fu) | (unsigned)(127 - j);
                if (q == 0) ka[tk] = key; else kb[tk] = key; }
        }
#if NSA_TOPK_BALLOT
        unsigned long long vun_lo = 0ull, vun_hi = 0ull;
#pragma unroll
        for (int tk = 0; tk < 8; ++tk) {
            unsigned T = 0u;
#pragma unroll 1
            for (int bit = 31; bit >= 0; --bit) {
                const unsigned cand = T | (1u << bit);
                const int cnt = __builtin_popcountll(__ballot(ka[tk] >= cand)) + __builtin_popcountll(__ballot(kb[tk] >= cand));
                T = (cnt >= 16) ? cand : T;
            }
            const unsigned long long mlo = __ballot(ka[tk] >= T), mhi = __ballot(kb[tk] >= T);
            if ((r >> 2) == tk) { L.sel_lo = mlo; L.sel_hi = mhi; }
            vun_lo |= mlo; vun_hi |= mhi;
        }
#else
        unsigned long long vun_lo = 0ull, vun_hi = 0ull;
#pragma unroll 1
        for (int it = 0; it < 16; ++it) {
#pragma unroll
            for (int tk = 0; tk < 8; ++tk) {
                const unsigned mx = wave_max_u32_fast(ka[tk] > kb[tk] ? ka[tk] : kb[tk]);
                const int idx = 127 - (int)(mx & 0x7Fu);
                const unsigned long long blo = idx < 64 ? (1ull << idx) : 0ull, bhi = idx < 64 ? 0ull : (1ull << (idx - 64));
                if (ka[tk] == mx) ka[tk] = 0u; if (kb[tk] == mx) kb[tk] = 0u;
                if ((r >> 2) == tk) { L.sel_lo |= blo; L.sel_hi |= bhi; }
                vun_lo |= blo; vun_hi |= bhi;
            }
        }
#endif
        wun_lo = ((unsigned long long)(unsigned)__builtin_amdgcn_readfirstlane((int)(vun_lo >> 32)) << 32) | (unsigned)__builtin_amdgcn_readfirstlane((int)vun_lo);
        wun_hi = ((unsigned long long)(unsigned)__builtin_amdgcn_readfirstlane((int)(vun_hi >> 32)) << 32) | (unsigned)__builtin_amdgcn_readfirstlane((int)vun_hi);
    }
    if (lane == 0) { atomicOr((unsigned*)(UN + 0), (unsigned)wun_lo); atomicOr((unsigned*)(UN + 1), (unsigned)(wun_lo >> 32)); atomicOr((unsigned*)(UN + 2), (unsigned)wun_hi); atomicOr((unsigned*)(UN + 3), (unsigned)(wun_hi >> 32)); }
    __syncthreads();
    int nsl = 0;
    {   unsigned long long ulo = (unsigned long long)UN[0] | ((unsigned long long)UN[1] << 32), uhi = (unsigned long long)UN[2] | ((unsigned long long)UN[3] << 32);
        if (j0 < 64) ulo &= ~(1ull << j0); else uhi &= ~(1ull << (j0 - 64));
        nsl = 1 + __builtin_popcountll(ulo) + __builtin_popcountll(uhi);
        if (tid == 0) { TL[0] = j0; int n = 1;
            while (uhi) { const int bpos = 63 - __builtin_clzll(uhi); TL[n++] = 64 + bpos; uhi &= ~(1ull << bpos); }
            while (ulo) { const int bpos = 63 - __builtin_clzll(ulo); TL[n++] = bpos; ulo &= ~(1ull << bpos); } }
    }
    const NsaSrc Ss{P0 + (size_t)b * SEQ * NP0 + C_KS + g * 64, P0 + (size_t)b * SEQ * NP0 + C_VS + g * 64, NP0};
    m = -1e30f; l = 0.f;
#if NSA_DMA && NSA_DMA_SLC
    nsa_run_dma<NK_SLC>(Ss.K, Ss.V, TL, nsl, j0, L, m, l, O, lds, tid, r, hh);
#elif NSA_PIPE && NSA_PIPE_SLC
    nsa_run_pipe<NK_SLC>(Ss, TL, nsl, j0, L, m, l, O, lds, wun_lo, wun_hi, tid, r, hh);
#else
    nsa_run<NK_SLC>(Ss, TL, nsl, j0, L, m, l, 0.f, O, lds, impw, wun_lo, wun_hi, tid, r, hh);
#endif
    l += __shfl_xor(l, 32);
    {   const float g1 = bf2f(P0[((size_t)b * SEQ + 64 * j0 + L.tloc) * NP0 + C_GT + (g * 4 + hd) * 3 + 1]);
        const float sc = g1 / fmaxf(l, 1e-30f);
#pragma unroll
        for (int dt = 0; dt < 2; ++dt)
#pragma unroll
            for (int i = 0; i < 16; ++i) { otl[(dt * 16 + i) * 64] += sc * O[dt][i]; O[dt][i] = 0.f; } }
    const int nw_ = min(9, j0 + 1);
    __syncthreads();
    if (tid < nw_) TL[tid] = j0 - tid;
    const NsaSrc Sw{P0 + (size_t)b * SEQ * NP0 + C_KW + g * 64, P0 + (size_t)b * SEQ * NP0 + C_VW + g * 64, NP0};
    m = -1e30f; l = 0.f;
#ifdef NSA_WIN_REP
    for (int rep2_ = 0; rep2_ < 2; ++rep2_) {
        m = -1e30f; l = 0.f;
#pragma unroll
        for (int dt = 0; dt < 2; ++dt)
#pragma unroll
            for (int i = 0; i < 16; ++i) O[dt][i] = 0.f;
        asm volatile("" ::: "memory");
#endif
#if NSA_DMA && NSA_DMA_WIN
    nsa_run_dma<NK_WIN>(Sw.K, Sw.V, TL, nw_, j0, L, m, l, O, lds, tid, r, hh);
#elif NSA_PIPE && NSA_PIPE_WIN
    nsa_run_pipe<NK_WIN>(Sw, TL, nw_, j0, L, m, l, O, lds, 0ull, 0ull, tid, r, hh);
#else
    nsa_run<NK_WIN>(Sw, TL, nw_, j0, L, m, l, 0.f, O, lds, impw, 0ull, 0ull, tid, r, hh);
#endif
#ifdef NSA_WIN_REP
    }
#endif
    l += __shfl_xor(l, 32);
    {   const float g2 = bf2f(P0[((size_t)b * SEQ + 64 * j0 + L.tloc) * NP0 + C_GT + (g * 4 + hd) * 3 + 2]);
        const float sc = g2 / fmaxf(l, 1e-30f);
#pragma unroll
        for (int dt = 0; dt < 2; ++dt)
#pragma unroll
            for (int i = 0; i < 16; ++i) O[dt][i] = otl[(dt * 16 + i) * 64] + sc * O[dt][i]; }
    bf16* orow = MIX + ((size_t)b * SEQ + 64 * j0 + L.tloc) * DM + 512 + (g * 4 + hd) * 64;
#pragma unroll
    for (int dt = 0; dt < 2; ++dt)
#pragma unroll
        for (int gq = 0; gq < 4; ++gq) { u32x2 v; v.x = pkbf(O[dt][4 * gq], O[dt][4 * gq + 1]); v.y = pkbf(O[dt][4 * gq + 2], O[dt][4 * gq + 3]); *(u32x2*)(orow + 32 * dt + 8 * gq + 4 * hh) = v; }
    __syncthreads();
}
constexpr int GM_P = 136;
__device__ __forceinline__ void gmlp_unit(int u, const bf16* P0, const float* lnw, const bf16* WSTRIL, const float* bs, bf16* MIX, LAS unsigned char* lds, int tid) {
    LAS bf16* VnT = (LAS bf16*)lds;
    const int g = u & 3, row0 = (u >> 2) * 128;
    {   const int rr = tid >> 2, q = tid & 3;
        const v4u* src = (const v4u*)(P0 + (size_t)(row0 + rr) * NP0 + C_V + g * 128 + q * 32);
        float v[32]; float s = 0.f;
#pragma unroll
        for (int c = 0; c < 4; ++c) { const v4u x = src[c]; v[8 * c] = bflo(x.x); v[8 * c + 1] = bfhi(x.x); v[8 * c + 2] = bflo(x.y); v[8 * c + 3] = bfhi(x.y); v[8 * c + 4] = bflo(x.z); v[8 * c + 5] = bfhi(x.z); v[8 * c + 6] = bflo(x.w); v[8 * c + 7] = bfhi(x.w); }
#pragma unroll
        for (int i = 0; i < 32; ++i) s += v[i];
        s += __shfl_xor(s, 1); s += __shfl_xor(s, 2);
        const float mean = s * (1.0f / 128.0f); float q2 = 0.f;
#pragma unroll
        for (int i = 0; i < 32; ++i) { const float d = v[i] - mean; q2 += d * d; }
        q2 += __shfl_xor(q2, 1); q2 += __shfl_xor(q2, 2);
        const float rstd = 1.0f / sqrtf(q2 * (1.0f / 128.0f) + EPS);
        const f32x4* lw = (const f32x4*)(lnw + g * 128 + q * 32);
#pragma unroll
        for (int c = 0; c < 8; ++c) { const f32x4 w4 = lw[c];
            VnT[(q * 32 + 4 * c + 0) * GM_P + rr] = (bf16)(pkbf((v[4 * c + 0] - mean) * rstd * w4.x, 0.f) & 0xffffu);
            VnT[(q * 32 + 4 * c + 1) * GM_P + rr] = (bf16)(pkbf((v[4 * c + 1] - mean) * rstd * w4.y, 0.f) & 0xffffu);
            VnT[(q * 32 + 4 * c + 2) * GM_P + rr] = (bf16)(pkbf((v[4 * c + 2] - mean) * rstd * w4.z, 0.f) & 0xffffu);
            VnT[(q * 32 + 4 * c + 3) * GM_P + rr] = (bf16)(pkbf((v[4 * c + 3] - mean) * rstd * w4.w, 0.f) & 0xffffu); }
    }
    __syncthreads();
    {   const int lane = tid & 63, w = tid >> 6, r = lane & 31, hh = lane >> 5, tt = w >> 1, dh = w & 1;
        f32x16 acc[2];
#pragma unroll
        for (int i = 0; i < 16; ++i) { acc[0][i] = 0.f; acc[1][i] = 0.f; }
        const bf16* wrow = WSTRIL + ((size_t)(g * 128 + 32 * tt + r)) * 128 + 8 * hh;
        const int nks = 2 * (tt + 1);
        for (int ks = 0; ks < nks; ++ks) {
            const bf16x8 a = *(const bf16x8*)(wrow + 16 * ks);
#pragma unroll
            for (int dd = 0; dd < 2; ++dd) { const bf16x8 bv = *(const LAS bf16x8*)(VnT + (32 * (2 * dh + dd) + r) * GM_P + 16 * ks + 8 * hh); acc[dd] = MFMA32(a, bv, acc[dd]); }
        }
#pragma unroll
        for (int dd = 0; dd < 2; ++dd)
#pragma unroll
            for (int i = 0; i < 16; ++i) { const int t = 32 * tt + (i & 3) + 8 * (i >> 2) + 4 * hh, d = 32 * (2 * dh + dd) + r;
                const float mixed = acc[dd][i] + bs[g * 128 + t];
                const float uu = bf2f(P0[(size_t)(row0 + t) * NP0 + C_U + g * 128 + d]);
                MIX[(size_t)(row0 + t) * DM + g * 128 + d] = (bf16)(pkbf(uu * mixed, 0.f) & 0xffffu); }
    }
    __syncthreads();
}
__device__ __forceinline__ void gmlp_run(int ubase, int ucnt, int ustep, const bf16* P0, const float* lnw, const bf16* WSTRIL, const float* bs, bf16* MIX, LAS unsigned char* lds, int tid) {
    const int g = ubase & 3;
    const int rr = tid >> 2, q = tid & 3;
    const int lane = tid & 63, w = tid >> 6, r = lane & 31, hh = lane >> 5, tt = w >> 1, dh = w & 1;
    const int nks = 2 * (tt + 1);
    bf16x8 a[8];
    const bf16* wrow = WSTRIL + ((size_t)(g * 128 + 32 * tt + r)) * 128 + 8 * hh;
#pragma unroll
    for (int ks = 0; ks < 8; ++ks) a[ks] = *(const bf16x8*)(wrow + 16 * ks);
    float bsv[16];
#pragma unroll
    for (int i = 0; i < 16; ++i) bsv[i] = bs[g * 128 + 32 * tt + (i & 3) + 8 * (i >> 2) + 4 * hh];
    f32x4 lw[8];
#pragma unroll
    for (int c = 0; c < 8; ++c) lw[c] = *((const f32x4*)(lnw + g * 128 + q * 32) + c);
    v4u vraw[4];
    {   const v4u* src = (const v4u*)(P0 + (size_t)((ubase >> 2) * 128 + rr) * NP0 + C_V + g * 128 + q * 32);
#pragma unroll
        for (int c = 0; c < 4; ++c) vraw[c] = src[c]; }
    for (int k = 0; k < ucnt; ++k) {
        const int u = ubase + ustep * k, row0 = (u >> 2) * 128;
        LAS bf16* VnT = (LAS bf16*)(lds + (k & 1) * (128 * GM_P * 2));
        bf16 uu[2][16];
#pragma unroll
        for (int dd = 0; dd < 2; ++dd)
#pragma unroll
            for (int i = 0; i < 16; ++i) { const int t = 32 * tt + (i & 3) + 8 * (i >> 2) + 4 * hh, d = 32 * (2 * dh + dd) + r;
                uu[dd][i] = P0[(size_t)(row0 + t) * NP0 + C_U + g * 128 + d]; }
        {   float v[32]; float s = 0.f;
#pragma unroll
            for (int c = 0; c < 4; ++c) { const v4u x = vraw[c]; v[8 * c] = bflo(x.x); v[8 * c + 1] = bfhi(x.x); v[8 * c + 2] = bflo(x.y); v[8 * c + 3] = bfhi(x.y); v[8 * c + 4] = bflo(x.z); v[8 * c + 5] = bfhi(x.z); v[8 * c + 6] = bflo(x.w); v[8 * c + 7] = bfhi(x.w); }
            if (k + 1 < ucnt) { const v4u* src = (const v4u*)(P0 + (size_t)(((u + ustep) >> 2) * 128 + rr) * NP0 + C_V + g * 128 + q * 32);
#pragma unroll
                for (int c = 0; c < 4; ++c) vraw[c] = src[c]; }
#pragma unroll
            for (int i = 0; i < 32; ++i) s += v[i];
            s += __shfl_xor(s, 1); s += __shfl_xor(s, 2);
            const float mean = s * (1.0f / 128.0f); float q2 = 0.f;
#pragma unroll
            for (int i = 0; i < 32; ++i) { const float d = v[i] - mean; q2 += d * d; }
            q2 += __shfl_xor(q2, 1); q2 += __shfl_xor(q2, 2);
            const float rstd = 1.0f / sqrtf(q2 * (1.0f / 128.0f) + EPS);
#pragma unroll
            for (int c = 0; c < 8; ++c) { const f32x4 w4 = lw[c];
                VnT[(q * 32 + 4 * c + 0) * GM_P + rr] = (bf16)(pkbf((v[4 * c + 0] - mean) * rstd * w4.x, 0.f) & 0xffffu);
                VnT[(q * 32 + 4 * c + 1) * GM_P + rr] = (bf16)(pkbf((v[4 * c + 1] - mean) * rstd * w4.y, 0.f) & 0xffffu);
                VnT[(q * 32 + 4 * c + 2) * GM_P + rr] = (bf16)(pkbf((v[4 * c + 2] - mean) * rstd * w4.z, 0.f) & 0xffffu);
                VnT[(q * 32 + 4 * c + 3) * GM_P + rr] = (bf16)(pkbf((v[4 * c + 3] - mean) * rstd * w4.w, 0.f) & 0xffffu); }
        }
        __syncthreads();
        f32x16 acc[2];
#pragma unroll
        for (int i = 0; i < 16; ++i) { acc[0][i] = 0.f; acc[1][i] = 0.f; }
#pragma unroll
        for (int ks = 0; ks < 8; ++ks) if (ks < nks) {
#pragma unroll
            for (int dd = 0; dd < 2; ++dd) { const bf16x8 bv = *(const LAS bf16x8*)(VnT + (32 * (2 * dh + dd) + r) * GM_P + 16 * ks + 8 * hh); acc[dd] = MFMA32(a[ks], bv, acc[dd]); }
        }
#pragma unroll
        for (int dd = 0; dd < 2; ++dd)
#pragma unroll
            for (int i = 0; i < 16; ++i) { const int t = 32 * tt + (i & 3) + 8 * (i >> 2) + 4 * hh, d = 32 * (2 * dh + dd) + r;
                MIX[(size_t)(row0 + t) * DM + g * 128 + d] = (bf16)(pkbf(bf2f(uu[dd][i]) * (acc[dd][i] + bsv[i]), 0.f) & 0xffffu); }
    }
    __syncthreads();
}
__device__ __forceinline__ void compress_unit(int cu, const bf16* P0, const bf16* W1T, const bf16* W2T, const float* BIAS1, bf16* KC, bf16* VC, LAS unsigned char* lds, int tid) {
    LAS bf16* H1 = (LAS bf16*)lds;
    const int nt8 = cu & 7, which = (cu >> 3) & 1, bg = cu >> 4, g = bg & 1, b = bg >> 1, n0 = 64 * nt8;
    const int lane = tid & 63, w = tid >> 6, r = lane & 31, hh = lane >> 5;
    const bf16* w1t = W1T + (size_t)which * 128 * 2048; const bf16* w2t = W2T + (size_t)which * 64 * 128; bf16* O = which ? VC : KC;
    const int col = (which ? C_VC : C_KC) + g * 64;
    {   const int mt = w & 1, ht = w >> 1;
        int n = n0 + 32 * mt + r; if (n > NCMP - 1) n = NCMP - 1;
        const bf16* arow = P0 + ((size_t)b * SEQ + 16 * n) * NP0 + col + 8 * hh;
        const bf16* brow = w1t + (size_t)(32 * ht + r) * 2048 + 8 * hh;
        f32x16 acc;
#pragma unroll
        for (int i = 0; i < 16; ++i) acc[i] = 0.f;
#if P2_PIPE
        bf16x8 A0[8], B0[8], A1[8], B1[8];
#define CU_LD(A, B, kb) { _Pragma("unroll") for (int j = 0; j < 8; ++j) { const int ks = 8 * (kb) + j; A[j] = *(const bf16x8*)(arow + (size_t)(ks >> 2) * NP0 + 16 * (ks & 3)); B[j] = *(const bf16x8*)(brow + 16 * ks); } }
#define CU_MM(A, B) { _Pragma("unroll") for (int j = 0; j < 8; ++j) acc = MFMA32(A[j], B[j], acc); }
        CU_LD(A0, B0, 0);
#pragma unroll 1
        for (int kb = 0; kb < 16; kb += 2) {
            CU_LD(A1, B1, kb + 1); CU_MM(A0, B0);
            if (kb + 2 < 16) CU_LD(A0, B0, kb + 2);
            CU_MM(A1, B1);
        }
#undef CU_LD
#undef CU_MM
#else
#pragma unroll 8
        for (int ks = 0; ks < 128; ++ks) {
            const bf16x8 a = *(const bf16x8*)(arow + (size_t)(ks >> 2) * NP0 + 16 * (ks & 3));
            const bf16x8 bv = *(const bf16x8*)(brow + 16 * ks);
            acc = MFMA32(a, bv, acc);
        }
#endif
        const float bias = BIAS1[which * 128 + 32 * ht + r];
#pragma unroll
        for (int i = 0; i < 16; ++i) { const int nn = 32 * mt + (i & 3) + 8 * (i >> 2) + 4 * hh; H1[nn * GM_P + 32 * ht + r] = (bf16)(pkbf(gelu_tanh(acc[i] + bias), 0.f) & 0xffffu); }
    }
    __syncthreads();
    if (w < 4) {
        const int mt = w & 1, dt = w >> 1;
        f32x16 acc;
#pragma unroll
        for (int i = 0; i < 16; ++i) acc[i] = 0.f;
#pragma unroll
        for (int ks = 0; ks < 8; ++ks) { const bf16x8 a = *(const LAS bf16x8*)(H1 + (32 * mt + r) * GM_P + 16 * ks + 8 * hh); const bf16x8 bv = *(const bf16x8*)(w2t + (size_t)(32 * dt + r) * 128 + 16 * ks + 8 * hh); acc = MFMA32(a, bv, acc); }
#pragma unroll
        for (int i = 0; i < 16; ++i) { const int n = n0 + 32 * mt + (i & 3) + 8 * (i >> 2) + 4 * hh;
            O[((size_t)(b * 2 + g) * NCMP_PAD + n) * 64 + 32 * dt + r] = (n < NCMP) ? (bf16)(pkbf(acc[i], 0.f) & 0xffffu) : (bf16)0; }
    }
    __syncthreads();
}

__device__ __forceinline__ void compress_unit32(int cu, const bf16* P0, const bf16* W1F, const bf16* W2T, const float* BIAS1, bf16* KC, bf16* VC, LAS unsigned char* lds, int tid) {
    const int nt = cu & 15, which = (cu >> 4) & 1, bg = cu >> 5, g = bg & 1, b = bg >> 1, n0 = 32 * nt;
    const int lane = tid & 63, w = tid >> 6, r = lane & 31, hh = lane >> 5;
    const int col = (which ? C_VC : C_KC) + g * 64;
    LAS unsigned char* WIN = lds;
    LAS float* RED = (LAS float*)(lds + 528 * 128);
    LAS bf16* H1 = (LAS bf16*)(lds + 528 * 128 + 32 * 132 * 4);
    {   v4u x[9];
#pragma unroll
        for (int j = 0; j < 9; ++j) { const int it = tid + 512 * j, row = it >> 3, c = it & 7; int t = 16 * n0 + row; if (t > SEQ - 1) t = SEQ - 1;
            if (it < 528 * 8) x[j] = *(const v4u*)(P0 + ((size_t)b * SEQ + t) * NP0 + col + 8 * c); }
#pragma unroll
        for (int j = 0; j < 9; ++j) { const int it = tid + 512 * j, row = it >> 3, c = it & 7;
            if (it < 528 * 8) *(LAS v4u*)(WIN + row * 128 + (((c + (row >> 4)) & 7) << 4)) = x[j]; }
    }
    const int ht = w & 3, kh = w >> 2;
    const bf16x8* bfr = (const bf16x8*)W1F + ((size_t)(which * 4 + ht) * 128 + 64 * kh) * 64 + lane;
    bf16x8 B0[8], B1[8];
#define C3_LD(B, kb) { _Pragma("unroll") for (int j = 0; j < 8; ++j) B[j] = bfr[(size_t)(8 * (kb) + j) * 64]; }
#define C3_MM(B, kb) { _Pragma("unroll") for (int j = 0; j < 8; ++j) { const int ks = 64 * kh + 8 * (kb) + j, p = ks >> 2, c = 2 * (ks & 3) + hh; \
        const bf16x8 a = *(const LAS bf16x8*)(WIN + (16 * r + p) * 128 + (((c + r + (p >> 4)) & 7) << 4)); acc = MFMA32(a, B[j], acc); } }
    C3_LD(B0, 0);
    f32x16 acc;
#pragma unroll
    for (int i = 0; i < 16; ++i) acc[i] = 0.f;
    __syncthreads();
#pragma unroll 1
    for (int kb = 0; kb < 8; kb += 2) {
        C3_LD(B1, kb + 1); C3_MM(B0, kb);
        if (kb + 2 < 8) C3_LD(B0, kb + 2);
        C3_MM(B1, kb + 1);
    }
#undef C3_LD
#undef C3_MM
    if (kh == 1) {
#pragma unroll
        for (int i = 0; i < 16; ++i) RED[((i & 3) + 8 * (i >> 2) + 4 * hh) * 132 + 32 * ht + r] = acc[i];
    }
    __syncthreads();
    if (kh == 0) { const float bias = BIAS1[which * 128 + 32 * ht + r];
#pragma unroll
        for (int i = 0; i < 16; ++i) { const int nn = (i & 3) + 8 * (i >> 2) + 4 * hh; H1[nn * GM_P + 32 * ht + r] = (bf16)(pkbf(gelu_tanh(acc[i] + RED[nn * 132 + 32 * ht + r] + bias), 0.f) & 0xffffu); }
    }
    __syncthreads();
    if (w < 2) {
        const int dt = w; const bf16* w2t = W2T + (size_t)which * 64 * 128; bf16* O = which ? VC : KC;
        f32x16 a2;
#pragma unroll
        for (int i = 0; i < 16; ++i) a2[i] = 0.f;
#pragma unroll
        for (int ks = 0; ks < 8; ++ks) { const bf16x8 a = *(const LAS bf16x8*)(H1 + r * GM_P + 16 * ks + 8 * hh); const bf16x8 bv = *(const bf16x8*)(w2t + (size_t)(32 * dt + r) * 128 + 16 * ks + 8 * hh); a2 = MFMA32(a, bv, a2); }
#pragma unroll
        for (int i = 0; i < 16; ++i) { const int n = n0 + (i & 3) + 8 * (i >> 2) + 4 * hh;
            O[((size_t)(b * 2 + g) * NCMP_PAD + n) * 64 + 32 * dt + r] = (n < NCMP) ? (bf16)(pkbf(a2[i], 0.f) & 0xffffu) : (bf16)0; }
    }
    __syncthreads();
}
__device__ __forceinline__ float wave_sum_fast(float v) {
    v += __builtin_bit_cast(float, __builtin_amdgcn_update_dpp(0, __builtin_bit_cast(int, v), 0xB1, 0xf, 0xf, false));
    v += __builtin_bit_cast(float, __builtin_amdgcn_update_dpp(0, __builtin_bit_cast(int, v), 0x4E, 0xf, 0xf, false));
    v += __builtin_bit_cast(float, __builtin_amdgcn_update_dpp(0, __builtin_bit_cast(int, v), 0x141, 0xf, 0xf, false));
    v += __builtin_bit_cast(float, __builtin_amdgcn_update_dpp(0, __builtin_bit_cast(int, v), 0x140, 0xf, 0xf, false));
    { auto sw = __builtin_amdgcn_permlane16_swap(__builtin_bit_cast(unsigned, v), __builtin_bit_cast(unsigned, v), false, false); const unsigned a = sw[0], b = sw[1]; v = __builtin_bit_cast(float, a) + __builtin_bit_cast(float, b); }
    { auto sw = __builtin_amdgcn_permlane32_swap(__builtin_bit_cast(unsigned, v), __builtin_bit_cast(unsigned, v), false, false); const unsigned a = sw[0], b = sw[1]; v = __builtin_bit_cast(float, a) + __builtin_bit_cast(float, b); }
    return v;
}
__device__ __forceinline__ float wave_max_fast(float v) {
    v = fmaxf(v, __builtin_bit_cast(float, __builtin_amdgcn_update_dpp(0, __builtin_bit_cast(int, v), 0xB1, 0xf, 0xf, false)));
    v = fmaxf(v, __builtin_bit_cast(float, __builtin_amdgcn_update_dpp(0, __builtin_bit_cast(int, v), 0x4E, 0xf, 0xf, false)));
    v = fmaxf(v, __builtin_bit_cast(float, __builtin_amdgcn_update_dpp(0, __builtin_bit_cast(int, v), 0x141, 0xf, 0xf, false)));
    v = fmaxf(v, __builtin_bit_cast(float, __builtin_amdgcn_update_dpp(0, __builtin_bit_cast(int, v), 0x140, 0xf, 0xf, false)));
    { auto sw = __builtin_amdgcn_permlane16_swap(__builtin_bit_cast(unsigned, v), __builtin_bit_cast(unsigned, v), false, false); const unsigned a = sw[0], b = sw[1]; v = fmaxf(__builtin_bit_cast(float, a), __builtin_bit_cast(float, b)); }
    { auto sw = __builtin_amdgcn_permlane32_swap(__builtin_bit_cast(unsigned, v), __builtin_bit_cast(unsigned, v), false, false); const unsigned a = sw[0], b = sw[1]; v = fmaxf(__builtin_bit_cast(float, a), __builtin_bit_cast(float, b)); }
    return v;
}
__device__ __forceinline__ void tab_to_fp8(const float* src, unsigned char* dst, float* scl, int nrows, int gw, int NGW, int lane) {
    f32x4 na = {}, nb = {}, nc = {}, nd = {};
    if (gw < nrows) { const f32x4* s = (const f32x4*)(src + (size_t)gw * DM + 16 * lane); na = s[0]; nb = s[1]; nc = s[2]; nd = s[3]; }
    for (int rw = gw; rw < nrows; rw += NGW) {
        const f32x4 a = na, b = nb, c = nc, d = nd;
        if (rw + NGW < nrows) { const f32x4* s = (const f32x4*)(src + (size_t)(rw + NGW) * DM + 16 * lane); na = s[0]; nb = s[1]; nc = s[2]; nd = s[3]; }
        float mx = fmaxf(fmaxf(fmaxf(fabsf(a.x), fabsf(a.y)), fmaxf(fabsf(a.z), fabsf(a.w))), fmaxf(fmaxf(fabsf(b.x), fabsf(b.y)), fmaxf(fabsf(b.z), fabsf(b.w))));
        mx = fmaxf(mx, fmaxf(fmaxf(fmaxf(fabsf(c.x), fabsf(c.y)), fmaxf(fabsf(c.z), fabsf(c.w))), fmaxf(fmaxf(fabsf(d.x), fabsf(d.y)), fmaxf(fabsf(d.z), fabsf(d.w)))));
        mx = fmaxf(wave_max_fast(mx), 1e-30f);
        const float inv = 440.0f / mx;
        v4u o; int p;
        p = __builtin_amdgcn_cvt_pk_fp8_f32(a.x * inv, a.y * inv, 0, false); p = __builtin_amdgcn_cvt_pk_fp8_f32(a.z * inv, a.w * inv, p, true); o.x = (unsigned)p;
        p = __builtin_amdgcn_cvt_pk_fp8_f32(b.x * inv, b.y * inv, 0, false); p = __builtin_amdgcn_cvt_pk_fp8_f32(b.z * inv, b.w * inv, p, true); o.y = (unsigned)p;
        p = __builtin_amdgcn_cvt_pk_fp8_f32(c.x * inv, c.y * inv, 0, false); p = __builtin_amdgcn_cvt_pk_fp8_f32(c.z * inv, c.w * inv, p, true); o.z = (unsigned)p;
        p = __builtin_amdgcn_cvt_pk_fp8_f32(d.x * inv, d.y * inv, 0, false); p = __builtin_amdgcn_cvt_pk_fp8_f32(d.z * inv, d.w * inv, p, true); o.w = (unsigned)p;
        *((v4u*)(dst + (size_t)rw * DM) + lane) = o;
        if (lane == 0) scl[rw] = mx * (1.0f / 440.0f);
    }
}
__device__ __forceinline__ unsigned pack_i8x4(float a, float b, float c, float d) {
    const int qa = (int)__builtin_rintf(a), qb = (int)__builtin_rintf(b), qc = (int)__builtin_rintf(c), qd = (int)__builtin_rintf(d);
    return ((unsigned)qa & 0xffu) | (((unsigned)qb & 0xffu) << 8) | (((unsigned)qc & 0xffu) << 16) | ((unsigned)qd << 24);
}
__device__ __forceinline__ void tab_to_i8(const float* src, unsigned char* dst, float* scl, int nrows, int gw, int NGW, int lane) {
    f32x4 na = {}, nb = {}, nc = {}, nd = {};
    if (gw < nrows) { const f32x4* s = (const f32x4*)(src + (size_t)gw * DM + 16 * lane); na = s[0]; nb = s[1]; nc = s[2]; nd = s[3]; }
    for (int rw = gw; rw < nrows; rw += NGW) {
        const f32x4 a = na, b = nb, c = nc, d = nd;
        if (rw + NGW < nrows) { const f32x4* s = (const f32x4*)(src + (size_t)(rw + NGW) * DM + 16 * lane); na = s[0]; nb = s[1]; nc = s[2]; nd = s[3]; }
        float mx = fmaxf(fmaxf(fmaxf(fabsf(a.x), fabsf(a.y)), fmaxf(fabsf(a.z), fabsf(a.w))), fmaxf(fmaxf(fabsf(b.x), fabsf(b.y)), fmaxf(fabsf(b.z), fabsf(b.w))));
        mx = fmaxf(mx, fmaxf(fmaxf(fmaxf(fabsf(c.x), fabsf(c.y)), fmaxf(fabsf(c.z), fabsf(c.w))), fmaxf(fmaxf(fabsf(d.x), fabsf(d.y)), fmaxf(fabsf(d.z), fabsf(d.w)))));
        mx = fmaxf(wave_max_fast(mx), 1e-30f);
        const float inv = 127.0f / mx;
        v4u o; o.x = pack_i8x4(a.x * inv, a.y * inv, a.z * inv, a.w * inv); o.y = pack_i8x4(b.x * inv, b.y * inv, b.z * inv, b.w * inv);
        o.z = pack_i8x4(c.x * inv, c.y * inv, c.z * inv, c.w * inv); o.w = pack_i8x4(d.x * inv, d.y * inv, d.z * inv, d.w * inv);
        *((v4u*)(dst + (size_t)rw * DM) + lane) = o;
        if (lane == 0) scl[rw] = mx * (1.0f / 127.0f);
    }
}
__device__ __forceinline__ int dot16_i8(const v4u q, const unsigned (&xq)[4]) {
    int a0 = __builtin_amdgcn_sdot4((int)q.x, (int)xq[0], 0, false), a1 = __builtin_amdgcn_sdot4((int)q.y, (int)xq[1], 0, false);
    a0 = __builtin_amdgcn_sdot4((int)q.z, (int)xq[2], a0, false); a1 = __builtin_amdgcn_sdot4((int)q.w, (int)xq[3], a1, false);
    return a0 + a1;
}
__device__ __forceinline__ int pe_reduce8_i(const int (&p)[8], int lane) {
    const bool b3 = lane & 8; int q4[4], q2[2];
#pragma unroll
    for (int i = 0; i < 4; ++i) { auto sw = __builtin_amdgcn_permlane32_swap((unsigned)p[i], (unsigned)p[i + 4], false, false); const unsigned s0_ = sw[0], s1_ = sw[1]; q4[i] = (int)(s0_ + s1_); }
#pragma unroll
    for (int i = 0; i < 2; ++i) { auto sw = __builtin_amdgcn_permlane16_swap((unsigned)q4[i], (unsigned)q4[i + 2], false, false); const unsigned s0_ = sw[0], s1_ = sw[1]; q2[i] = (int)(s0_ + s1_); }
    int s; { const int send = b3 ? q2[0] : q2[1], keep = b3 ? q2[1] : q2[0]; s = keep + __builtin_amdgcn_update_dpp(0, send, 0x140, 0xf, 0xf, false); }
    s += __builtin_amdgcn_update_dpp(0, s, 0x141, 0xf, 0xf, false);
    s += __builtin_amdgcn_update_dpp(0, s, 0xB1, 0xf, 0xf, false);
    s += __builtin_amdgcn_update_dpp(0, s, 0x4E, 0xf, 0xf, false);
    return s;
}
__device__ __forceinline__ void axpy16_fp8_pk(const v4u q, float w, f32x2 (&acc)[8]) {
    const f32x2 w2 = {w, w};
#define AXP_STEP(word, hi, k) { const f32x2 t = __builtin_amdgcn_cvt_pk_f32_fp8(word, hi); acc[k] = __builtin_elementwise_fma(t, w2, acc[k]); asm("" : "+v"(acc[k])); }
    AXP_STEP(q.x, false, 0) AXP_STEP(q.x, true, 1) AXP_STEP(q.y, false, 2) AXP_STEP(q.y, true, 3) AXP_STEP(q.z, false, 4) AXP_STEP(q.z, true, 5) AXP_STEP(q.w, false, 6) AXP_STEP(q.w, true, 7)
#undef AXP_STEP
}
__device__ __forceinline__ float dot16_fp8(const v4u q, const float (&x)[16]) {
    float a0 = 0.f, a1 = 0.f;
#define DT_STEP(word, hi, k0) { const f32x2 t = __builtin_amdgcn_cvt_pk_f32_fp8(word, hi); a0 = __builtin_fmaf(t.x, x[k0], a0); a1 = __builtin_fmaf(t.y, x[(k0) + 1], a1); asm("" : "+v"(a0), "+v"(a1)); }
    DT_STEP(q.x, false, 0) DT_STEP(q.x, true, 2) DT_STEP(q.y, false, 4) DT_STEP(q.y, true, 6) DT_STEP(q.z, false, 8) DT_STEP(q.z, true, 10) DT_STEP(q.w, false, 12) DT_STEP(q.w, true, 14)
#undef DT_STEP
    return a0 + a1;
}
__device__ __forceinline__ void axpy16_fp8(const v4u q, float w, float (&acc)[16]) {
#define AX_STEP(word, hi, k0) { const f32x2 t = __builtin_amdgcn_cvt_pk_f32_fp8(word, hi); acc[k0] = __builtin_fmaf(t.x, w, acc[k0]); acc[(k0) + 1] = __builtin_fmaf(t.y, w, acc[(k0) + 1]); asm("" : "+v"(acc[k0]), "+v"(acc[(k0) + 1])); }
    AX_STEP(q.x, false, 0) AX_STEP(q.x, true, 2) AX_STEP(q.y, false, 4) AX_STEP(q.y, true, 6) AX_STEP(q.z, false, 8) AX_STEP(q.z, true, 10) AX_STEP(q.w, false, 12) AX_STEP(q.w, true, 14)
#undef AX_STEP
}
#ifndef PE_RED_MODE
#define PE_RED_MODE 3
#endif
__device__ __forceinline__ float pe_reduce8(const float (&p)[8], int lane) {
#if PE_RED_MODE == 0
    const bool b5 = lane & 32, b4 = lane & 16, b3 = lane & 8; float q[4], r[2];
#pragma unroll
    for (int i = 0; i < 4; ++i) { const float send = b5 ? p[i] : p[i + 4], keep = b5 ? p[i + 4] : p[i]; q[i] = keep + __shfl_xor(send, 32); }
#pragma unroll
    for (int i = 0; i < 2; ++i) { const float send = b4 ? q[i] : q[i + 2], keep = b4 ? q[i + 2] : q[i]; r[i] = keep + __shfl_xor(send, 16); }
    float s; { const float send = b3 ? r[0] : r[1], keep = b3 ? r[1] : r[0]; s = keep + __shfl_xor(send, 8); }
    s += __shfl_xor(s, 4); s += __shfl_xor(s, 2); s += __shfl_xor(s, 1);
    return s;
#else
    const bool b4 = lane & 16, b3 = lane & 8; float q4[4], q2[2];
#pragma unroll
    for (int i = 0; i < 4; ++i) { auto sw = __builtin_amdgcn_permlane32_swap(__builtin_bit_cast(unsigned, p[i]), __builtin_bit_cast(unsigned, p[i + 4]), false, false); const unsigned s0_ = sw[0], s1_ = sw[1]; q4[i] = __builtin_bit_cast(float, s0_) + __builtin_bit_cast(float, s1_); }
#if PE_RED_MODE == 1
#pragma unroll
    for (int i = 0; i < 2; ++i) { const float send = b4 ? q4[i] : q4[i + 2], keep = b4 ? q4[i + 2] : q4[i]; q2[i] = keep + __shfl_xor(send, 16); }
    float s; { const float send = b3 ? q2[0] : q2[1], keep = b3 ? q2[1] : q2[0]; s = keep + __shfl_xor(send, 8); }
    s += __shfl_xor(s, 4); s += __shfl_xor(s, 2); s += __shfl_xor(s, 1);
    return s;
#else
#pragma unroll
    for (int i = 0; i < 2; ++i) { auto sw = __builtin_amdgcn_permlane16_swap(__builtin_bit_cast(unsigned, q4[i]), __builtin_bit_cast(unsigned, q4[i + 2]), false, false); const unsigned s0_ = sw[0], s1_ = sw[1]; q2[i] = __builtin_bit_cast(float, s0_) + __builtin_bit_cast(float, s1_); }
#if PE_RED_MODE == 2
    float s; { const float send = b3 ? q2[0] : q2[1], keep = b3 ? q2[1] : q2[0]; s = keep + __shfl_xor(send, 8); }
    s += __shfl_xor(s, 4); s += __shfl_xor(s, 2); s += __shfl_xor(s, 1);
    return s;
#else
    float s; { const float send = b3 ? q2[0] : q2[1], keep = b3 ? q2[1] : q2[0]; s = keep + __builtin_bit_cast(float, __builtin_amdgcn_update_dpp(0, __builtin_bit_cast(int, send), 0x140, 0xf, 0xf, false)); }
    s += __builtin_bit_cast(float, __builtin_amdgcn_update_dpp(0, __builtin_bit_cast(int, s), 0x141, 0xf, 0xf, false));
    s += __builtin_bit_cast(float, __builtin_amdgcn_update_dpp(0, __builtin_bit_cast(int, s), 0xB1, 0xf, 0xf, false));
    s += __builtin_bit_cast(float, __builtin_amdgcn_update_dpp(0, __builtin_bit_cast(int, s), 0x4E, 0xf, 0xf, false));
    return s;
#endif
#endif
#endif
}
__device__ __forceinline__ float dot16_fp8_bf(const v4u q, const unsigned (&xp)[8]) {
    float a0 = 0.f, a1 = 0.f;
#define DB_STEP(word, hi, k0) { a0 = __builtin_amdgcn_fdot2_f32_bf16(__builtin_amdgcn_cvt_scalef32_pk_bf16_fp8(word, 1.0f, hi), __builtin_bit_cast(bf16x2_t, xp[k0]), a0, false); }
#define DB_STEP1(word, hi, k0) { a1 = __builtin_amdgcn_fdot2_f32_bf16(__builtin_amdgcn_cvt_scalef32_pk_bf16_fp8(word, 1.0f, hi), __builtin_bit_cast(bf16x2_t, xp[k0]), a1, false); }
    DB_STEP(q.x, false, 0) DB_STEP1(q.x, true, 1) DB_STEP(q.y, false, 2) DB_STEP1(q.y, true, 3) DB_STEP(q.z, false, 4) DB_STEP1(q.z, true, 5) DB_STEP(q.w, false, 6) DB_STEP1(q.w, true, 7)
#undef DB_STEP
#undef DB_STEP1
    return a0 + a1;
}
__device__ __forceinline__ void peer_eval_wave(int tok, const bf16* XN, bf16* XNO, const unsigned char* TU, const unsigned char* TV, const float* SU, const float* SV, const int* EXPI, const float* GATEI,
                                               const float* xres, float* xout, const float* nw_bf, const float* nw_f, LAS float* WL, int lane, int exmask = 0x3FFF) {
    float x[16];
    {   const v4u* xr = (const v4u*)(XN + (size_t)tok * DM + 16 * lane); const v4u x0 = xr[0], x1 = xr[1];
        x[0] = bflo(x0.x); x[1] = bfhi(x0.x); x[2] = bflo(x0.y); x[3] = bfhi(x0.y); x[4] = bflo(x0.z); x[5] = bfhi(x0.z); x[6] = bflo(x0.w); x[7] = bfhi(x0.w);
        x[8] = bflo(x1.x); x[9] = bfhi(x1.x); x[10] = bflo(x1.y); x[11] = bfhi(x1.y); x[12] = bflo(x1.z); x[13] = bfhi(x1.z); x[14] = bflo(x1.w); x[15] = bfhi(x1.w); }
    int exA = EXPI[(size_t)tok * 128 + lane] & exmask, exB = EXPI[(size_t)tok * 128 + 64 + lane] & exmask;
    float gA = GATEI[(size_t)tok * 128 + lane] * SV[exA], gB = GATEI[(size_t)tok * 128 + 64 + lane] * SV[exB];
    float suA = SU[exA], suB = SU[exB];
#if PEER_SORT
    {
        const int kA = exA * 128 + lane, kB = exB * 128 + 64 + lane; int rA = 0, rB = 0;
#pragma unroll 4
        for (int j = 0; j < 64; ++j) { const int a = __builtin_amdgcn_readlane(kA, j), b = __builtin_amdgcn_readlane(kB, j); rA += (a < kA) + (b < kA); rB += (a < kB) + (b < kB); }
        LAS int* SI = (LAS int*)(WL + 128); LAS float* SG = WL + 256; LAS float* SS = WL + 384;
        SI[rA] = exA; SI[rB] = exB; SG[rA] = gA; SG[rB] = gB; SS[rA] = suA; SS[rB] = suB;
        LDS_WAIT();
        exA = SI[lane]; exB = SI[64 + lane]; gA = SG[lane]; gB = SG[64 + lane]; suA = SS[lane]; suB = SS[64 + lane];
    }
#endif
#define PE_LOAD(buf, T, gi_) do { const int exv_ = (gi_) < 8 ? exA : exB; _Pragma("unroll") for (int j = 0; j < 8; ++j) { const int ex_ = __builtin_amdgcn_readlane(exv_, (((gi_) * 8 + j) & 63)); buf[j] = *((const v4u*)((T) + (size_t)ex_ * DM) + lane); } } while (0)
#define PE_DPPADD(v, ctrl) ((v) + __builtin_bit_cast(float, __builtin_amdgcn_update_dpp(0, __builtin_bit_cast(int, (v)), (ctrl), 0xf, 0xf, false)))
#define PE_DOTS(buf, gi_) do { float p[8]; _Pragma("unroll") for (int j = 0; j < 8; ++j) p[j] = dot16_fp8(buf[j], x); \
        float s_ = pe_reduce8(p, lane); \
        const int el_ = (((gi_) * 8) & 63) + (lane >> 3); \
        const float su_ = __shfl((gi_) < 8 ? suA : suB, el_), gt_ = __shfl((gi_) < 8 ? gA : gB, el_); \
        if ((lane & 7) == 0) WL[(gi_) * 8 + (lane >> 3)] = gt_ * gelu_tanh(s_ * su_); } while (0)
    {
        v4u ua[8], ub[8];
        PE_LOAD(ua, TU, 0);
#pragma unroll 1
        for (int gi = 0; gi < 16; gi += 2) {
            PE_LOAD(ub, TU, gi + 1);
            PE_DOTS(ua, gi);
            if (gi + 2 < 16) PE_LOAD(ua, TU, gi + 2);
            PE_DOTS(ub, gi + 1);
        }
    }
    LDS_WAIT();
    float acc[16];
#pragma unroll
    for (int i = 0; i < 16; ++i) acc[i] = 0.f;
#define PE_AXPY(buf, gi_) do { _Pragma("unroll") for (int j = 0; j < 8; ++j) axpy16_fp8(buf[j], WL[(gi_) * 8 + j], acc); } while (0)
    {
        v4u va[8], vb[8];
        PE_LOAD(va, TV, 0);
#pragma unroll 1
        for (int gi = 0; gi < 16; gi += 2) {
            PE_LOAD(vb, TV, gi + 1);
            PE_AXPY(va, gi);
            if (gi + 2 < 16) PE_LOAD(va, TV, gi + 2);
            PE_AXPY(vb, gi + 1);
        }
    }
#undef PE_LOAD
#undef PE_DOTS
#undef PE_AXPY
#undef PE_DPPADD
    const float* xrow = xres + (size_t)tok * DM + 16 * lane; float* orow = xout + (size_t)tok * DM + 16 * lane; f32x4 y[4]; float ss = 0.f;
#pragma unroll
    for (int c = 0; c < 4; ++c) { f32x4 rr = *(const f32x4*)(xrow + 4 * c); rr.x += acc[4 * c]; rr.y += acc[4 * c + 1]; rr.z += acc[4 * c + 2]; rr.w += acc[4 * c + 3]; y[c] = rr; ss += (rr.x * rr.x + rr.y * rr.y) + (rr.z * rr.z + rr.w * rr.w); }
    const float rn = 1.0f / sqrtf(wave_sum(ss) * (1.0f / DM) + EPS);
    if (nw_f) {
#pragma unroll
        for (int c = 0; c < 4; ++c) { const f32x4 wv = *(const f32x4*)(nw_f + 16 * lane + 4 * c); *(f32x4*)(orow + 4 * c) = y[c] * rn * wv; }
    } else {
#pragma unroll
        for (int c = 0; c < 4; ++c) *(f32x4*)(orow + 4 * c) = y[c];
    }
    if (nw_bf) {
        f32x4 z[4];
#pragma unroll
        for (int c = 0; c < 4; ++c) { const f32x4 wv = *(const f32x4*)(nw_bf + 16 * lane + 4 * c); z[c] = y[c] * rn * wv; }
        v4u o0, o1; o0.x = pkbf(z[0].x, z[0].y); o0.y = pkbf(z[0].z, z[0].w); o0.z = pkbf(z[1].x, z[1].y); o0.w = pkbf(z[1].z, z[1].w);
        o1.x = pkbf(z[2].x, z[2].y); o1.y = pkbf(z[2].z, z[2].w); o1.z = pkbf(z[3].x, z[3].y); o1.w = pkbf(z[3].z, z[3].w);
        v4u* xo = (v4u*)(XNO + (size_t)tok * DM + 16 * lane); xo[0] = o0; xo[1] = o1;
    }
    LDS_WAIT();
}
#ifndef PEER_PT
#define PEER_PT 4
#endif
#ifndef PEER_BUCKET
#define PEER_BUCKET 1
#endif
constexpr int PT = PEER_PT;
constexpr int PE4_LDS = PT * 512 * 4;
__device__ __forceinline__ void peer_eval4m_wave(int tok0, const bf16* XN, bf16* XNO, const unsigned char* TU, const unsigned char* TV, const float* SU, const float* SV, const int* EXPI, const float* GATEI,
                                                 const float* xres, float* xout, const float* nw_bf, const float* nw_f, LAS float* W4, int lane, const float* rsx = nullptr, const float* nwx = nullptr, bool wgsync = false, const XcdBarrier& xbr = XcdBarrier()) {
    unsigned x[PT][8];
#pragma unroll
    for (int tl = 0; tl < PT; ++tl) { const v4u* xr = (const v4u*)(XN + (size_t)(tok0 + tl) * DM + 16 * lane); const v4u x0 = xr[0], x1 = xr[1];
        x[tl][0] = x0.x; x[tl][1] = x0.y; x[tl][2] = x0.z; x[tl][3] = x0.w; x[tl][4] = x1.x; x[tl][5] = x1.y; x[tl][6] = x1.z; x[tl][7] = x1.w; }
    {
        int a_[PT], b_[PT]; float ga_[PT], gb_[PT], sa_[PT], sb_[PT];
#pragma unroll
        for (int tl = 0; tl < PT; ++tl) { const size_t eb = (size_t)(tok0 + tl) * 128; a_[tl] = EXPI[eb + lane]; b_[tl] = EXPI[eb + 64 + lane]; ga_[tl] = GATEI[eb + lane]; gb_[tl] = GATEI[eb + 64 + lane]; }
#pragma unroll
        for (int tl = 0; tl < PT; ++tl) { ga_[tl] *= SV[a_[tl]]; gb_[tl] *= SV[b_[tl]]; sa_[tl] = SU[a_[tl]]; sb_[tl] = SU[b_[tl]]; }
#pragma unroll
        for (int tl = 0; tl < PT; ++tl) ((LAS int*)(W4 + tl * 512))[lane] = 0;
        int ra_[PT], rb_[PT], c_[PT], incl[PT];
#pragma unroll
        for (int tl = 0; tl < PT; ++tl) { LAS int* HI = (LAS int*)(W4 + tl * 512);
            ra_[tl] = __hip_atomic_fetch_add(HI + (a_[tl] >> 8), 1, __ATOMIC_RELAXED, __HIP_MEMORY_SCOPE_WORKGROUP); rb_[tl] = __hip_atomic_fetch_add(HI + (b_[tl] >> 8), 1, __ATOMIC_RELAXED, __HIP_MEMORY_SCOPE_WORKGROUP); }
#pragma unroll
        for (int tl = 0; tl < PT; ++tl) { c_[tl] = ((LAS int*)(W4 + tl * 512))[lane]; incl[tl] = c_[tl]; }
#pragma unroll
        for (int tl = 0; tl < PT; ++tl) { int v = incl[tl];
            v += __builtin_amdgcn_update_dpp(0, v, 0x111, 0xf, 0xf, true);
            v += __builtin_amdgcn_update_dpp(0, v, 0x112, 0xf, 0xf, true);
            v += __builtin_amdgcn_update_dpp(0, v, 0x114, 0xf, 0xf, true);
            v += __builtin_amdgcn_update_dpp(0, v, 0x118, 0xf, 0xf, true);
            v += __builtin_amdgcn_update_dpp(0, v, 0x142, 0xa, 0xf, false);
            v += __builtin_amdgcn_update_dpp(0, v, 0x143, 0xc, 0xf, false);
            incl[tl] = v; }
#pragma unroll
        for (int tl = 0; tl < PT; ++tl) ((LAS int*)(W4 + tl * 512))[64 + lane] = incl[tl] - c_[tl];
        int rA[PT], rB[PT];
#pragma unroll
        for (int tl = 0; tl < PT; ++tl) { LAS int* HI = (LAS int*)(W4 + tl * 512); rA[tl] = HI[64 + (a_[tl] >> 8)] + ra_[tl]; rB[tl] = HI[64 + (b_[tl] >> 8)] + rb_[tl]; }
#pragma unroll
        for (int tl = 0; tl < PT; ++tl) { LAS float* WLt = W4 + tl * 512; LAS int* SI = (LAS int*)(WLt + 128); LAS float* SG = WLt + 256; LAS float* SS = WLt + 384;
            SI[rA[tl]] = a_[tl]; SI[rB[tl]] = b_[tl]; SG[rA[tl]] = ga_[tl]; SG[rB[tl]] = gb_[tl]; SS[rA[tl]] = sa_[tl]; SS[rB[tl]] = sb_[tl]; }
    }
    LDS_WAIT();
#if PEER_BUFLD
    const __amdgpu_buffer_rsrc_t PE_RS_TU = __builtin_amdgcn_make_buffer_rsrc((void*)TU, 0, NEXP * DM, 0x00020000);
    const __amdgpu_buffer_rsrc_t PE_RS_TV = __builtin_amdgcn_make_buffer_rsrc((void*)TV, 0, NEXP * DM, 0x00020000);
    const int pe_vo_ = lane * 16;
#define PE_LOAD(buf, T, tl_, gi_) do { const LAS int* si_ = (const LAS int*)(W4 + (tl_) * 512 + 128) + (gi_) * 8; _Pragma("unroll") for (int j = 0; j < 8; ++j) { const int ex_ = __builtin_amdgcn_readfirstlane(si_[j]); \
        buf[j] = __builtin_bit_cast(v4u, __builtin_amdgcn_raw_buffer_load_b128(PE_RS_##T, pe_vo_, ex_ * DM, 0)); } } while (0)
#else
#define PE_LOAD(buf, T, tl_, gi_) do { const LAS int* si_ = (const LAS int*)(W4 + (tl_) * 512 + 128) + (gi_) * 8; _Pragma("unroll") for (int j = 0; j < 8; ++j) { const int ex_ = __builtin_amdgcn_readfirstlane(si_[j]); buf[j] = *((const v4u*)((T) + (size_t)ex_ * DM) + lane); } } while (0)
#endif
    {
        if (rsx) {
            float wn[16];
#pragma unroll
            for (int c = 0; c < 4; ++c) { const f32x4 wv = *(const f32x4*)(nwx + 16 * lane + 4 * c); wn[4 * c] = wv.x; wn[4 * c + 1] = wv.y; wn[4 * c + 2] = wv.z; wn[4 * c + 3] = wv.w; }
#pragma unroll
            for (int tl = 0; tl < PT; ++tl) { const f32x4* rp = (const f32x4*)(rsx + (size_t)(tok0 + tl) * 16); const f32x4 t0 = rp[0], t1 = rp[1], t2 = rp[2], t3 = rp[3];
                const float tot = (((t0[0] + t0[1]) + (t0[2] + t0[3])) + ((t1[0] + t1[1]) + (t1[2] + t1[3]))) + (((t2[0] + t2[1]) + (t2[2] + t2[3])) + ((t3[0] + t3[1]) + (t3[2] + t3[3])));
                const float rr = 1.0f / sqrtf(tot * (1.0f / DM) + EPS);
#pragma unroll
                for (int k = 0; k < 8; ++k) x[tl][k] = pkbf(bflo(x[tl][k]) * rr * wn[2 * k], bfhi(x[tl][k]) * rr * wn[2 * k + 1]); }
        }
#if PEER_I8
        unsigned xq[PT][4]; float sx[PT];
#pragma unroll
        for (int tl = 0; tl < PT; ++tl) {
            float v[16]; float mx = 0.f;
#pragma unroll
            for (int k = 0; k < 8; ++k) { v[2 * k] = bflo(x[tl][k]); v[2 * k + 1] = bfhi(x[tl][k]); mx = fmaxf(mx, fmaxf(fabsf(v[2 * k]), fabsf(v[2 * k + 1]))); }
            mx = fmaxf(wave_max_fast(mx), 1e-30f);
            const float inv = 127.0f / mx; sx[tl] = mx * (1.0f / 127.0f);
#pragma unroll
            for (int k = 0; k < 4; ++k) xq[tl][k] = pack_i8x4(v[4 * k] * inv, v[4 * k + 1] * inv, v[4 * k + 2] * inv, v[4 * k + 3] * inv);
        }
#define PE_DOTS(buf, tl_, gi_) do { int p[8]; _Pragma("unroll") for (int j = 0; j < 8; ++j) p[j] = dot16_i8(buf[j], xq[tl_]); \
        const float s_ = (float)pe_reduce8_i(p, lane); const int el_ = (gi_) * 8 + (lane >> 3); \
        const float su_ = W4[(tl_) * 512 + 384 + el_] * sx[tl_], gt_ = W4[(tl_) * 512 + 256 + el_]; \
        if ((lane & 7) == 0) W4[(tl_) * 512 + el_] = gt_ * gelu_tanh(s_ * su_); } while (0)
#else
#define PE_DOTS(buf, tl_, gi_) do { float p[8]; _Pragma("unroll") for (int j = 0; j < 8; ++j) { p[j] = dot16_fp8_bf(buf[j], x[tl_]); if (j & 1) __builtin_amdgcn_sched_barrier(0); } \
        const float s_ = pe_reduce8(p, lane); const int el_ = (gi_) * 8 + (lane >> 3); \
        const float su_ = W4[(tl_) * 512 + 384 + el_], gt_ = W4[(tl_) * 512 + 256 + el_]; \
        if ((lane & 7) == 0) W4[(tl_) * 512 + el_] = gt_ * gelu_tanh(s_ * su_); } while (0)
#endif
#if PEER_RING4
        v4u ur[PT][8];
#pragma unroll
        for (int tl = 0; tl < PT; ++tl) PE_LOAD(ur[tl], TU, tl, 0);
#pragma unroll 1
        for (int gi = 0; gi < 16; ++gi) {
#pragma unroll
            for (int tl = 0; tl < PT; ++tl) { PE_DOTS(ur[tl], tl, gi); if (gi + 1 < 16) PE_LOAD(ur[tl], TU, tl, gi + 1); }
        }
#else
        v4u ua[8], ub[8];
        PE_LOAD(ua, TU, 0, 0);
#pragma unroll 1
        for (int gi = 0; gi < 16; ++gi) {
#if PEER_ALIGN_IN
            if (wgsync && (gi & (PEER_ALIGN_IN - 1)) == 0 && gi) { if (PEER_ALIGN_XIN) xcd_align(xbr); else __syncthreads(); }
#endif
            PE_LOAD(ub, TU, 1, gi);
            PE_DOTS(ua, 0, gi);
            if (PT == 4) { PE_LOAD(ua, TU, 2, gi); PE_DOTS(ub, 1, gi); PE_LOAD(ub, TU, 3, gi); PE_DOTS(ua, 2, gi); }
            if (gi + 1 < 16) PE_LOAD(ua, TU, 0, gi + 1);
            PE_DOTS(ub, PT - 1, gi);
        }
#endif
#undef PE_DOTS
    }
    LDS_WAIT();
    __builtin_amdgcn_sched_barrier(0);
#if RESID_BF16 && PEER_XPF
    v4u xpf[PT][2];
#pragma unroll
    for (int tl = 0; tl < PT; ++tl) { const v4u* xb = (const v4u*)((const bf16*)xres + (size_t)(tok0 + tl) * DM + 16 * lane); xpf[tl][0] = xb[0]; xpf[tl][1] = xb[1]; }
#endif
#if PEER_PKFMA
    f32x2 acc2[PT][8];
#pragma unroll
    for (int tl = 0; tl < PT; ++tl)
#pragma unroll
        for (int k = 0; k < 8; ++k) acc2[tl][k] = (f32x2){0.f, 0.f};
#define PE_AXPY(buf, tl_, gi_) do { _Pragma("unroll") for (int j = 0; j < 8; ++j) { axpy16_fp8_pk(buf[j], W4[(tl_) * 512 + (gi_) * 8 + j], acc2[tl_]); if (j & 1) __builtin_amdgcn_sched_barrier(0); } } while (0)
#define PE_ACC(tl_, i_) acc2[tl_][(i_) >> 1][(i_) & 1]
#else
    float acc[PT][16];
#pragma unroll
    for (int tl = 0; tl < PT; ++tl)
#pragma unroll
        for (int k = 0; k < 16; ++k) acc[tl][k] = 0.f;
#define PE_AXPY(buf, tl_, gi_) do { _Pragma("unroll") for (int j = 0; j < 8; ++j) { axpy16_fp8(buf[j], W4[(tl_) * 512 + (gi_) * 8 + j], acc[tl_]); if (j & 1) __builtin_amdgcn_sched_barrier(0); } } while (0)
#define PE_ACC(tl_, i_) acc[tl_][i_]
#endif
    {
#if PEER_RING4
        v4u vr[PT][8];
#pragma unroll
        for (int tl = 0; tl < PT; ++tl) PE_LOAD(vr[tl], TV, tl, 0);
#pragma unroll 1
        for (int gi = 0; gi < 16; ++gi) {
#pragma unroll
            for (int tl = 0; tl < PT; ++tl) { PE_AXPY(vr[tl], tl, gi); if (gi + 1 < 16) PE_LOAD(vr[tl], TV, tl, gi + 1); }
        }
#else
        v4u va[8], vb[8];
        PE_LOAD(va, TV, 0, 0);
        if (wgsync) __syncthreads();
#pragma unroll 1
        for (int gi = 0; gi < 16; ++gi) {
#if PEER_ALIGN_IN
            if (wgsync && (gi & (PEER_ALIGN_IN - 1)) == 0 && gi) { if (PEER_ALIGN_XIN) xcd_align(xbr); else __syncthreads(); }
#endif
            PE_LOAD(vb, TV, 1, gi);
            PE_AXPY(va, 0, gi);
            if (PT == 4) { PE_LOAD(va, TV, 2, gi); PE_AXPY(vb, 1, gi); PE_LOAD(vb, TV, 3, gi); PE_AXPY(va, 2, gi); }
            if (gi + 1 < 16) PE_LOAD(va, TV, 0, gi + 1);
            PE_AXPY(vb, PT - 1, gi);
        }
#endif
    }
#undef PE_AXPY
#undef PE_LOAD
#pragma unroll
    for (int tl = 0; tl < PT; ++tl) {
        asm volatile("" ::: "memory"); __builtin_amdgcn_sched_barrier(0);
        const float* xrow = xres + (size_t)(tok0 + tl) * DM + 16 * lane; float* orow = xout + (size_t)(tok0 + tl) * DM + 16 * lane; f32x4 y[4]; float ss = 0.f;
#if RESID_BF16
        {
#if PEER_XPF
            const v4u b0 = xpf[tl][0], b1 = xpf[tl][1];
#else
            const v4u* xb = (const v4u*)((const bf16*)xres + (size_t)(tok0 + tl) * DM + 16 * lane); const v4u b0 = xb[0], b1 = xb[1];
#endif
            y[0] = (f32x4){bflo(b0.x), bfhi(b0.x), bflo(b0.y), bfhi(b0.y)}; y[1] = (f32x4){bflo(b0.z), bfhi(b0.z), bflo(b0.w), bfhi(b0.w)};
            y[2] = (f32x4){bflo(b1.x), bfhi(b1.x), bflo(b1.y), bfhi(b1.y)}; y[3] = (f32x4){bflo(b1.z), bfhi(b1.z), bflo(b1.w), bfhi(b1.w)};
#pragma unroll
            for (int c = 0; c < 4; ++c) { f32x4 rr = y[c]; rr.x += PE_ACC(tl, 4 * c); rr.y += PE_ACC(tl, 4 * c + 1); rr.z += PE_ACC(tl, 4 * c + 2); rr.w += PE_ACC(tl, 4 * c + 3); y[c] = rr; ss += (rr.x * rr.x + rr.y * rr.y) + (rr.z * rr.z + rr.w * rr.w); }
        }
#else
#pragma unroll
        for (int c = 0; c < 4; ++c) { f32x4 rr = *(const f32x4*)(xrow + 4 * c); rr.x += PE_ACC(tl, 4 * c); rr.y += PE_ACC(tl, 4 * c + 1); rr.z += PE_ACC(tl, 4 * c + 2); rr.w += PE_ACC(tl, 4 * c + 3); y[c] = rr; ss += (rr.x * rr.x + rr.y * rr.y) + (rr.z * rr.z + rr.w * rr.w); }
#endif
        const float rn = 1.0f / sqrtf(wave_sum_fast(ss) * (1.0f / DM) + EPS);
        if (nw_f) {
#pragma unroll
            for (int c = 0; c < 4; ++c) { const f32x4 wv = *(const f32x4*)(nw_f + 16 * lane + 4 * c); *(f32x4*)(orow + 4 * c) = y[c] * rn * wv; }
        } else {
#if RESID_BF16
            v4u r0, r1; r0.x = pkbf(y[0].x, y[0].y); r0.y = pkbf(y[0].z, y[0].w); r0.z = pkbf(y[1].x, y[1].y); r0.w = pkbf(y[1].z, y[1].w);
            r1.x = pkbf(y[2].x, y[2].y); r1.y = pkbf(y[2].z, y[2].w); r1.z = pkbf(y[3].x, y[3].y); r1.w = pkbf(y[3].z, y[3].w);
            v4u* xo_ = (v4u*)((bf16*)xout + (size_t)(tok0 + tl) * DM + 16 * lane); xo_[0] = r0; xo_[1] = r1;
#else
#pragma unroll
            for (int c = 0; c < 4; ++c) *(f32x4*)(orow + 4 * c) = y[c];
#endif
        }
        if (nw_bf) {
            f32x4 z[4];
#pragma unroll
            for (int c = 0; c < 4; ++c) { const f32x4 wv = *(const f32x4*)(nw_bf + 16 * lane + 4 * c); z[c] = y[c] * rn * wv; }
            v4u o0, o1; o0.x = pkbf(z[0].x, z[0].y); o0.y = pkbf(z[0].z, z[0].w); o0.z = pkbf(z[1].x, z[1].y); o0.w = pkbf(z[1].z, z[1].w);
            o1.x = pkbf(z[2].x, z[2].y); o1.y = pkbf(z[2].z, z[2].w); o1.z = pkbf(z[3].x, z[3].y); o1.w = pkbf(z[3].z, z[3].w);
            v4u* xo = (v4u*)(XNO + (size_t)(tok0 + tl) * DM + 16 * lane); xo[0] = o0; xo[1] = o1;
        }
    }
#undef PE_ACC
    LDS_WAIT();
}
constexpr int PE4C_LDS = (4 * 512 + 80 + 192) * 4;
__device__ __forceinline__ void peer_eval4c_wave(int tok0, const bf16* XN, bf16* XNO, const unsigned char* TU, const unsigned char* TV, const float* SU, const float* SV, const int* EXPI, const float* GATEI,
                                                 const float* xres, float* xout, const float* nw_bf, const float* nw_f, LAS float* W4, int lane) {
    LAS int* CS = (LAS int*)(W4 + 2048); LAS int* BL = CS + 80;
#pragma unroll 1
    for (int tl = 0; tl < 4; ++tl) {
        const size_t eb = (size_t)(tok0 + tl) * 128;
        const int a = EXPI[eb + lane], b = EXPI[eb + 64 + lane];
        const float ga = GATEI[eb + lane] * SV[a], gb = GATEI[eb + 64 + lane] * SV[b], sa = SU[a], sb = SU[b];
        const int kA = a * 128 + lane, kB = b * 128 + 64 + lane; int rA = 0, rB = 0, cnt = 0;
#pragma unroll 4
        for (int j = 0; j < 64; ++j) { const int p_ = __builtin_amdgcn_readlane(kA, j), q_ = __builtin_amdgcn_readlane(kB, j); rA += (p_ < kA) + (q_ < kA); rB += (p_ < kB) + (q_ < kB);
            cnt += ((p_ >> 7) < 1024 * lane) + ((q_ >> 7) < 1024 * lane); }
        LAS float* WLt = W4 + tl * 512; LAS int* SI = (LAS int*)(WLt + 128); LAS float* SG = WLt + 256; LAS float* SS = WLt + 384;
        SI[rA] = a; SI[rB] = b; SG[rA] = ga; SG[rB] = gb; SS[rA] = sa; SS[rB] = sb;
        if (lane <= 16) CS[tl * 20 + lane] = cnt;
    }
    LDS_WAIT();
    int nb;
    {   const int c = lane >> 2, tl = lane & 3, lo = CS[tl * 20 + c], hi = CS[tl * 20 + c + 1], n = hi - lo, nbt = (n + 7) >> 3;
        int incl = nbt;
#pragma unroll
        for (int o = 1; o < 64; o <<= 1) { const int t = __shfl_up(incl, o); if (lane >= o) incl += t; }
        const int base = incl - nbt;
        for (int q = 0; q < nbt; ++q) BL[base + q] = tl | ((lo + 8 * q) << 2) | (min(8, n - 8 * q) << 9);
        nb = __builtin_amdgcn_readlane(incl, 63);
    }
    LDS_WAIT();
#define PC_LOAD(buf, be, T, k_) do { be = __builtin_amdgcn_readfirstlane(BL[(k_)]); const int tl_ = be & 3, st_ = (be >> 2) & 127, n_ = be >> 9; const LAS int* si_ = (const LAS int*)(W4 + tl_ * 512 + 128) + st_; \
        _Pragma("unroll") for (int j = 0; j < 8; ++j) { const int ex_ = __builtin_amdgcn_readfirstlane(si_[j < n_ ? j : n_ - 1]); buf[j] = *((const v4u*)((T) + (size_t)ex_ * DM) + lane); } } while (0)
    {
        float x[4][16];
#pragma unroll
        for (int tl = 0; tl < 4; ++tl) { const v4u* xr = (const v4u*)(XN + (size_t)(tok0 + tl) * DM + 16 * lane); const v4u x0 = xr[0], x1 = xr[1];
            x[tl][0] = bflo(x0.x); x[tl][1] = bfhi(x0.x); x[tl][2] = bflo(x0.y); x[tl][3] = bfhi(x0.y); x[tl][4] = bflo(x0.z); x[tl][5] = bfhi(x0.z); x[tl][6] = bflo(x0.w); x[tl][7] = bfhi(x0.w);
            x[tl][8] = bflo(x1.x); x[tl][9] = bfhi(x1.x); x[tl][10] = bflo(x1.y); x[tl][11] = bfhi(x1.y); x[tl][12] = bflo(x1.z); x[tl][13] = bfhi(x1.z); x[tl][14] = bflo(x1.w); x[tl][15] = bfhi(x1.w); }
#define PC_DOT8(buf, n_, xx) do { asm volatile("" ::: "memory"); _Pragma("unroll") for (int j = 0; j < 8; ++j) { if (j < n_) p[j] = dot16_fp8(buf[j], xx); } } while (0)
#define PC_DOTS(buf, be) do { float p[8]; _Pragma("unroll") for (int j = 0; j < 8; ++j) p[j] = 0.f; const int tl_ = be & 3, st_ = (be >> 2) & 127, n_ = be >> 9; \
        if (tl_ == 0) PC_DOT8(buf, n_, x[0]); else if (tl_ == 1) PC_DOT8(buf, n_, x[1]); else if (tl_ == 2) PC_DOT8(buf, n_, x[2]); else PC_DOT8(buf, n_, x[3]); \
        const float s_ = pe_reduce8(p, lane); const int e_ = (lane >> 3); LAS float* wl_ = W4 + tl_ * 512; \
        if ((lane & 7) == 0 && e_ < n_) wl_[st_ + e_] = wl_[256 + st_ + e_] * gelu_tanh(s_ * wl_[384 + st_ + e_]); } while (0)
        v4u ua[8], ub[8]; int ea, ebb;
        PC_LOAD(ua, ea, TU, 0);
#pragma unroll 1
        for (int k = 0; k < nb; k += 2) {
            if (k + 1 < nb) PC_LOAD(ub, ebb, TU, k + 1);
            PC_DOTS(ua, ea);
            if (k + 2 < nb) PC_LOAD(ua, ea, TU, k + 2);
            if (k + 1 < nb) PC_DOTS(ub, ebb);
        }
#undef PC_DOTS
#undef PC_DOT8
    }
    LDS_WAIT();
    float acc[4][16];
#pragma unroll
    for (int tl = 0; tl < 4; ++tl)
#pragma unroll
        for (int k = 0; k < 16; ++k) acc[tl][k] = 0.f;
#define PC_AX8(buf, n_, wl_, aa) do { asm volatile("" ::: "memory"); _Pragma("unroll") for (int j = 0; j < 8; ++j) { if (j < n_) axpy16_fp8(buf[j], wl_[j], aa); } } while (0)
#define PC_AXPY(buf, be) do { const int tl_ = be & 3, st_ = (be >> 2) & 127, n_ = be >> 9; const LAS float* wl_ = W4 + tl_ * 512 + st_; \
        if (tl_ == 0) PC_AX8(buf, n_, wl_, acc[0]); else if (tl_ == 1) PC_AX8(buf, n_, wl_, acc[1]); else if (tl_ == 2) PC_AX8(buf, n_, wl_, acc[2]); else PC_AX8(buf, n_, wl_, acc[3]); } while (0)
    {
        v4u va[8], vb[8]; int ea, ebb;
        PC_LOAD(va, ea, TV, 0);
#pragma unroll 1
        for (int k = 0; k < nb; k += 2) {
            if (k + 1 < nb) PC_LOAD(vb, ebb, TV, k + 1);
            PC_AXPY(va, ea);
            if (k + 2 < nb) PC_LOAD(va, ea, TV, k + 2);
            if (k + 1 < nb) PC_AXPY(vb, ebb);
        }
    }
#undef PC_AXPY
#undef PC_AX8
#undef PC_LOAD
#pragma unroll
    for (int tl = 0; tl < 4; ++tl) {
        asm volatile("" ::: "memory"); __builtin_amdgcn_sched_barrier(0);
        const float* xrow = xres + (size_t)(tok0 + tl) * DM + 16 * lane; float* orow = xout + (size_t)(tok0 + tl) * DM + 16 * lane; f32x4 y[4]; float ss = 0.f;
#pragma unroll
        for (int c = 0; c < 4; ++c) { f32x4 rr = *(const f32x4*)(xrow + 4 * c); rr.x += acc[tl][4 * c]; rr.y += acc[tl][4 * c + 1]; rr.z += acc[tl][4 * c + 2]; rr.w += acc[tl][4 * c + 3]; y[c] = rr; ss += (rr.x * rr.x + rr.y * rr.y) + (rr.z * rr.z + rr.w * rr.w); }
        const float rn = 1.0f / sqrtf(wave_sum(ss) * (1.0f / DM) + EPS);
        if (nw_f) {
#pragma unroll
            for (int c = 0; c < 4; ++c) { const f32x4 wv = *(const f32x4*)(nw_f + 16 * lane + 4 * c); *(f32x4*)(orow + 4 * c) = y[c] * rn * wv; }
        } else {
#pragma unroll
            for (int c = 0; c < 4; ++c) *(f32x4*)(orow + 4 * c) = y[c];
        }
        if (nw_bf) {
            f32x4 z[4];
#pragma unroll
            for (int c = 0; c < 4; ++c) { const f32x4 wv = *(const f32x4*)(nw_bf + 16 * lane + 4 * c); z[c] = y[c] * rn * wv; }
            v4u o0, o1; o0.x = pkbf(z[0].x, z[0].y); o0.y = pkbf(z[0].z, z[0].w); o0.z = pkbf(z[1].x, z[1].y); o0.w = pkbf(z[1].z, z[1].w);
            o1.x = pkbf(z[2].x, z[2].y); o1.y = pkbf(z[2].z, z[2].w); o1.z = pkbf(z[3].x, z[3].y); o1.w = pkbf(z[3].z, z[3].w);
            v4u* xo = (v4u*)(XNO + (size_t)(tok0 + tl) * DM + 16 * lane); xo[0] = o0; xo[1] = o1;
        }
    }
    LDS_WAIT();
}
__device__ __forceinline__ float fkey(float v, unsigned clr, unsigned payload) { return __builtin_bit_cast(float, (__builtin_bit_cast(unsigned, v) & ~clr) | payload); }
__device__ __forceinline__ float fkey_val(float k, unsigned clr) { return __builtin_bit_cast(float, __builtin_bit_cast(unsigned, k) & ~clr); }
__device__ __forceinline__ float kmax(float x, float y) { float r; asm("v_max_f32 %0, %1, %2" : "=v"(r) : "v"(x), "v"(y)); return r; }
__device__ __forceinline__ float kmin(float x, float y) { float r; asm("v_min_f32 %0, %1, %2" : "=v"(r) : "v"(x), "v"(y)); return r; }
template <int N> __device__ __forceinline__ void sortnet_desc(float (&a)[N]) {
#pragma unroll
    for (int k = 2; k <= N; k <<= 1)
#pragma unroll
        for (int j = k >> 1; j > 0; j >>= 1)
#pragma unroll
            for (int i = 0; i < N; ++i) { const int l = i ^ j; if (l > i) { const bool desc = ((i & k) == 0); const float x = a[i], y = a[l]; const float mx = kmax(x, y), mn = kmin(x, y); a[i] = desc ? mx : mn; a[l] = desc ? mn : mx; } }
}
template <int N> __device__ __forceinline__ void bitonic_merge_desc(float (&a)[N]) {
#pragma unroll
    for (int j = N >> 1; j > 0; j >>= 1)
#pragma unroll
        for (int i = 0; i < N; ++i) { const int l = i ^ j; if (l > i) { const float x = a[i], y = a[l]; a[i] = kmax(x, y); a[l] = kmin(x, y); } }
}
__device__ __forceinline__ void sort16_desc(float (&a)[16]) {
#define SN_CE(i, j) { const float x_ = a[i], y_ = a[j]; a[i] = kmax(x_, y_); a[j] = kmin(x_, y_); }
    SN_CE(0,1) SN_CE(2,3) SN_CE(0,2) SN_CE(1,3) SN_CE(1,2) SN_CE(4,5) SN_CE(6,7) SN_CE(4,6) SN_CE(5,7) SN_CE(5,6) SN_CE(0,4) SN_CE(2,6) SN_CE(2,4) SN_CE(1,5) SN_CE(3,7) SN_CE(3,5) SN_CE(1,2) SN_CE(3,4) SN_CE(5,6) SN_CE(8,9) SN_CE(10,11) SN_CE(8,10) SN_CE(9,11) SN_CE(9,10) SN_CE(12,13) SN_CE(14,15) SN_CE(12,14) SN_CE(13,15) SN_CE(13,14) SN_CE(8,12) SN_CE(10,14) SN_CE(10,12) SN_CE(9,13) SN_CE(11,15) SN_CE(11,13) SN_CE(9,10) SN_CE(11,12) SN_CE(13,14) SN_CE(0,8) SN_CE(4,12) SN_CE(4,8) SN_CE(2,10) SN_CE(6,14) SN_CE(6,10) SN_CE(2,4) SN_CE(6,8) SN_CE(10,12) SN_CE(1,9) SN_CE(5,13) SN_CE(5,9) SN_CE(3,11) SN_CE(7,15) SN_CE(7,11) SN_CE(3,5) SN_CE(7,9) SN_CE(11,13) SN_CE(1,2) SN_CE(3,4) SN_CE(5,6) SN_CE(7,8) SN_CE(9,10) SN_CE(11,12) SN_CE(13,14)
#undef SN_CE
}
__device__ __forceinline__ void top16_merge(float (&a)[16], const float (&b)[16]) {
#pragma unroll
    for (int i = 0; i < 16; ++i) { const float y = b[15 - i]; a[i] = kmax(a[i], y); }
    bitonic_merge_desc<16>(a);
}
__device__ __forceinline__ void top16_xchg32(float (&a)[16], bool upper) {
    float o[16];
#pragma unroll
    for (int i = 0; i < 16; ++i) { const unsigned ai_ = __builtin_bit_cast(unsigned, a[i]); auto sw = __builtin_amdgcn_permlane32_swap(ai_, ai_, false, false); const unsigned lo_ = sw[0], hi_ = sw[1]; o[i] = __builtin_bit_cast(float, upper ? lo_ : hi_); }
    top16_merge(a, o);
}
constexpr int PS_KP = 136;
__device__ __forceinline__ void peer_select_unit(int unit, const bf16* QP, const LAS bf16* KLDS, int* EXPO, float* GATEO, LAS unsigned* KL, int wave, int lane) {
    const int h = unit & 7, tile = unit >> 3, r = lane & 31, hh = lane >> 5, tok = tile * 256 + wave * 32 + r;
    LAS unsigned* kl = KL + lane;
    f32x16 f0, f1;
    bf16x8 qf[8];
#pragma unroll
    for (int s = 0; s < 8; ++s) qf[s] = *(const bf16x8*)(QP + (size_t)tok * NQP + h * 256 + 8 * hh + 16 * s);
#pragma unroll
    for (int p = 0; p < 2; ++p) {
        f32x16 acc[4];
#pragma unroll
        for (int nt = 0; nt < 4; ++nt)
#pragma unroll
            for (int i = 0; i < 16; ++i) acc[nt][i] = 0.f;
        const LAS bf16* krow = KLDS + (p * 128 + r) * PS_KP + 8 * hh;
        bf16x8 ka[2][4];
#pragma unroll
        for (int nt = 0; nt < 4; ++nt) ka[0][nt] = *(const LAS bf16x8*)(krow + nt * 32 * PS_KP);
#pragma unroll
        for (int s = 0; s < 8; ++s) {
            if (s + 1 < 8) {
#pragma unroll
                for (int nt = 0; nt < 4; ++nt) ka[(s + 1) & 1][nt] = *(const LAS bf16x8*)(krow + nt * 32 * PS_KP + 16 * (s + 1)); }
            __builtin_amdgcn_sched_barrier(0);
            const bf16x8 b = qf[s];
#pragma unroll
            for (int nt = 0; nt < 4; ++nt) acc[nt] = MFMA32(ka[s & 1][nt], b, acc[nt]);
            __builtin_amdgcn_sched_barrier(0);
        }
        if (p == 0) {
#pragma unroll
            for (int s = 0; s < 8; ++s) qf[s] = *(const bf16x8*)(QP + (size_t)tok * NQP + h * 256 + 128 + 8 * hh + 16 * s); }
        float top[16];
#pragma unroll
        for (int nt = 0; nt < 4; ++nt) {
            float c[16];
#pragma unroll
            for (int i = 0; i < 16; ++i) { const int n = nt * 32 + (i & 3) + 8 * (i >> 2) + 4 * hh; c[i] = fkey(acc[nt][i], 0x7Fu, (unsigned)(127 - n)); }
            sort16_desc(c);
            if (nt == 0) {
#pragma unroll
                for (int i = 0; i < 16; ++i) top[i] = c[i];
            } else top16_merge(top, c);
        }
        top16_xchg32(top, hh != 0);
#pragma unroll
        for (int i = 0; i < 16; ++i) { kl[(p * 16 + i) * 64] = __builtin_bit_cast(unsigned, top[i]); const float f = fkey_val(top[i], 0x7Fu); if (p == 0) f0[i] = f; else f1[i] = f; }
    }
    float cd[32]; const float NEGK = -__builtin_inff();
#define PSEL_C(idx, a0, b0, a1, b1) { const float sm = (hh ? f0[a1] : f0[a0]) + (hh ? f1[b1] : f1[b0]); const int fl = hh ? ((a1) * 16 + (b1)) : ((a0) * 16 + (b0)); cd[idx] = fkey(sm, 0xFFu, (unsigned)(255 - fl)); }
#define PSEL_C0(idx, a0, b0) { const float sm = f0[a0] + f1[b0]; cd[idx] = hh ? NEGK : fkey(sm, 0xFFu, (unsigned)(255 - ((a0) * 16 + (b0)))); }
#define PSEL_C1(idx, a1, b1) { const float sm = f0[a1] + f1[b1]; cd[idx] = hh ? fkey(sm, 0xFFu, (unsigned)(255 - ((a1) * 16 + (b1)))) : NEGK; }
    PSEL_C(0, 0, 0, 1, 0) PSEL_C(1, 0, 1, 1, 1) PSEL_C(2, 0, 2, 1, 2) PSEL_C(3, 0, 3, 1, 3) PSEL_C(4, 0, 4, 1, 4) PSEL_C(5, 0, 5, 1, 5) PSEL_C(6, 0, 6, 1, 6) PSEL_C(7, 0, 7, 1, 7)
    PSEL_C(8, 0, 8, 3, 0) PSEL_C(9, 0, 9, 3, 1) PSEL_C(10, 0, 10, 3, 2) PSEL_C(11, 0, 11, 3, 3) PSEL_C(12, 0, 12, 5, 0) PSEL_C(13, 0, 13, 5, 1) PSEL_C(14, 0, 14, 6, 0) PSEL_C(15, 0, 15, 6, 1)
    PSEL_C(16, 2, 0, 7, 0) PSEL_C(17, 2, 1, 7, 1) PSEL_C(18, 2, 2, 8, 0) PSEL_C(19, 2, 3, 9, 0) PSEL_C(20, 2, 4, 10, 0) PSEL_C(21, 4, 0, 11, 0) PSEL_C(22, 4, 1, 12, 0) PSEL_C(23, 4, 2, 13, 0)
    PSEL_C1(24, 14, 0) PSEL_C1(25, 15, 0)
#pragma unroll
    for (int i = 26; i < 32; ++i) cd[i] = NEGK;
#undef PSEL_C
#undef PSEL_C0
#undef PSEL_C1
    float ca[16], cb[16];
#pragma unroll
    for (int i = 0; i < 16; ++i) { ca[i] = cd[i]; cb[i] = cd[16 + i]; }
    sort16_desc(ca); sort16_desc(cb); top16_merge(ca, cb); top16_xchg32(ca, hh != 0);
    typedef unsigned u32x16 __attribute__((ext_vector_type(16)));
    u32x16 cav; f32x16 e;
#pragma unroll
    for (int i = 0; i < 16; ++i) cav[i] = __builtin_bit_cast(unsigned, ca[i]);
    const float bmax = fkey_val(ca[0], 0xFFu); float sum = 0.f;
#pragma unroll
    for (int i = 0; i < 16; ++i) { e[i] = __expf(fkey_val(ca[i], 0xFFu) - bmax); sum += e[i]; }
    const float inv = 1.0f / sum;
    LDS_WAIT();
    int* eo = EXPO + (size_t)tok * 128 + h * 16 + 8 * hh; float* go = GATEO + (size_t)tok * 128 + h * 16 + 8 * hh;
    int ex8[8]; float g8[8];
#pragma unroll
    for (int i = 0; i < 8; ++i) {
        const unsigned key = hh ? cav[8 + i] : cav[i]; const float ev = hh ? e[8 + i] : e[i];
        const int fl = 255 - (int)(key & 0xFFu), a = fl >> 4, b = fl & 15;
        const unsigned ka = kl[a * 64], kb = kl[(16 + b) * 64];
        ex8[i] = (127 - (int)(ka & 0x7Fu)) * 128 + (127 - (int)(kb & 0x7Fu)); g8[i] = ev * inv;
    }
    { v4u w0, w1; w0.x = (unsigned)ex8[0]; w0.y = (unsigned)ex8[1]; w0.z = (unsigned)ex8[2]; w0.w = (unsigned)ex8[3]; w1.x = (unsigned)ex8[4]; w1.y = (unsigned)ex8[5]; w1.z = (unsigned)ex8[6]; w1.w = (unsigned)ex8[7];
      ((v4u*)eo)[0] = w0; ((v4u*)eo)[1] = w1;
      ((f32x4*)go)[0] = (f32x4){g8[0], g8[1], g8[2], g8[3]}; ((f32x4*)go)[1] = (f32x4){g8[4], g8[5], g8[6], g8[7]}; }
    LDS_WAIT();
}
__device__ __forceinline__ void psel_stage_keys(const bf16* K, LAS bf16* KLDS, int tid) {
    __syncthreads();
#pragma unroll
    for (int i = 0; i < 8; ++i) { const int c = tid + NTHR * i, row = c >> 4, ch = c & 15;
        *(LAS v4u*)(KLDS + row * PS_KP + 8 * ch) = *(const v4u*)(K + (size_t)row * 128 + 8 * ch); }
    __syncthreads();
}
struct Args { const float* in[22]; float* out; unsigned char* ws; int ph_lo, ph_hi, li, pad; };
enum { I_X = 0, I_NMIX, I_NFFN, I_FNORM, I_EWIN, I_LNW, I_WS, I_BS, I_POS, I_CKW1, I_CKW2, I_CVW1, I_CVW2, I_EWOUT, I_OWIN, I_LB, I_HNW, I_OWOUT, I_PWQ, I_PKEYS, I_PU, I_PV };

#define WSP_EARLY ((unsigned char*)args.ws)
__device__ __forceinline__ int qsel_unit(int i, int G, int c) {
    static_assert(pg8::WGM == 1 && pg8::NXCD == 8 && !GEMM_XCD2D, "qsel_unit mirrors StaticOrder::next for WGM = 1");
    const int nN = NQP / 256, nwg = (MTOK / 256) * nN, L = i * G + c, q = nwg / 8, xcd = L % 8, off = L / 8, wgid = xcd * q + off;
    return (wgid / nN) * 8 + (wgid % nN);
}
__device__ __forceinline__ bool eval_align(int G, const XcdBarrier& b) { if (G == 256) { if (PEER_ALIGN_XCD) xcd_align(b); else __syncthreads(); } return true; }
__global__ void __launch_bounds__(NTHR, 2) fwd_kernel(Args args) {
    extern __shared__ __attribute__((aligned(16))) unsigned char lds_raw[];
    LAS unsigned char* lds = (LAS unsigned char*)lds_raw;
    volatile LAS unsigned* MISC = (volatile LAS unsigned*)(lds + MISC_OFF);
    const int tid = threadIdx.x, lane = tid & 63, wave = __builtin_amdgcn_readfirstlane(tid >> 6);
    const int G = gridDim.x, bx = blockIdx.x;
    const int gw = bx * NWAVES + wave, NGW = G * NWAVES, gtid = bx * NTHR + tid, gthreads = G * NTHR;
    typedef __attribute__((address_space(4))) const volatile Args CArgs;
    CArgs* kargs = (CArgs*)__builtin_amdgcn_kernarg_segment_ptr();
    gu32* ctl = (gu32*)(WSP_EARLY + WS_CTL);
    for (int u = tid; u < (LDS_BYTES - LDSCTL_OFF) / 4; u += NTHR) ((LAS unsigned*)(lds + LDSCTL_OFF))[u] = 0u;
    __syncthreads();
    XcdBarrier bar; bar.bar = (unsigned*)(ctl + CW_BAR); bar.x = 0; bar.st = nullptr;
    if (MK_N_LAUNCHES == 1) bar = xcd_barrier_post((unsigned*)(ctl + CW_BAR), MISC + 8);
    const int lo = args.ph_lo, hi = args.ph_hi;
#define IN(k) (lo <= (k) && (k) < hi)
#ifndef PROBE_REPEAT
#define PROBE_REPEAT -1
#endif
#ifndef PROBE_BAR2
#define PROBE_BAR2 0
#endif
#ifndef PROBE_EXMASK
#define PROBE_EXMASK 0x3FFF
#endif
#define NREP(k) ((k) == PROBE_REPEAT ? 2 : 1)
#define DRY(k) ((k) == PROBE_REPEAT && rep_ == 0)
#if PEER_ALIGN
#define EVAL_ALIGN if (eval_align(G, bar))
#else
#define EVAL_ALIGN
#endif
#define PH_IDS int tid_o_ = threadIdx.x; asm volatile("" : "+v"(tid_o_)); const int tid = tid_o_, lane = tid & 63, wave = __builtin_amdgcn_readfirstlane(tid >> 6), gw = bx * NWAVES + wave, gtid = bx * NTHR + tid; (void)lane; (void)wave; (void)gw; (void)gtid
#define SEAM_QSEL(k) do { if (IN(k) && IN((k) + 1)) { if (FUSE_QSEL && G == 256) { asm volatile("s_waitcnt vmcnt(0)" ::: "memory"); __syncthreads(); __builtin_amdgcn_fence(__ATOMIC_ACQUIRE, "agent"); \
        asm volatile("s_waitcnt vmcnt(0)" ::: "memory"); __syncthreads(); } else { xcd_barrier(bar); if (PROBE_BAR2) xcd_barrier(bar); } } } while (0)
#define SEAM(k) do { if (IN(k) && IN((k) + 1)) { xcd_barrier(bar); if (PROBE_BAR2) xcd_barrier(bar); } } while (0)

#define AIN(i) ((const float*)kargs->in[i])
#define WSP ((unsigned char*)kargs->ws)
#define Win0t ((bf16*)(WSP + WS_WIN0))
#define Wout0t ((bf16*)(WSP + WS_WOUT0))
#define Win1t ((bf16*)(WSP + WS_WIN1))
#define Wout1t ((bf16*)(WSP + WS_WOUT1))
#define Wqt ((bf16*)(WSP + WS_WQ))
#define KEYS ((bf16*)(WSP + WS_KEYS))
#define WSTRIL ((bf16*)(WSP + WS_WSTRIL))
#define LBV ((float*)(WSP + WS_LB))
#define KCMP ((bf16*)(WSP + WS_KCMP))
#define VCMP ((bf16*)(WSP + WS_VCMP))
#define XN ((bf16*)(WSP + WS_XN))
#define MIX ((bf16*)(WSP + WS_MIX))
#define TAB8U(l) ((unsigned char*)(WSP + WS_TAB8 + (size_t)(l) * 32 * MiB))
#define TAB8V(l) ((unsigned char*)(WSP + WS_TAB8 + (size_t)(l) * 32 * MiB + 16 * MiB))
#define SCLU(l) ((float*)(WSP + WS_SCL + (size_t)(l) * 131072))
#define SCLV(l) ((float*)(WSP + WS_SCL + (size_t)(l) * 131072 + 65536))
#define EXPB ((int*)(WSP + WS_EXP))
#define GATEB ((float*)(WSP + WS_GATE))
#define PB ((bf16*)(WSP + WS_P))
#define xres ((float*)kargs->out)
#define XRB ((bf16*)kargs->out)
#define X3B ((bf16*)(WSP + WS_P + 128 * MiB))
#define RSB(l) ((float*)(WSP + WS_P + 192 * MiB))
    for (int rep_ = 0; rep_ < NREP(0); ++rep_) if (IN(0)) { PH_IDS;
        LAS float* scr = (LAS float*)(lds + wave * 16384);
        {
            const int n0 = (DM / 64) * (NP0 / 32), n1 = (DM / 64) * (DM / 32), n2 = (DM / 64) * (NP1 / 32), n3 = n1, n4 = (DM / 64) * (NQP / 32), n5 = n4;
            const int tot = n0 + n1 + n2 + n3 + n4 + n5;
            for (int it = gw; it < tot; it += NGW) { int r = it;
                if (r < n0) { tr_item(AIN(I_EWIN), DM, NP0_REAL, Win0t, scr, r, NP0 / 32, lane, FUSE_NORM0 ? AIN(I_NMIX) : nullptr); continue; } r -= n0;
                if (r < n1) { tr_item(AIN(I_EWOUT), DM, DM, Wout0t, scr, r, DM / 32, lane); continue; } r -= n1;
                if (r < n2) { tr_item(AIN(I_OWIN), DM, NP1, Win1t, scr, r, NP1 / 32, lane); continue; } r -= n2;
                if (r < n3) { tr_item(AIN(I_OWOUT), DM, DM, Wout1t, scr, r, DM / 32, lane); continue; } r -= n3;
                if (r < n4) { tr_item(AIN(I_PWQ), DM, NQP, Wqt, scr, r, NQP / 32, lane, FUSE_NORM ? AIN(I_NFFN) : nullptr); continue; } r -= n4;
                tr_item(AIN(I_PWQ) + (size_t)DM * NQP, DM, NQP, Wqt + (size_t)NQP * DM, scr, r, NQP / 32, lane, FUSE_NORM ? AIN(I_NFFN) + DM : nullptr); }
        }
        {
            bf16* W1T = (bf16*)(WSP + WS_CW1); bf16* W2T = (bf16*)(WSP + WS_CW2); float* B1 = (float*)(WSP + WS_BIAS1);
            for (int it = gw; it < 2 * 128 + 2 * 4; it += NGW) { int r = it;
#if P2_C32
                if (r < 256) continue;
                r -= 256;
#else
                if (r < 128) { tr_item(AIN(I_CKW1), 2048, 128, W1T, scr, r, 4, lane); continue; } r -= 128;
                if (r < 128) { tr_item(AIN(I_CVW1), 2048, 128, W1T + (size_t)128 * 2048, scr, r, 4, lane); continue; } r -= 128;
#endif
                if (r < 4) { tr_item(AIN(I_CKW2), 128, 64, W2T, scr, r, 2, lane); continue; } r -= 4;
                tr_item(AIN(I_CVW2), 128, 64, W2T + 64 * 128, scr, r, 2, lane); }
#if P2_C32
            for (int it = gw; it < 1024; it += NGW) {
                const int ks = it & 127, ht = (it >> 7) & 3; const float* w1 = (it >> 9) ? AIN(I_CVW1) : AIN(I_CKW1);
                const float* s0 = w1 + (size_t)(16 * ks + 8 * (lane >> 5)) * 128 + 32 * ht + (lane & 31);
                v4u o; o.x = pk2(s0[0], s0[128]); o.y = pk2(s0[256], s0[384]); o.z = pk2(s0[512], s0[640]); o.w = pk2(s0[768], s0[896]);
                *((v4u*)W1T + (size_t)it * 64 + lane) = o; }
#endif
            for (int o = gw; o < 256; o += NGW) { const float* w1 = (o < 128) ? AIN(I_CKW1) : AIN(I_CVW1); const int hid = o & 127; float a = 0.f;
                for (int jj = lane; jj < 2048; jj += 64) a += AIN(I_POS)[jj] * w1[(size_t)jj * 128 + hid];
                a = wave_sum(a); if (lane == 0) B1[o] = a; }
        }
        cvt_items(AIN(I_PKEYS), KEYS, (size_t)2 * 8 * 2 * 128 * 128, gw, NGW, lane);
        for (int l = 0; l < (TAB1_IN_P7 ? 1 : 2); ++l) { if (PEER_I8) tab_to_i8(AIN(I_PU) + (size_t)l * NEXP * DM, TAB8U(l), SCLU(l), NEXP, gw, NGW, lane); else tab_to_fp8(AIN(I_PU) + (size_t)l * NEXP * DM, TAB8U(l), SCLU(l), NEXP, gw, NGW, lane); tab_to_fp8(AIN(I_PV) + (size_t)l * NEXP * DM, TAB8V(l), SCLV(l), NEXP, gw, NGW, lane); }
        for (int i = gtid; i < 4 * 128 * 128; i += gthreads) { const int t = (i >> 7) & 127, s = i & 127; WSTRIL[i] = (s <= t) ? f2bf(AIN(I_WS)[i]) : (bf16)0; }
        for (int i = gtid; i < DM; i += gthreads) LBV[i] = sigmoidf_(AIN(I_LB)[DM + i] - AIN(I_LB)[i]);
        if (FUSE_NORM0) cvt_rows_rstd(AIN(I_X), XN, (float*)(WSP + WS_RS), gw, NGW, lane);
        else rms_rows(AIN(I_X), AIN(I_NMIX), XN, nullptr, gw, NGW, lane);
    }
    SEAM(0);
    for (int rep_ = 0; rep_ < NREP(1); ++rep_) if (IN(1)) { PH_IDS;
#if FAST_GEMM
        pg8::Gemm g{XN, Win0t, MTOK, NP0, DM}; pg8::StaticOrder S; S.init(MTOK, NP0, G, bx);
        pg8::EpiAct<0> E{PB, NP0, nullptr, FUSE_NORM0 ? (const float*)(WSP + WS_RS) : nullptr};
        pg8::gemm_phase<pg8::EpiAct<0>, pg8::StaticOrder, GEMM_ALIGN_ACT, true>(lds + RING_OFF, g, S, E);
#else
        naive_gemm(XN, Win0t, MTOK, NP0, DM, NEpiAct{PB, NP0, 0, nullptr}, gtid, gthreads);
#endif
    }
    SEAM(1);
    for (int rep_ = 0; rep_ < NREP(2); ++rep_) if (IN(2)) { PH_IDS;
#if FAST_P2
        if (G == 256) {
#if P2_C32
#ifdef P2_CMP_REP
            compress_unit32(bx, PB, (const bf16*)(WSP + WS_CW1), (const bf16*)(WSP + WS_CW2), (const float*)(WSP + WS_BIAS1), KCMP, VCMP, lds, tid);
#endif
            compress_unit32(bx, PB, (const bf16*)(WSP + WS_CW1), (const bf16*)(WSP + WS_CW2), (const float*)(WSP + WS_BIAS1), KCMP, VCMP, lds, tid);
            gmlp_run(bx, 4, 256, PB, AIN(I_LNW), WSTRIL, AIN(I_BS), MIX, lds, tid);
#elif P2_PIPE
#ifdef P2_CMP_REP
            if (bx < 128) compress_unit(bx, PB, (const bf16*)(WSP + WS_CW1), (const bf16*)(WSP + WS_CW2), (const float*)(WSP + WS_BIAS1), KCMP, VCMP, lds, tid);
#endif
            if (bx < 128) { compress_unit(bx, PB, (const bf16*)(WSP + WS_CW1), (const bf16*)(WSP + WS_CW2), (const float*)(WSP + WS_BIAS1), KCMP, VCMP, lds, tid);
                gmlp_run(bx, P2_NC, 128, PB, AIN(I_LNW), WSTRIL, AIN(I_BS), MIX, lds, tid); }
            else gmlp_run(128 * P2_NC + (bx - 128), (1024 - 128 * P2_NC) / 128, 128, PB, AIN(I_LNW), WSTRIL, AIN(I_BS), MIX, lds, tid);
#else
            if (bx < 128) { compress_unit(bx, PB, (const bf16*)(WSP + WS_CW1), (const bf16*)(WSP + WS_CW2), (const float*)(WSP + WS_BIAS1), KCMP, VCMP, lds, tid);
                for (int k = 0; k < 3; ++k) gmlp_unit(bx + 128 * k, PB, AIN(I_LNW), WSTRIL, AIN(I_BS), MIX, lds, tid); }
            else { for (int k = 0; k < 5; ++k) gmlp_unit(384 + (bx - 128) + 128 * k, PB, AIN(I_LNW), WSTRIL, AIN(I_BS), MIX, lds, tid); }
#endif
        } else
        for (int u = bx; u < 128 + 1024; u += G) {
            if (u < 128) compress_unit(u, PB, (const bf16*)(WSP + WS_CW1), (const bf16*)(WSP + WS_CW2), (const float*)(WSP + WS_BIAS1), KCMP, VCMP, lds, tid);
            else gmlp_unit(u - 128, PB, AIN(I_LNW), WSTRIL, AIN(I_BS), MIX, lds, tid);
        }
#else
        for (int u = bx; u < 1024; u += G) naive_gmlp_unit(u, PB, AIN(I_LNW), AIN(I_WS), AIN(I_BS), MIX, lds, tid);
        for (int cu = bx; cu < 2 * NCMP * 8; cu += G) naive_compress_unit(cu, PB, AIN(I_POS), AIN(I_CKW1), AIN(I_CKW2), AIN(I_CVW1), AIN(I_CVW2), KCMP, VCMP, lds, tid);
#endif
    }
    SEAM(2);
    for (int rep_ = 0; rep_ < NREP(3); ++rep_) if (IN(3)) { PH_IDS;
#if FAST_NSA
#if NSA_QUEUE
        {
            const bool dyn = (G == 256) && (NREP(3) == 1);
            gu32* qc = (gu32*)(WSP + WS_CTL) + 12288 + 64 * (bx & 7);
            int k = 0;
            if (dyn) { if (tid == 0) MISC[13] = __hip_atomic_fetch_add((unsigned*)qc, 1u, __ATOMIC_RELAXED, __HIP_MEMORY_SCOPE_AGENT); __syncthreads(); k = __builtin_amdgcn_readfirstlane((int)MISC[13]); __syncthreads(); }
#pragma unroll 1
            for (int it = 0; ; ++it) {
                int unit;
                if (dyn) { if (k >= 128) break; unit = ((127 - k) << 3) | (bx & 7);
                    if (tid == 0) MISC[13] = __hip_atomic_fetch_add((unsigned*)qc, 1u, __ATOMIC_RELAXED, __HIP_MEMORY_SCOPE_AGENT); }
                else { const int u = bx + it * G; if (u >= 1024) break; unit = u; if (G == 256 && ((u >> 8) & 1)) unit = (u & ~(31 << 3)) | ((31 - ((u >> 3) & 31)) << 3); }
                nsa_unit(unit, PB, KCMP, VCMP, MIX, lds, tid);
                if (dyn) { k = __builtin_amdgcn_readfirstlane((int)MISC[13]); __syncthreads(); }
            }
        }
#else
        for (int u = bx; u < 1024; u += G) {
            int u2 = u;
            if (G == 256 && ((u >> 8) & 1)) u2 = (u & ~(31 << 3)) | ((31 - ((u >> 3) & 31)) << 3);
            nsa_unit(u2, PB, KCMP, VCMP, MIX, lds, tid); }
#endif
#else
        for (int wu = gw; wu < BATCH * 2 * SEQ; wu += NGW) naive_nsa_wave(wu, PB, KCMP, VCMP, MIX, lds + wave * NSA_WAVE_LDS, lane);
#endif
    }
    SEAM(3);
    for (int rep_ = 0; rep_ < NREP(4); ++rep_) if (IN(4)) { PH_IDS;
#if FAST_GEMM
        pg8::Gemm g{MIX, Wout0t, MTOK, DM, DM}; pg8::StaticOrder S; S.init(MTOK, DM, G, bx);
#if FUSE_NORM
        pg8::EpiResidNorm E{AIN(I_X), xres, XN, RSB(0), DM};
        pg8::gemm_phase<pg8::EpiResidNorm, pg8::StaticOrder, true, true>(lds + RING_OFF, g, S, E);
#elif RESID_BF16
#if FUSE_NORM0
        pg8::EpiResidBf<true> E{XN, XRB, DM};
        pg8::gemm_phase<pg8::EpiResidBf<true>, pg8::StaticOrder, GEMM_ALIGN_RES, true>(lds + RING_OFF, g, S, E);
#else
        pg8::EpiResidBf<false> E{AIN(I_X), XRB, DM};
        pg8::gemm_phase<pg8::EpiResidBf<false>, pg8::StaticOrder, GEMM_ALIGN_RES, true>(lds + RING_OFF, g, S, E);
#endif
#else
        pg8::EpiResid E{AIN(I_X), xres, DM};
        pg8::gemm_phase<pg8::EpiResid, pg8::StaticOrder, true, true>(lds + RING_OFF, g, S, E);
#endif
#else
        naive_gemm(MIX, Wout0t, MTOK, DM, DM, NEpiResid{AIN(I_X), xres, DM}, gtid, gthreads);
#endif
    }
    SEAM(4);
#if !FUSE_NORM
    for (int rep_ = 0; rep_ < NREP(5); ++rep_) if (IN(5)) { PH_IDS; if (RESID_BF16) rms_rows_bf(XRB, AIN(I_NFFN), XN, gw, NGW, lane); else rms_rows(xres, AIN(I_NFFN), XN, nullptr, gw, NGW, lane); }
    SEAM(5);
#endif
    for (int rep_ = 0; rep_ < NREP(6); ++rep_) if (IN(6)) { PH_IDS;
#if FAST_GEMM
        pg8::Gemm g{XN, Wqt, MTOK, NQP, DM}; pg8::StaticOrder S; S.init(MTOK, NQP, G, bx);
#if FUSE_NORM
        pg8::EpiRowScale E{PB, NQP, RSB(0), 1.0f / DM, EPS};
        pg8::gemm_phase<pg8::EpiRowScale, pg8::StaticOrder, true, true>(lds + RING_OFF, g, S, E);
#else
        pg8::EpiAct<2> E{PB, NQP, nullptr};
        pg8::gemm_phase<pg8::EpiAct<2>, pg8::StaticOrder, true, true>(lds + RING_OFF, g, S, E);
#endif
#else
        naive_gemm(XN, Wqt, MTOK, NQP, DM, NEpiAct{PB, NQP, 2, nullptr}, gtid, gthreads);
#endif
    }
    SEAM_QSEL(6);
#if FAST_PSEL
    for (int rep_ = 0; rep_ < NREP(7); ++rep_) if (IN(7)) { PH_IDS; int curh = -1; for (int ui_ = 0, u = bx; u < 1024; u += G, ++ui_) { int u_ = u; if (FUSE_QSEL && G == 256) u_ = qsel_unit(ui_, G, bx); if ((u_ & 7) != curh) { curh = u_ & 7; psel_stage_keys(KEYS + (size_t)curh * 2 * 128 * 128, (LAS bf16*)(lds + 65536), tid); } peer_select_unit(u_, PB, (const LAS bf16*)(lds + 65536), EXPB, GATEB, (LAS unsigned*)(lds + wave * 8192), wave, lane);
            if (TAB1_IN_P7) {
                const int nsl = (1024 + G - 1) / G * G;
                for (int rw = u * 32 + wave * 4; rw < u * 32 + wave * 4 + 4; ++rw) { (void)nsl;
                    if (rw < NEXP) tab_to_fp8(AIN(I_PU) + (size_t)NEXP * DM + (size_t)rw * DM, TAB8U(1) + (size_t)rw * DM, SCLU(1) + rw, 1, 0, 1, lane);
                    else tab_to_fp8(AIN(I_PV) + (size_t)NEXP * DM + (size_t)(rw - NEXP) * DM, TAB8V(1) + (size_t)(rw - NEXP) * DM, SCLV(1) + (rw - NEXP), 1, 0, 1, lane); } } } }
#else
    if (IN(7)) { PH_IDS; for (int wu = gw; wu < MTOK * 8; wu += NGW) naive_peer_select_wave(wu, PB, KEYS, EXPB, GATEB, lds + wave * 2048, lane); }
#endif
    SEAM(7);
#if FAST_PEVAL
#if PEER_CHUNK
    for (int rep_ = 0; rep_ < NREP(8); ++rep_) if (IN(8)) { PH_IDS; for (int t4 = gw; t4 < MTOK / 4; t4 += NGW) peer_eval4c_wave(4 * t4, XN, DRY(8) ? MIX : XN, TAB8U(0), TAB8V(0), SCLU(0), SCLV(0), EXPB, GATEB, xres, DRY(8) ? (float*)PB : xres, AIN(I_NMIX) + DM, nullptr, (LAS float*)(lds + wave * PE4C_LDS), lane); }
#elif PEER_EVAL4
    for (int rep_ = 0; rep_ < NREP(8); ++rep_) if (IN(8)) { PH_IDS; for (int t4 = gw; t4 < MTOK / PT; t4 += NGW) EVAL_ALIGN peer_eval4m_wave(PT * t4, XN, DRY(8) ? MIX : XN, TAB8U(0), TAB8V(0), SCLU(0), SCLV(0), EXPB, GATEB, RESID_BF16 ? (const float*)XRB : xres, DRY(8) ? (float*)PB : (RESID_BF16 ? (float*)XRB : xres), AIN(I_NMIX) + DM, nullptr, (LAS float*)(lds + wave * PE4_LDS), lane, FUSE_NORM ? RSB(0) : nullptr, AIN(I_NFFN) + 0 * DM, PEER_ALIGN && G == 256, bar); }
#else
    for (int rep_ = 0; rep_ < NREP(8); ++rep_) if (IN(8)) { PH_IDS; for (int tok = gw; tok < MTOK; tok += NGW) peer_eval_wave(tok, XN, DRY(8) ? MIX : XN, TAB8U(0), TAB8V(0), SCLU(0), SCLV(0), EXPB, GATEB, xres, DRY(8) ? (float*)PB : xres, AIN(I_NMIX) + DM, nullptr, (LAS float*)(lds + wave * 2048), lane, DRY(8) ? PROBE_EXMASK : 0x3FFF); }
#endif
    SEAM(8);
#else
    if (IN(8)) { PH_IDS; for (int tok = gw; tok < MTOK; tok += NGW) naive_peer_eval_wave(tok, XN, (const bf16*)TAB8U(0), (const bf16*)TAB8V(0), EXPB, GATEB, xres, nullptr, nullptr, lane); }
    SEAM(8);
    if (IN(9)) { PH_IDS; rms_rows(xres, AIN(I_NMIX) + DM, XN, nullptr, gw, NGW, lane); }
    SEAM(9);
#endif
    for (int rep_ = 0; rep_ < NREP(10); ++rep_) if (IN(10)) { PH_IDS;
#if FAST_GEMM
        pg8::Gemm g{XN, Win1t, MTOK, NP1, DM}; pg8::StaticOrder S; S.init(MTOK, NP1, G, bx);
        S.rot = 4;

#if GEMM3_STAGGER
        if ((bx >> 3) & 1) { for (int i_ = 0; i_ < GEMM3_STAGGER; ++i_) __builtin_amdgcn_s_sleep(127); }
#endif
        pg8::EpiAct<1> E{PB, NP1, LBV};
        pg8::gemm_phase<pg8::EpiAct<1>, pg8::StaticOrder, GEMM_ALIGN_ACT, true>(lds + RING_OFF, g, S, E);
#else
        naive_gemm(XN, Win1t, MTOK, NP1, DM, NEpiAct{PB, NP1, 1, LBV}, gtid, gthreads);
#endif
    }
    SEAM(10);
#if FAST_HGRN
    for (int rep_ = 0; rep_ < NREP(11); ++rep_) if (IN(11)) { PH_IDS; for (int u = bx; u < 256; u += G) hgrn_pass_a(u, PB, (float*)(WSP + WS_EXP), (float*)(WSP + WS_GATE), lds, tid); }
#endif
    SEAM(11);
#if FAST_HGRN
    for (int rep_ = 0; rep_ < NREP(12); ++rep_) if (IN(12)) { PH_IDS; for (int u = bx; u < 256; u += G) hgrn_pass_c(u, PB, (const float*)(WSP + WS_EXP), (const float*)(WSP + WS_GATE), AIN(I_HNW), MIX, lds, tid); }
#else
    if (IN(12)) { PH_IDS; for (int blk = bx; blk < 8; blk += G) naive_hgrn_block(blk, PB, AIN(I_HNW), MIX, lds, tid); }
#endif
    SEAM(12);
    for (int rep_ = 0; rep_ < NREP(13); ++rep_) if (IN(13)) { PH_IDS;
#if FAST_GEMM
        pg8::Gemm g{MIX, Wout1t, MTOK, DM, DM}; pg8::StaticOrder S; S.init(MTOK, DM, G, bx);
#if FUSE_NORM
        pg8::EpiResidNorm E{xres, DRY(13) ? (float*)PB : xres, XN, RSB(1), DM};
        pg8::gemm_phase<pg8::EpiResidNorm, pg8::StaticOrder, true, true>(lds + RING_OFF, g, S, E);
#elif RESID_BF16
        pg8::EpiResidBf<true> E{XRB, DRY(13) ? PB : X3B, DM};
        pg8::gemm_phase<pg8::EpiResidBf<true>, pg8::StaticOrder, GEMM_ALIGN_RES, true>(lds + RING_OFF, g, S, E);
#else
        pg8::EpiResid E{xres, DRY(13) ? (float*)PB : xres, DM};
        pg8::gemm_phase<pg8::EpiResid, pg8::StaticOrder, true, true>(lds + RING_OFF, g, S, E);
#endif
#else
        naive_gemm(MIX, Wout1t, MTOK, DM, DM, NEpiResid{xres, xres, DM}, gtid, gthreads);
#endif
    }
    SEAM(13);
#if !FUSE_NORM
    for (int rep_ = 0; rep_ < NREP(14); ++rep_) if (IN(14)) { PH_IDS; if (RESID_BF16) rms_rows_bf(X3B, AIN(I_NFFN) + DM, XN, gw, NGW, lane); else rms_rows(xres, AIN(I_NFFN) + DM, XN, nullptr, gw, NGW, lane); }
    SEAM(14);
#endif
    for (int rep_ = 0; rep_ < NREP(15); ++rep_) if (IN(15)) { PH_IDS;
#if FAST_GEMM
        pg8::Gemm g{XN, Wqt + (size_t)NQP * DM, MTOK, NQP, DM}; pg8::StaticOrder S; S.init(MTOK, NQP, G, bx);
#if FUSE_NORM
        pg8::EpiRowScale E{PB, NQP, RSB(1), 1.0f / DM, EPS};
        pg8::gemm_phase<pg8::EpiRowScale, pg8::StaticOrder, true, true>(lds + RING_OFF, g, S, E);
#else
        pg8::EpiAct<2> E{PB, NQP, nullptr};
        pg8::gemm_phase<pg8::EpiAct<2>, pg8::StaticOrder, true, true>(lds + RING_OFF, g, S, E);
#endif
#else
        naive_gemm(XN, Wqt + (size_t)NQP * DM, MTOK, NQP, DM, NEpiAct{PB, NQP, 2, nullptr}, gtid, gthreads);
#endif
    }
    SEAM_QSEL(15);
#if FAST_PSEL
    for (int rep_ = 0; rep_ < NREP(16); ++rep_) if (IN(16)) { PH_IDS; int curh = -1; for (int ui_ = 0, u = bx; u < 1024; u += G, ++ui_) { int u_ = u; if (FUSE_QSEL && G == 256) u_ = qsel_unit(ui_, G, bx); if ((u_ & 7) != curh) { curh = u_ & 7; psel_stage_keys(KEYS + (size_t)(8 + curh) * 2 * 128 * 128, (LAS bf16*)(lds + 65536), tid); } peer_select_unit(u_, PB, (const LAS bf16*)(lds + 65536), EXPB, GATEB, (LAS unsigned*)(lds + wave * 8192), wave, lane); } }
#else
    if (IN(16)) { PH_IDS; for (int wu = gw; wu < MTOK * 8; wu += NGW) naive_peer_select_wave(wu, PB, KEYS + (size_t)8 * 2 * 128 * 128, EXPB, GATEB, lds + wave * 2048, lane); }
#endif
    SEAM(16);
#if FAST_PEVAL
#if PEER_CHUNK
    for (int rep_ = 0; rep_ < NREP(17); ++rep_) if (IN(17)) { PH_IDS; for (int t4 = gw; t4 < MTOK / 4; t4 += NGW) peer_eval4c_wave(4 * t4, XN, XN, TAB8U(1), TAB8V(1), SCLU(1), SCLV(1), EXPB, GATEB, xres, DRY(17) ? (float*)PB : xres, nullptr, AIN(I_FNORM), (LAS float*)(lds + wave * PE4C_LDS), lane); }
#elif PEER_EVAL4
    for (int rep_ = 0; rep_ < NREP(17); ++rep_) if (IN(17)) { PH_IDS; for (int t4 = gw; t4 < MTOK / PT; t4 += NGW) EVAL_ALIGN peer_eval4m_wave(PT * t4, XN, XN, TAB8U(1), TAB8V(1), SCLU(1), SCLV(1), EXPB, GATEB, RESID_BF16 ? (const float*)X3B : xres, DRY(17) ? (float*)PB : xres, nullptr, AIN(I_FNORM), (LAS float*)(lds + wave * PE4_LDS), lane, FUSE_NORM ? RSB(1) : nullptr, AIN(I_NFFN) + 1 * DM, PEER_ALIGN && G == 256, bar); }
#else
    for (int rep_ = 0; rep_ < NREP(17); ++rep_) if (IN(17)) { PH_IDS; for (int tok = gw; tok < MTOK; tok += NGW) peer_eval_wave(tok, XN, XN, TAB8U(1), TAB8V(1), SCLU(1), SCLV(1), EXPB, GATEB, xres, DRY(17) ? (float*)PB : xres, nullptr, AIN(I_FNORM), (LAS float*)(lds + wave * 2048), lane); }
#endif
#else
    if (IN(17)) { PH_IDS; for (int tok = gw; tok < MTOK; tok += NGW) naive_peer_eval_wave(tok, XN, (const bf16*)TAB8U(0), (const bf16*)TAB8V(0), EXPB, GATEB, xres, nullptr, AIN(I_FNORM), lane); }
#endif
#undef IN
#undef SEAM
}

extern "C" void kernel_launch(void* const* d_in, const int* in_sizes, int n_in, void* d_out, int out_size, void* d_ws, size_t ws_size, hipStream_t stream) {
    static int grid = 0;
    if (grid == 0) {
        if (n_in != 22 || in_sizes[0] != MTOK * DM || out_size != MTOK * DM || ws_size < WS_END) { fprintf(stderr, "kernel_launch: unexpected shapes / workspace (n_in %d, ws %zu); nothing launched\n", n_in, ws_size); grid = -1; return; }
        int dev = 0, cus = 0, per_cu = 0;
        if (hipGetDevice(&dev) != hipSuccess || hipDeviceGetAttribute(&cus, hipDeviceAttributeMultiprocessorCount, dev) != hipSuccess) { grid = -1; return; }
        if (hipFuncSetAttribute((const void*)fwd_kernel, hipFuncAttributeMaxDynamicSharedMemorySize, LDS_BYTES) != hipSuccess) { fprintf(stderr, "kernel_launch: hipFuncSetAttribute failed\n"); grid = -1; return; }
        if (hipOccupancyMaxActiveBlocksPerMultiprocessor(&per_cu, (const void*)fwd_kernel, NTHR, LDS_BYTES) != hipSuccess || per_cu < 1) { fprintf(stderr, "kernel_launch: occupancy query reports %d workgroups per CU; nothing launched\n", per_cu); (void)hipGetLastError(); grid = -1; return; }
        grid = cus;
    }
    if (grid < 0) return;
    (void)hipMemsetAsync((char*)d_ws + WS_CTL, 0, CTL_ZERO_BYTES, stream);
    Args a{};
    for (int i = 0; i < 22; ++i) a.in[i] = (const float*)d_in[i];
    a.out = (float*)d_out; a.ws = (unsigned char*)d_ws;
    for (int li = 0; li < MK_N_LAUNCHES; ++li) {
        if (MK_N_LAUNCHES == 1) { a.ph_lo = 0; a.ph_hi = N_PHASES; } else { a.ph_lo = li; a.ph_hi = li + 1; }
        a.li = li;
        hipLaunchKernelGGL(fwd_kernel, dim3(grid), dim3(NTHR), LDS_BYTES, stream, a);
    }
}
```
